# Optimizing an MI355X kernel written in HIP

```python
import jax, jax.numpy as jnp
from jax import lax
import numpy as np

D_MODEL = 1024
BATCH = 1
SEQ = 16384
DEPTH = 4

N_A = DEPTH // 2
N_B = DEPTH - N_A
EPS = 1e-6

NH_A = 4
DV_A = D_MODEL // NH_A
DQK_A = DV_A // 2
CHUNK = 64
GATE_CAP = 15.0
QK_W = NH_A * DQK_A
V_W = NH_A * DV_A
IN_A = 2 * QK_W + 2 * V_W + 2 * NH_A

NH_B = 16
KVH_B = 2
GRP_B = NH_B // KVH_B
DH_B = 64
WINDOW = 128
BLK = WINDOW

D_FF = ((8 * D_MODEL // 3 + 255) // 256) * 256

kernel_name = "yoco_mlstm_swa_sink_hybrid"


def rmsnorm(x, g):
    xf = x.astype(jnp.float32)
    y = xf * lax.rsqrt(jnp.mean(xf * xf, axis=-1, keepdims=True) + EPS)
    return (y * g.astype(jnp.float32)).astype(x.dtype)


def swiglu(x, w_gate_up, w_down):
    gu = x @ w_gate_up
    g, u = jnp.split(gu, 2, axis=-1)
    return (jax.nn.silu(g) * u) @ w_down


def mlstm_chunkwise(q, k, v, ig, lf):
    Bsz, S, H, _ = q.shape
    nc = S // CHUNK

    def to_chunks(t):
        return t.reshape(Bsz, nc, CHUNK, H, -1).transpose(1, 0, 3, 2, 4)

    def gate_chunks(t):
        return t.reshape(Bsz, nc, CHUNK, H).transpose(1, 0, 3, 2)

    causal = jnp.tril(jnp.ones((CHUNK, CHUNK), dtype=bool))

    def body(carry, xs):
        C, n, m = carry
        qc, kc, vc, ic, lfc = xs
        b = jnp.cumsum(lfc, axis=-1)
        b_tot = b[..., -1]
        D = b[..., :, None] - b[..., None, :] + ic[..., None, :]
        D = jnp.where(causal, D, -jnp.inf)
        inter = b + m[..., None]
        m_t = jnp.maximum(inter, jnp.max(D, axis=-1))
        Sw = jnp.einsum('bhtd,bhsd->bhts', qc, kc) * jnp.exp(D - m_t[..., None])
        e_inter = jnp.exp(inter - m_t)
        num = jnp.einsum('bhts,bhsv->bhtv', Sw, vc) + e_inter[..., None] * jnp.einsum('bhvd,bhtd->bhtv', C, qc)
        den = jnp.sum(Sw, axis=-1) + e_inter * jnp.einsum('bhd,bhtd->bht', n, qc)
        h = num / jnp.maximum(jnp.abs(den), jnp.exp(-m_t))[..., None]
        w = b_tot[..., None] - b + ic
        m_new = jnp.maximum(b_tot + m, jnp.max(w, axis=-1))
        decay = jnp.exp(b_tot + m - m_new)
        ws = jnp.exp(w - m_new[..., None])
        C_new = decay[..., None, None] * C + jnp.einsum('bhs,bhsv,bhsd->bhvd', ws, vc, kc)
        n_new = decay[..., None] * n + jnp.einsum('bhs,bhsd->bhd', ws, kc)
        return (C_new, n_new, m_new), h

    init = (jnp.zeros((Bsz, H, v.shape[-1], q.shape[-1]), jnp.float32),
            jnp.zeros((Bsz, H, q.shape[-1]), jnp.float32),
            jnp.zeros((Bsz, H), jnp.float32))
    xs = (to_chunks(q), to_chunks(k), to_chunks(v), gate_chunks(ig), gate_chunks(lf))
    _, hs = lax.scan(body, init, xs)
    return hs.transpose(1, 0, 3, 2, 4).reshape(Bsz, S, H, -1)


def mlstm_mixer(x, w_in, b_gates, head_norm, w_out):
    Bsz, S, _ = x.shape
    proj = x @ w_in
    q, k, v, o, gates = jnp.split(proj, [QK_W, 2 * QK_W, 2 * QK_W + V_W, 2 * QK_W + 2 * V_W], axis=-1)
    gates = gates.astype(jnp.float32) + b_gates.astype(jnp.float32)
    gates = GATE_CAP * jnp.tanh(gates / GATE_CAP)
    ig, fg = jnp.split(gates, 2, axis=-1)
    lf = jax.nn.log_sigmoid(fg)
    qf = q.astype(jnp.float32).reshape(Bsz, S, NH_A, DQK_A) * (DQK_A ** -0.5)
    kf = k.astype(jnp.float32).reshape(Bsz, S, NH_A, DQK_A)
    vf = v.astype(jnp.float32).reshape(Bsz, S, NH_A, DV_A)
    h = mlstm_chunkwise(qf, kf, vf, ig, lf)
    h = h * lax.rsqrt(jnp.mean(h * h, axis=-1, keepdims=True) + EPS)
    h = h * head_norm.astype(jnp.float32).reshape(NH_A, DV_A)
    h = h.reshape(Bsz, S, V_W) * jax.nn.sigmoid(o.astype(jnp.float32))
    return h.astype(x.dtype) @ w_out


def shared_kv(x, kv_norm, w_kv, b_kv):
    Bsz, S, _ = x.shape
    nb = S // BLK
    kv = rmsnorm(x, kv_norm) @ w_kv + b_kv
    k, v = jnp.split(kv, 2, axis=-1)

    def band(t):
        tb = t.reshape(Bsz, nb, BLK, KVH_B, DH_B)
        prev = jnp.concatenate([jnp.zeros_like(tb[:, :1]), tb[:, :-1]], axis=1)
        return jnp.concatenate([prev, tb], axis=2)

    return band(k), band(v)


def swa_sink_mixer(x, k2, v2, w_q, b_q, sinks, w_out, b_out):
    Bsz, S, _ = x.shape
    nb = S // BLK
    q = (x @ w_q + b_q).reshape(Bsz, nb, BLK, KVH_B, GRP_B, DH_B)
    s = jnp.einsum('bnqkgd,bnpkd->bnkgqp', q, k2).astype(jnp.float32) * (DH_B ** -0.5)
    i = jnp.arange(BLK)[:, None]
    j = jnp.arange(2 * BLK)[None, :]
    rel = i + BLK - j
    band = (rel >= 0) & (rel < WINDOW)
    valid = band[None] & ((jnp.arange(nb) > 0)[:, None, None] | (j >= BLK)[None])
    s = jnp.where(valid[None, :, None, None], s, -jnp.inf)
    sk = sinks.astype(jnp.float32).reshape(KVH_B, GRP_B)[None, None, :, :, None, None]
    mx = jnp.maximum(jnp.max(s, axis=-1, keepdims=True), sk)
    p = jnp.exp(s - mx)
    p = p / (jnp.sum(p, axis=-1, keepdims=True) + jnp.exp(sk - mx))
    o = jnp.einsum('bnkgqp,bnpkd->bnqkgd', p.astype(v2.dtype), v2)
    return o.reshape(Bsz, S, NH_B * DH_B) @ w_out + b_out


def setup_inputs(seed: int = 0) -> dict:
    key = jax.random.key(seed)
    ks = jax.random.split(key, 24)
    f32 = jnp.float32
    nrm = lambda k, shape, scale: jax.random.normal(k, shape, f32) * scale
    b_i = nrm(ks[4], (N_A, NH_A), 0.1)
    b_f = 3.0 + nrm(ks[5], (N_A, NH_A), 0.5)
    return {
        "x": nrm(ks[0], (BATCH, SEQ, D_MODEL), 1.0),
        "a_norm": 1.0 + nrm(ks[1], (N_A, D_MODEL), 0.02),
        "a_w_in": nrm(ks[2], (N_A, D_MODEL, IN_A), D_MODEL ** -0.5),
        "a_b_gates": jnp.concatenate([b_i, b_f], axis=-1),
        "a_head_norm": 1.0 + nrm(ks[3], (N_A, V_W), 0.02),
        "a_w_out": nrm(ks[6], (N_A, V_W, D_MODEL), V_W ** -0.5),
        "kv_norm": 1.0 + nrm(ks[7], (D_MODEL,), 0.02),
        "w_kv": nrm(ks[8], (D_MODEL, 2 * KVH_B * DH_B), D_MODEL ** -0.5),
        "b_kv": nrm(ks[9], (2 * KVH_B * DH_B,), 0.02),
        "b_norm": 1.0 + nrm(ks[10], (N_B, D_MODEL), 0.02),
        "b_w_q": nrm(ks[11], (N_B, D_MODEL, NH_B * DH_B), D_MODEL ** -0.5),
        "b_b_q": nrm(ks[12], (N_B, NH_B * DH_B), 0.02),
        "b_sinks": nrm(ks[13], (N_B, NH_B), 0.5),
        "b_w_out": nrm(ks[14], (N_B, NH_B * DH_B, D_MODEL), (NH_B * DH_B) ** -0.5),
        "b_b_out": nrm(ks[15], (N_B, D_MODEL), 0.02),
        "ffn_norm": 1.0 + nrm(ks[16], (DEPTH, D_MODEL), 0.02),
        "w_gate_up": nrm(ks[17], (DEPTH, D_MODEL, 2 * D_FF), D_MODEL ** -0.5),
        "w_down": nrm(ks[18], (DEPTH, D_FF, D_MODEL), D_FF ** -0.5),
        "final_norm": 1.0 + nrm(ks[19], (D_MODEL,), 0.02),
    }


def reference(x, a_norm, a_w_in, a_b_gates, a_head_norm, a_w_out, kv_norm, w_kv, b_kv,
              b_norm, b_w_q, b_b_q, b_sinks, b_w_out, b_b_out, ffn_norm, w_gate_up, w_down, final_norm):
    k2 = v2 = None
    for l in range(DEPTH):
        if l < N_A:
            x = x + mlstm_mixer(rmsnorm(x, a_norm[l]), a_w_in[l], a_b_gates[l], a_head_norm[l], a_w_out[l])
        else:
            j = l - N_A
            x = x + swa_sink_mixer(rmsnorm(x, b_norm[j]), k2, v2, b_w_q[j], b_b_q[j], b_sinks[j], b_w_out[j], b_b_out[j])
        x = x + swiglu(rmsnorm(x, ffn_norm[l]), w_gate_up[l], w_down[l])
        if l == N_A - 1:
            k2, v2 = shared_kv(x, kv_norm, w_kv, b_kv)
    return rmsnorm(x, final_norm)
```

```cpp
#include <hip/hip_runtime.h>
#include <cstdio>
#include <cstdint>

namespace {
constexpr int M = 16384, D = 1024, INA = 3080, DFF = 2816;
constexpr int NC = 256;
constexpr float EPS = 1e-6f;

__device__ __forceinline__ float wave_sum(float v) {
#pragma unroll
    for (int o = 1; o < 64; o <<= 1) v += __shfl_xor(v, o);
    return v;
}

__global__ void __launch_bounds__(256) k_rmsnorm(const float* x, const float* __restrict__ g, float* out) {
    const int row = blockIdx.x * 4 + (threadIdx.x >> 6), lane = threadIdx.x & 63;
    const float4* xr = (const float4*)(x + (size_t)row * D) + lane;
    float4 v[4]; float s = 0.f;
#pragma unroll
    for (int j = 0; j < 4; ++j) { v[j] = xr[64 * j]; s += v[j].x * v[j].x + v[j].y * v[j].y + v[j].z * v[j].z + v[j].w * v[j].w; }
    const float r = rsqrtf(wave_sum(s) * (1.f / D) + EPS);
    float4* o = (float4*)(out + (size_t)row * D) + lane; const float4* gg = (const float4*)g + lane;
#pragma unroll
    for (int j = 0; j < 4; ++j) { const float4 w = gg[64 * j]; o[64 * j] = make_float4(v[j].x * r * w.x, v[j].y * r * w.y, v[j].z * r * w.z, v[j].w * r * w.w); }
}

template <int MODE>
__global__ void __launch_bounds__(256) k_gemm(const float* __restrict__ A, int lda, const float* __restrict__ B, int ldb, float* C, int ldc,
                                             const float* __restrict__ bias, int N, int K) {
    __shared__ float As[16][64 + 4];
    __shared__ float Bs[16][64 + 4];
    __shared__ float Bs2[MODE == 2 ? 16 : 1][64 + 4];
    const int tid = threadIdx.x, tx = tid & 15, ty = tid >> 4;
    const int m0 = blockIdx.y * 64, n0 = blockIdx.x * 64;
    float acc[4][4] = {}, acc2[4][4] = {};
    for (int k0 = 0; k0 < K; k0 += 16) {
#pragma unroll
        for (int i = 0; i < 4; ++i) { const int idx = tid + i * 256, r = idx >> 4, kk = idx & 15; As[kk][r] = A[(size_t)(m0 + r) * lda + k0 + kk]; }
#pragma unroll
        for (int i = 0; i < 4; ++i) { const int idx = tid + i * 256, kk = idx >> 6, c = idx & 63; const int n = n0 + c;
            Bs[kk][c] = (n < N) ? B[(size_t)(k0 + kk) * ldb + n] : 0.f;
            if (MODE == 2) Bs2[kk][c] = B[(size_t)(k0 + kk) * ldb + n + N]; }
        __syncthreads();
#pragma unroll
        for (int kk = 0; kk < 16; ++kk) {
            float a[4], b[4], b2[4];
#pragma unroll
            for (int i = 0; i < 4; ++i) { a[i] = As[kk][ty * 4 + i]; b[i] = Bs[kk][tx * 4 + i]; if (MODE == 2) b2[i] = Bs2[kk][tx * 4 + i]; }
#pragma unroll
            for (int i = 0; i < 4; ++i)
#pragma unroll
                for (int j = 0; j < 4; ++j) { acc[i][j] += a[i] * b[j]; if (MODE == 2) acc2[i][j] += a[i] * b2[j]; }
        }
        __syncthreads();
    }
#pragma unroll
    for (int i = 0; i < 4; ++i)
#pragma unroll
        for (int j = 0; j < 4; ++j) {
            const int m = m0 + ty * 4 + i, n = n0 + tx * 4 + j;
            if (n < N) {
                float v = acc[i][j] + (bias ? bias[n] : 0.f);
                if (MODE == 2) { const float g = acc[i][j], u = acc2[i][j]; v = g / (1.f + __expf(-g)) * u; }
                float* p = C + (size_t)m * ldc + n;
                if (MODE == 1) *p += v; else *p = v;
            }
        }
}

__device__ __forceinline__ float softcap(float x) { return 15.f * tanhf(x * (1.f / 15.f)); }
__device__ __forceinline__ float logsigmoid(float x) { return fminf(x, 0.f) - log1pf(expf(-fabsf(x))); }

__device__ __forceinline__ void chunk_gates(const float* __restrict__ proj, const float* __restrict__ bg, int c, int h, float* bcum, float* aval, float* igs) {
    const int tid = threadIdx.x;
    if (tid < 64) {
        const size_t row = (size_t)(c * 64 + tid) * INA;
        const float ip = softcap(proj[row + 3072 + h] + bg[h]);
        const float fp = softcap(proj[row + 3076 + h] + bg[4 + h]);
        igs[tid] = ip; bcum[tid] = logsigmoid(fp);
    }
    __syncthreads();
    if (tid == 0) { float s = 0.f; for (int t = 0; t < 64; ++t) { s += bcum[t]; bcum[t] = s; } }
    __syncthreads();
    if (tid < 64) aval[tid] = igs[tid] - bcum[tid];
    __syncthreads();
}

__global__ void __launch_bounds__(256) k_ml_local(const float* __restrict__ proj, const float* __restrict__ bg, int h0, float* __restrict__ STATE, float* __restrict__ NST, float* __restrict__ CH) {
    __shared__ float bcum[64], aval[64], igs[64], wsv[64];
    const int c = blockIdx.x, hh = blockIdx.y, h = h0 + hh, tid = threadIdx.x;
    chunk_gates(proj, bg, c, h, bcum, aval, igs);
    const float btot = bcum[63];
    float amax = -INFINITY; for (int s = 0; s < 64; ++s) amax = fmaxf(amax, aval[s]);
    const float mloc = btot + amax;
    if (tid < 64) wsv[tid] = expf(btot + aval[tid] - mloc);
    __syncthreads();
    const float* kbase = proj + (size_t)(c * 64) * INA + 512 + h * 128;
    const float* vbase = proj + (size_t)(c * 64) * INA + 1024 + h * 256 + tid;
    float* st = STATE + ((size_t)(c * 2 + hh) * 128) * 256 + tid;
    for (int d0 = 0; d0 < 128; d0 += 16) {
        float acc[16] = {};
        for (int s = 0; s < 64; ++s) {
            const float wv = wsv[s] * vbase[(size_t)s * INA];
#pragma unroll
            for (int j = 0; j < 16; ++j) acc[j] += wv * kbase[(size_t)s * INA + d0 + j];
        }
#pragma unroll
        for (int j = 0; j < 16; ++j) st[(size_t)(d0 + j) * 256] = acc[j];
    }
    if (tid < 128) { float a = 0.f; for (int s = 0; s < 64; ++s) a += wsv[s] * kbase[(size_t)s * INA + tid]; NST[(size_t)(c * 2 + hh) * 128 + tid] = a; }
    if (tid == 0) { CH[(c * 2 + hh) * 2 + 0] = btot; CH[(c * 2 + hh) * 2 + 1] = mloc; }
}

__global__ void __launch_bounds__(256) k_ml_scan(float* __restrict__ STATE, float* __restrict__ NST, const float* __restrict__ CH, float* __restrict__ MS) {
    const int e = blockIdx.x * 256 + threadIdx.x;
    const bool isn = e >= 2 * 32768;
    const int hh = isn ? (e - 2 * 32768) / 128 : e / 32768;
    float* base = isn ? NST + (e - 2 * 32768) : STATE + e;
    const size_t stride = isn ? 256 : 2 * 32768;
    const bool writer = isn ? ((e - 2 * 32768) % 128 == 0) : false;
    float m = 0.f, Cv = 0.f;
    for (int c = 0; c < NC; ++c) {
        const float bt = CH[(c * 2 + hh) * 2], ml = CH[(c * 2 + hh) * 2 + 1];
        const float mn = fmaxf(bt + m, ml);
        const float f1 = expf(bt + m - mn), f2 = expf(ml - mn);
        const float u = base[(size_t)c * stride];
        base[(size_t)c * stride] = Cv;
        if (writer) MS[c * 2 + hh] = m;
        Cv = f1 * Cv + f2 * u; m = mn;
    }
}

__global__ void __launch_bounds__(256) k_ml_out(const float* __restrict__ proj, const float* __restrict__ bg, int h0, const float* __restrict__ STATE, const float* __restrict__ NST,
                                                const float* __restrict__ MS, const float* __restrict__ hnorm, float* __restrict__ HG) {
    __shared__ float bcum[64], aval[64], igs[64], mt[64], et[64], den[64], nq[64];
    __shared__ float S[64][65];
    __shared__ float red[4];
    const int c = blockIdx.x, hh = blockIdx.y, h = h0 + hh, tid = threadIdx.x;
    chunk_gates(proj, bg, c, h, bcum, aval, igs);
    const float mc = MS[c * 2 + hh];
    const float scale = 0.08838834764831845f;
    if (tid < 64) { float am = -INFINITY; for (int s = 0; s <= tid; ++s) am = fmaxf(am, aval[s]); const float m_t = bcum[tid] + fmaxf(mc, am); mt[tid] = m_t; et[tid] = expf(bcum[tid] + mc - m_t); }
    __syncthreads();
    const float* qbase = proj + (size_t)(c * 64) * INA + h * 128;
    const float* kbase = proj + (size_t)(c * 64) * INA + 512 + h * 128;
    {
        const int t = tid >> 2;
        for (int j = 0; j < 16; ++j) { const int s = (tid & 3) * 16 + j; float a = 0.f;
            if (s <= t) { for (int d = 0; d < 128; ++d) a += qbase[(size_t)t * INA + d] * kbase[(size_t)s * INA + d]; a *= scale * expf(bcum[t] + aval[s] - mt[t]); }
            S[t][s] = a; }
    }
    if (tid < 64) { float a = 0.f; const float* nn = NST + (size_t)(c * 2 + hh) * 128; for (int d = 0; d < 128; ++d) a += nn[d] * qbase[(size_t)tid * INA + d]; nq[tid] = a * scale; }
    __syncthreads();
    if (tid < 64) { float a = 0.f; for (int s = 0; s < 64; ++s) a += S[tid][s]; a += et[tid] * nq[tid]; den[tid] = fmaxf(fabsf(a), expf(-mt[tid])); }
    __syncthreads();
    float Ccol[128];
    const float* st = STATE + ((size_t)(c * 2 + hh) * 128) * 256 + tid;
#pragma unroll
    for (int d = 0; d < 128; ++d) Ccol[d] = st[(size_t)d * 256];
    const float* vbase = proj + (size_t)(c * 64) * INA + 1024 + h * 256 + tid;
    const float gain = hnorm[h * 256 + tid];
    for (int t = 0; t < 64; ++t) {
        float a = 0.f;
        for (int s = 0; s <= t; ++s) a += S[t][s] * vbase[(size_t)s * INA];
        float b = 0.f;
#pragma unroll
        for (int d = 0; d < 128; ++d) b += Ccol[d] * qbase[(size_t)t * INA + d];
        const float hv = (a + et[t] * scale * b) / den[t];
        float ss = wave_sum(hv * hv);
        __syncthreads();
        if ((tid & 63) == 0) red[tid >> 6] = ss;
        __syncthreads();
        const float tot = red[0] + red[1] + red[2] + red[3];
        const float r = rsqrtf(tot * (1.f / 256.f) + EPS);
        const size_t row = (size_t)(c * 64 + t);
        const float o = proj[row * INA + 2048 + h * 256 + tid];
        HG[row * D + h * 256 + tid] = hv * r * gain / (1.f + expf(-o));
    }
}

__global__ void __launch_bounds__(128) k_attn(const float* __restrict__ Q, const float* __restrict__ KV, const float* __restrict__ sinks, float* __restrict__ O) {
    const int nb = blockIdx.x, head = blockIdx.y, kvh = head >> 3, i = threadIdx.x;
    const int qpos = nb * 128 + i;
    float q[64];
#pragma unroll
    for (int d = 0; d < 64; ++d) q[d] = Q[(size_t)qpos * D + head * 64 + d];
    float m = sinks[head], l = 1.f, o[64];
#pragma unroll
    for (int d = 0; d < 64; ++d) o[d] = 0.f;
    for (int j = 0; j < 256; ++j) {
        const int kpos = (nb - 1) * 128 + j;
        if (kpos < 0) continue;
        const int rel = i + 128 - j;
        const bool valid = (rel >= 0) && (rel < 128);
        const float* kr = KV + (size_t)kpos * 256 + kvh * 64;
        const float* vr = KV + (size_t)kpos * 256 + 128 + kvh * 64;
        float s = 0.f;
#pragma unroll
        for (int d = 0; d < 64; ++d) s += q[d] * kr[d];
        s *= 0.125f;
        if (valid) {
            const float mn = fmaxf(m, s), corr = expf(m - mn), p = expf(s - mn);
            l = l * corr + p;
#pragma unroll
            for (int d = 0; d < 64; ++d) o[d] = o[d] * corr + p * vr[d];
            m = mn;
        }
    }
    const float inv = 1.f / l;
#pragma unroll
    for (int d = 0; d < 64; ++d) O[(size_t)qpos * D + head * 64 + d] = o[d] * inv;
}

template <int MODE>
void gemm(hipStream_t s, const float* A, int lda, const float* B, int ldb, float* C, int ldc, const float* bias, int N, int K) {
    dim3 grid((N + 63) / 64, M / 64);
    hipLaunchKernelGGL(k_gemm<MODE>, grid, dim3(256), 0, s, A, lda, B, ldb, C, ldc, bias, N, K);
}
}

extern "C" void kernel_launch(void* const* d_in, const int* in_sizes, int n_in, void* d_out, int out_size, void* d_ws, size_t ws_size, hipStream_t stream) {
    const float* x = (const float*)d_in[0];
    const float* a_norm = (const float*)d_in[1];
    const float* a_w_in = (const float*)d_in[2];
    const float* a_b_gates = (const float*)d_in[3];
    const float* a_head_norm = (const float*)d_in[4];
    const float* a_w_out = (const float*)d_in[5];
    const float* kv_norm = (const float*)d_in[6];
    const float* w_kv = (const float*)d_in[7];
    const float* b_kv = (const float*)d_in[8];
    const float* b_norm = (const float*)d_in[9];
    const float* b_w_q = (const float*)d_in[10];
    const float* b_b_q = (const float*)d_in[11];
    const float* b_sinks = (const float*)d_in[12];
    const float* b_w_out = (const float*)d_in[13];
    const float* b_b_out = (const float*)d_in[14];
    const float* ffn_norm = (const float*)d_in[15];
    const float* w_gate_up = (const float*)d_in[16];
    const float* w_down = (const float*)d_in[17];
    const float* final_norm = (const float*)d_in[18];
    float* X = (float*)d_out;
    const size_t MiB = 1u << 20;
    char* ws = (char*)d_ws;
    float* XN = (float*)(ws);
    float* BIG = (float*)(ws + 64 * MiB);
    float* STATE = (float*)(ws + 257 * MiB);
    float* NST = (float*)(ws + 321 * MiB);
    float* CH = NST + 256 * 2 * 128;
    float* MS = CH + 256 * 2 * 2;
    float* KVb = (float*)(ws + 322 * MiB);
    const size_t need = 322 * MiB + (size_t)M * 256 * 4;
    if (ws_size < need) { fprintf(stderr, "kernel_launch: workspace too small: %zu < %zu\n", ws_size, need); return; }

    hipMemcpyAsync(X, x, (size_t)M * D * 4, hipMemcpyDeviceToDevice, stream);
    for (int l = 0; l < 4; ++l) {
        if (l < 2) {
            hipLaunchKernelGGL(k_rmsnorm, dim3(M / 4), dim3(256), 0, stream, X, a_norm + l * D, XN);
            gemm<0>(stream, XN, D, a_w_in + (size_t)l * D * INA, INA, BIG, INA, nullptr, INA, D);
            for (int hp = 0; hp < 2; ++hp) {
                hipLaunchKernelGGL(k_ml_local, dim3(NC, 2), dim3(256), 0, stream, BIG, a_b_gates + l * 8, hp * 2, STATE, NST, CH);
                hipLaunchKernelGGL(k_ml_scan, dim3((2 * 32768 + 256) / 256), dim3(256), 0, stream, STATE, NST, CH, MS);
                hipLaunchKernelGGL(k_ml_out, dim3(NC, 2), dim3(256), 0, stream, BIG, a_b_gates + l * 8, hp * 2, STATE, NST, MS, a_head_norm + l * D, XN);
            }
            gemm<1>(stream, XN, D, a_w_out + (size_t)l * D * D, D, X, D, nullptr, D, D);
        } else {
            const int j = l - 2;
            hipLaunchKernelGGL(k_rmsnorm, dim3(M / 4), dim3(256), 0, stream, X, b_norm + j * D, XN);
            gemm<0>(stream, XN, D, b_w_q + (size_t)j * D * D, D, BIG, D, b_b_q + j * D, D, D);
            hipLaunchKernelGGL(k_attn, dim3(128, 16), dim3(128), 0, stream, BIG, KVb, b_sinks + j * 16, XN);
            gemm<1>(stream, XN, D, b_w_out + (size_t)j * D * D, D, X, D, b_b_out + j * D, D, D);
        }
        hipLaunchKernelGGL(k_rmsnorm, dim3(M / 4), dim3(256), 0, stream, X, ffn_norm + l * D, XN);
        gemm<2>(stream, XN, D, w_gate_up + (size_t)l * D * 2 * DFF, 2 * DFF, BIG, DFF, nullptr, DFF, D);
        gemm<1>(stream, BIG, DFF, w_down + (size_t)l * DFF * D, D, X, D, nullptr, D, DFF);
        if (l == 1) {
            hipLaunchKernelGGL(k_rmsnorm, dim3(M / 4), dim3(256), 0, stream, X, kv_norm, XN);
            gemm<0>(stream, XN, D, w_kv, 256, KVb, 256, b_kv, 256, D);
        }
    }
    hipLaunchKernelGGL(k_rmsnorm, dim3(M / 4), dim3(256), 0, stream, X, final_norm, X);
}
```

```cpp
#include <hip/hip_runtime.h>
#include <cstdio>
#include <cstdint>
#include <cmath>
namespace pg8 {
#define PG8_LAS __attribute__((address_space(3)))
typedef unsigned short bf16_t;
typedef short bf16x8 __attribute__((ext_vector_type(8)));
typedef float f32x4 __attribute__((ext_vector_type(4)));
typedef unsigned u32x4 __attribute__((ext_vector_type(4)));
constexpr int BM = 256, BK = 64, HALF = 128, HTB = HALF * BK * 2  , STAGE_BYTES = 8 * HTB, NXCD = 8, WGM = 8;

__host__ __device__ __forceinline__ int lds_byte(int r, int c) { const int st = (r >> 4) * 2 + (c >> 5), rr = r & 15, cc = c & 31, ob = rr * 64 + cc * 2; return st * 1024 + (ob ^ (((ob >> 9) & 1) << 5)); }
__host__ __device__ __forceinline__ void stage_rc(int b, int& R, int& C) { const int st = b / 1024, sb = b % 1024, swz = sb ^ (((sb >> 9) & 1) << 5); R = (st >> 1) * 16 + swz / 64; C = (st & 1) * 32 + (swz % 64) / 2; }
__host__ __device__ __forceinline__ int perm32(int rho) { const int n = rho >> 4, i = rho & 15; return 8 * (i >> 2) + 4 * n + (i & 3); }

struct Unit { int pm, pn; };
struct Gemm { const bf16_t* A; const bf16_t* Bt; int M, N, K; };

struct StaticOrder {
    int nM, nN, nwg, G, c;
    __host__ __device__ void init(int M, int N, int G_, int c_) { nM = M / BM; nN = N / BM; nwg = nM * nN; G = G_; c = c_; }
    __host__ __device__ bool next(int i, Unit& u) const {
        const long L = (long)i * G + c; if (L >= nwg) return false;
        int wgid = (int)L; { const int q = nwg / NXCD, r = nwg % NXCD, xcd = wgid % NXCD, off = wgid / NXCD; wgid = (xcd < r ? xcd * (q + 1) : r * (q + 1) + (xcd - r) * q) + off; }
        const int nig = WGM * nN, gid = wgid / nig, fm = gid * WGM, gsz = (nM - fm) < WGM ? (nM - fm) : WGM;
        u.pm = fm + ((wgid % nig) % gsz); u.pn = (wgid % nig) / gsz; return true;
    }
    __device__ __forceinline__ void a_ready(const Unit&) const {}
    __device__ __forceinline__ void done(const Unit&) const {}
};

__device__ __forceinline__ unsigned cvt_pk_bf16(float lo, float hi) { unsigned r; asm volatile("v_cvt_pk_bf16_f32 %0, %1, %2" : "=v"(r) : "v"(lo), "v"(hi)); return r; }
typedef float f32x2 __attribute__((ext_vector_type(2)));
template <class Epi, class Sched, bool ALIGN_EPI = false, bool SP2 = false>
__device__ __forceinline__ void gemm_phase(PG8_LAS unsigned char* lds, const Gemm g, const Sched& S, const Epi& E) {
    int tid_ = threadIdx.x; asm volatile("" : "+v"(tid_));
    const int tid = tid_, wid = __builtin_amdgcn_readfirstlane(tid >> 6), lane = tid & 63, wr = wid >> 2, wc = wid & 3, fr = lane & 15, fq = lane >> 4;
    const int K = g.K, nt = K / BK;
    unsigned voffA[2], voffB[2];
#pragma unroll
    for (int i = 0; i < 2; ++i) { int R, C; stage_rc(tid * 16 + i * 8192, R, C); const int Rb = Epi::PERM ? ((R & ~31) + perm32(R & 31)) : R;
        voffA[i] = (unsigned)(R * K + C) * 2u; voffB[i] = (unsigned)(Rb * K + C) * 2u; }
    const size_t kstep = (size_t)(BK * 2);
    const size_t hstep = (size_t)HALF * K * 2;
    const size_t tstep = 2 * hstep;
    const unsigned ldsw = (unsigned)wid * 1024u;
    const int aoff = lds_byte(wr * 64 + fr, fq * 8), boff = lds_byte(wc * 32 + fr, fq * 8);
#define PG8_SA(b, h) (((b) * 2 + (h)) * HTB)
#define PG8_SB(b, h) ((4 + (b) * 2 + (h)) * HTB)
#define PG8_STAGE(bufoff, gbase, voff) do { _Pragma("unroll") for (int _i = 0; _i < 2; ++_i) \
        __builtin_amdgcn_global_load_lds((const unsigned*)((const char*)(gbase) + (voff)[_i]), (PG8_LAS unsigned*)(lds + (bufoff) + ldsw + _i * 8192), 16, 0, 0); } while (0)
#define PG8_LDA(dst, b, h) do { _Pragma("unroll") for (int m = 0; m < 4; ++m) _Pragma("unroll") for (int k = 0; k < 2; ++k) dst[m][k] = *(const PG8_LAS bf16x8*)(lds + PG8_SA(b, h) + aoff + m * 2048 + k * 1024); } while (0)
#define PG8_LDB(dst, b, h) do { _Pragma("unroll") for (int n = 0; n < 2; ++n) _Pragma("unroll") for (int k = 0; k < 2; ++k) dst[n][k] = *(const PG8_LAS bf16x8*)(lds + PG8_SB(b, h) + boff + n * 2048 + k * 1024); } while (0)
#define PG8_MMA(ai, bj, At, Bt) do { __builtin_amdgcn_s_setprio(1); _Pragma("unroll") for (int m = 0; m < 4; ++m) _Pragma("unroll") for (int n = 0; n < 2; ++n) _Pragma("unroll") for (int k = 0; k < 2; ++k) \
        acc[ai][bj][m][n] = __builtin_amdgcn_mfma_f32_16x16x32_bf16(Bt[n][k], At[m][k], acc[ai][bj][m][n], 0, 0, 0); __builtin_amdgcn_s_setprio(0); } while (0)
#define PG8_WAIT_V(n) asm volatile("s_waitcnt vmcnt(" #n ")" ::: "memory")
#define PG8_WAIT_L(n) asm volatile("s_waitcnt lgkmcnt(" #n ")" ::: "memory")
#define PG8_BAR __builtin_amdgcn_s_barrier()
#define PG8_SCHED __builtin_amdgcn_sched_barrier(0)
    Unit cur, nxt; int ui = 0;
    if (!S.next(0, cur)) return;
    f32x4 acc[2][2][4][2];
#pragma unroll
    for (int a = 0; a < 2; ++a)
#pragma unroll
        for (int b = 0; b < 2; ++b)
#pragma unroll
            for (int m = 0; m < 4; ++m)
#pragma unroll
                for (int n = 0; n < 2; ++n) acc[a][b][m][n] = (f32x4){0.f, 0.f, 0.f, 0.f};
    bf16x8 At[4][2], B0[2][2], B1[2][2];
    const char* cA = (const char*)g.A + (size_t)cur.pm * tstep; const char* cB = (const char*)g.Bt + (size_t)cur.pn * tstep;
    S.a_ready(cur);
    if constexpr (SP2) {
        PG8_STAGE(PG8_SB(0, 0), cB, voffB); PG8_STAGE(PG8_SB(0, 1), cB + hstep, voffB); PG8_STAGE(PG8_SA(0, 0), cA, voffA); PG8_STAGE(PG8_SA(0, 1), cA + hstep, voffA);
        if (wr == 1) PG8_BAR;
        PG8_WAIT_V(2); PG8_BAR;
        PG8_STAGE(PG8_SB(1, 0), cB + kstep, voffB); PG8_STAGE(PG8_SA(1, 0), cA + kstep, voffA); PG8_STAGE(PG8_SB(1, 1), cB + hstep + kstep, voffB);
        PG8_WAIT_V(6); PG8_BAR;
    } else {
        PG8_STAGE(PG8_SB(0, 0), cB, voffB); PG8_STAGE(PG8_SA(0, 0), cA, voffA); PG8_STAGE(PG8_SB(0, 1), cB + hstep, voffB); PG8_STAGE(PG8_SA(0, 1), cA + hstep, voffA);
        if (wr == 1) PG8_BAR;
        PG8_WAIT_V(4); PG8_BAR;
        PG8_STAGE(PG8_SB(1, 0), cB + kstep, voffB); PG8_STAGE(PG8_SA(1, 0), cA + kstep, voffA); PG8_STAGE(PG8_SB(1, 1), cB + hstep + kstep, voffB);
        PG8_WAIT_V(6); PG8_BAR;
    }
    for (;;) {
        const bool has_next = S.next(ui + 1, nxt);
        const char* nA = has_next ? (const char*)g.A + (size_t)nxt.pm * tstep : cA; const char* nB = has_next ? (const char*)g.Bt + (size_t)nxt.pn * tstep : cB;
        for (int t = 0; t < nt; t += 2) {
            const bool last = (t == nt - 2);
            const char* a1 = cA + (size_t)(t + 1) * kstep;
            const char* a2 = last ? nA : cA + (size_t)(t + 2) * kstep; const char* b2 = last ? nB : cB + (size_t)(t + 2) * kstep;
            const char* a3 = a2 + kstep; const char* b3 = b2 + kstep;
            if (last && has_next) S.a_ready(nxt);
            if constexpr (SP2) {
            PG8_LDB(B0, 0, 0); PG8_LDB(B1, 0, 1); PG8_SCHED; PG8_LDA(At, 0, 0); PG8_STAGE(PG8_SA(1, 1), a1 + hstep, voffA);
            PG8_WAIT_V(8); PG8_WAIT_L(0); PG8_BAR; PG8_MMA(0, 0, At, B0); PG8_MMA(0, 1, At, B1); PG8_BAR; PG8_SCHED;
            PG8_LDA(At, 0, 1); PG8_STAGE(PG8_SB(0, 0), b2, voffB); PG8_STAGE(PG8_SB(0, 1), b2 + hstep, voffB); PG8_STAGE(PG8_SA(0, 0), a2, voffA);
            PG8_WAIT_V(8); PG8_WAIT_L(0); PG8_BAR; PG8_MMA(1, 0, At, B0); PG8_MMA(1, 1, At, B1); PG8_BAR; PG8_SCHED;
            PG8_LDB(B0, 1, 0); PG8_LDB(B1, 1, 1); PG8_SCHED; PG8_LDA(At, 1, 0); PG8_STAGE(PG8_SA(0, 1), a2 + hstep, voffA);
            PG8_WAIT_V(8); PG8_WAIT_L(0); PG8_BAR; PG8_MMA(0, 0, At, B0); PG8_MMA(0, 1, At, B1); PG8_BAR; PG8_SCHED;
            PG8_LDA(At, 1, 1); PG8_STAGE(PG8_SB(1, 0), b3, voffB); PG8_STAGE(PG8_SB(1, 1), b3 + hstep, voffB); PG8_STAGE(PG8_SA(1, 0), a3, voffA);
            PG8_WAIT_V(8); PG8_WAIT_L(0); PG8_BAR; PG8_MMA(1, 0, At, B0); PG8_MMA(1, 1, At, B1); PG8_BAR; PG8_SCHED;
            } else {
            PG8_LDB(B0, 0, 0); PG8_SCHED; PG8_LDA(At, 0, 0); PG8_STAGE(PG8_SA(1, 1), a1 + hstep, voffA);
            PG8_WAIT_L(8); PG8_BAR; PG8_WAIT_L(0); PG8_MMA(0, 0, At, B0); PG8_BAR; PG8_SCHED;
            PG8_LDB(B1, 0, 1); PG8_STAGE(PG8_SB(0, 0), b2, voffB);
            PG8_BAR; PG8_WAIT_L(0); PG8_MMA(0, 1, At, B1); PG8_BAR;
            PG8_LDA(At, 0, 1); PG8_STAGE(PG8_SA(0, 0), a2, voffA);
            PG8_BAR; PG8_WAIT_L(0); PG8_MMA(1, 0, At, B0); PG8_BAR; PG8_SCHED;
            PG8_STAGE(PG8_SB(0, 1), b2 + hstep, voffB);
            PG8_WAIT_V(6); PG8_BAR; PG8_MMA(1, 1, At, B1); PG8_BAR;
            PG8_LDB(B0, 1, 0); PG8_SCHED; PG8_LDA(At, 1, 0); PG8_STAGE(PG8_SA(0, 1), a2 + hstep, voffA);
            PG8_WAIT_L(8); PG8_BAR; PG8_WAIT_L(0); PG8_MMA(0, 0, At, B0); PG8_BAR; PG8_SCHED;
            PG8_LDB(B1, 1, 1); PG8_STAGE(PG8_SB(1, 0), b3, voffB);
            PG8_BAR; PG8_WAIT_L(0); PG8_MMA(0, 1, At, B1); PG8_BAR;
            PG8_LDA(At, 1, 1); PG8_STAGE(PG8_SA(1, 0), a3, voffA);
            PG8_BAR; PG8_WAIT_L(0); PG8_MMA(1, 0, At, B0); PG8_BAR; PG8_SCHED;
            PG8_STAGE(PG8_SB(1, 1), b3 + hstep, voffB);
            PG8_WAIT_V(6); PG8_BAR; PG8_MMA(1, 1, At, B1); PG8_BAR;
            }
        }
        if constexpr (ALIGN_EPI) { if (wr == 0) PG8_BAR; }
        if constexpr (!Epi::AFTER_DRAIN) { E(acc, cur, wr, wc, fr, fq); S.done(cur); }
        if (!has_next) break;
#pragma unroll
        for (int a = 0; a < 2; ++a)
#pragma unroll
            for (int b = 0; b < 2; ++b)
#pragma unroll
                for (int m = 0; m < 4; ++m)
#pragma unroll
                    for (int n = 0; n < 2; ++n) acc[a][b][m][n] = (f32x4){0.f, 0.f, 0.f, 0.f};
        cur = nxt; cA = nA; cB = nB; ++ui;
        if constexpr (ALIGN_EPI) { if (wr == 1) PG8_BAR; }
    }
    PG8_WAIT_V(0);
    if constexpr (!ALIGN_EPI) { if (wr == 0) PG8_BAR; }
    PG8_BAR;
    if constexpr (Epi::AFTER_DRAIN) { E.fused(acc, cur, wr, wc, fr, fq, lds, wid, lane); S.done(cur); }
#undef PG8_SA
#undef PG8_SB
#undef PG8_STAGE
#undef PG8_LDA
#undef PG8_LDB
#undef PG8_MMA
#undef PG8_WAIT_V
#undef PG8_WAIT_L
#undef PG8_BAR
#undef PG8_SCHED
}
}
#define GAS __attribute__((address_space(1)))
#define LAS __attribute__((address_space(3)))
typedef unsigned short bf16;
typedef unsigned v4u __attribute__((ext_vector_type(4)));
typedef float f32x4 __attribute__((ext_vector_type(4)));
typedef short bf16x8 __attribute__((ext_vector_type(8)));
typedef GAS unsigned gu32;
typedef GAS unsigned long long gu64;
#define RLX_AGENT __ATOMIC_RELAXED, __HIP_MEMORY_SCOPE_AGENT
#define LDS_WAIT() asm volatile("s_waitcnt lgkmcnt(0)" ::: "memory")
#define VM_WAIT() asm volatile("s_waitcnt vmcnt(0)" ::: "memory")
__device__ __forceinline__ unsigned long long rt() { return __builtin_amdgcn_s_memrealtime(); }
__device__ __forceinline__ unsigned f2bf(float f) { unsigned u = __builtin_bit_cast(unsigned, f); return (u + 0x7fffu + ((u >> 16) & 1u)) >> 16; }
__device__ __forceinline__ unsigned pk2(float lo, float hi) { return f2bf(lo) | (f2bf(hi) << 16); }

#define XB_TMO      128
#define XB_XCNT(j)  (256  + 64 * (j))
#define XB_XSUB(j)  (1280 + 64 * (j))
#define XB_XGEN(j)  (2304 + 64 * (j))
#define XB_TOP      3328
#define XB_TOPGEN   3392
#define XCD_BAR_WORDS 3456
#define XB_SPIN_CAP (1u << 18)

__device__ __forceinline__ unsigned xb_ld(unsigned* p)              { return __hip_atomic_load(p, __ATOMIC_RELAXED, __HIP_MEMORY_SCOPE_AGENT); }
__device__ __forceinline__ unsigned xb_add(unsigned* p, unsigned v) { return __hip_atomic_fetch_add(p, v, __ATOMIC_RELAXED, __HIP_MEMORY_SCOPE_AGENT); }
__device__ __forceinline__ unsigned xb_xcc_id() { return (unsigned)__builtin_amdgcn_s_getreg((3 << 11) | 20) & 0xFu; }
#define XB_SPIN(cond, bar) do { unsigned _sp = 0; while (cond) { __builtin_amdgcn_s_sleep(1); \
    if ((++_sp & 255u) == 0u) { if (xb_ld(&(bar)[XB_TMO])) break; if (_sp > XB_SPIN_CAP) { atomicAdd(&(bar)[XB_TMO], 1u); break; } } } } while (0)

struct XcdBarrier {
    unsigned* bar; unsigned x;
    volatile LAS unsigned* st;
};

__device__ __forceinline__ XcdBarrier xcd_barrier_post(unsigned* bar, volatile LAS unsigned* st) {
    XcdBarrier b; b.bar = bar; b.x = xb_xcc_id(); b.st = st;
    if (threadIdx.x == 0) (void)xb_add(&bar[XB_XCNT(b.x)], 1u);
    return b;
}
__device__ __forceinline__ void xcd_barrier_complete(unsigned* bar, unsigned x, unsigned& nloc, unsigned& nx) {
    const unsigned G = gridDim.x * gridDim.y * gridDim.z;
    unsigned sum, cnt, mine, sp = 0u;
    for (;;) {
        sum = 0u; cnt = 0u; mine = 0u;
#pragma unroll
        for (unsigned j = 0; j < 16; ++j) { const unsigned c = xb_ld(&bar[XB_XCNT(j)]); sum += c; cnt += (c > 0u) ? 1u : 0u; mine = (j == x) ? c : mine; }
        if (sum == G) break;
        __builtin_amdgcn_s_sleep(1);
        if ((++sp & 255u) == 0u) { if (xb_ld(&bar[XB_TMO])) break; if (sp > XB_SPIN_CAP) { atomicAdd(&bar[XB_TMO], 1u); break; } }
    }
    nloc = mine > 0u ? mine : 1u; nx = cnt > 0u ? cnt : 1u;
}

__device__ __forceinline__ void xcd_barrier(const XcdBarrier& b) {
    asm volatile("s_waitcnt vmcnt(0)" ::: "memory");
    __syncthreads();
    if (threadIdx.x == 0) {
        unsigned* bar = b.bar;
        __builtin_amdgcn_s_waitcnt(0);
        unsigned nloc = b.st[0], nx = b.st[1];
        if (nloc == 0u) { xcd_barrier_complete(bar, b.x, nloc, nx); b.st[0] = nloc; b.st[1] = nx; }
        const unsigned old = xb_add(&bar[XB_XSUB(b.x)], 1u);
        const unsigned gen = old / nloc;
        if (old + 1u == (gen + 1u) * nloc) {
            __builtin_amdgcn_fence(__ATOMIC_RELEASE, "agent");
            asm volatile("s_waitcnt vmcnt(0)" ::: "memory");
            const unsigned og = xb_add(&bar[XB_TOP], 1u);
            const unsigned tg = og / nx;
            if (og + 1u == (tg + 1u) * nx) xb_add(&bar[XB_TOPGEN], 1u);
            else XB_SPIN(xb_ld(&bar[XB_TOPGEN]) == tg, bar);
            __builtin_amdgcn_fence(__ATOMIC_ACQUIRE, "agent");
            xb_add(&bar[XB_XGEN(b.x)], 1u);
            asm volatile("s_waitcnt vmcnt(0)" ::: "memory");
        } else {
            XB_SPIN(xb_ld(&bar[XB_XGEN(b.x)]) == gen, bar);
            __builtin_amdgcn_fence(__ATOMIC_ACQUIRE, "agent");
            asm volatile("s_waitcnt vmcnt(0)" ::: "memory");
        }
    }
    __syncthreads();
}

constexpr int NWAVES = 8;
constexpr int M = 16384, D = 1024, DFF = 2816, INA = 3080, NC = 256;
constexpr float RMS_EPS = 1e-6f;
constexpr float LOG2E = 1.4426950408889634f;
constexpr float QSCALE_A = 0.08838834764831845f;
constexpr float C2 = 0.125f * LOG2E;

constexpr size_t MiB = 1u << 20;
constexpr size_t WS_CTL = 0, CTL_ZERO_BYTES = 1 * MiB;
constexpr size_t WS_SSP = 1 * MiB;
constexpr size_t WS_GATES = WS_SSP + 256 * 1024;
constexpr size_t WS_NST = 2 * MiB;
constexpr size_t WS_CH = WS_NST + 512 * 1024;
constexpr size_t WS_MS = WS_CH + 16 * 1024;
constexpr size_t WS_WGT = WS_MS + 16 * 1024;
constexpr size_t WS_BQ = WS_WGT + 64 * 1024;
constexpr size_t WS_WIN = 3 * MiB;
constexpr size_t WS_WOUT = 15 * MiB;
constexpr size_t WS_WQ2 = 19 * MiB;
constexpr size_t WS_WQ3 = WS_WQ2 + 1280 * 1024 * 2;
constexpr size_t WS_WBO = 24 * MiB;
constexpr size_t WS_WGU = 28 * MiB;
constexpr size_t WS_WD = 72 * MiB;
constexpr size_t WS_XB = 94 * MiB;
constexpr size_t WS_PROJ = 126 * MiB;
constexpr size_t WS_KV = 222 * MiB;
constexpr size_t WS_HG = 230 * MiB;
constexpr size_t WS_STATE = 262 * MiB;
constexpr size_t WS_END = 326 * MiB;
constexpr int CW_BAR = 4096;

constexpr int RING_OFF = 0, RING_BYTES = 131072;
constexpr int LDSCTL_OFF = RING_BYTES, MISC_OFF = LDSCTL_OFF + 320;
constexpr int LDS_BYTES = 147456;

typedef float f32x2 __attribute__((ext_vector_type(2)));
typedef unsigned u32x2 __attribute__((ext_vector_type(2)));
__device__ __forceinline__ float bf2f(unsigned short b) { return __builtin_bit_cast(float, (unsigned)b << 16); }
__device__ __forceinline__ float bflo(unsigned w) { return __builtin_bit_cast(float, w << 16); }
__device__ __forceinline__ float bfhi(unsigned w) { return __builtin_bit_cast(float, w & 0xffff0000u); }
__device__ __forceinline__ float wave_sum(float v) {
#pragma unroll
    for (int o = 1; o < 64; o <<= 1) v += __shfl_xor(v, o);
    return v;
}
__device__ __forceinline__ float rstd_of(const float* ssp, int row) { const f32x4 p = *(const f32x4*)(ssp + (size_t)row * 4); return rsqrtf(((p.x + p.y) + (p.z + p.w)) * (1.f / D) + RMS_EPS); }

struct EpiProj {
    static constexpr bool PERM = true, AFTER_DRAIN = false;
    bf16* O0; int ld0; bf16* O1; int ld1; int split; const float* bias; const float* ssp;
    __device__ __forceinline__ void operator()(const pg8::f32x4 (&acc)[2][2][4][2], const pg8::Unit& u, int wr, int wc, int fr, int fq) const {
        const int row0 = u.pm * 256 + wr * 64 + fr; int colt = u.pn * 256; bf16* base = O0; int ld = ld0;
        if (split && colt >= split) { base = O1; ld = ld1; colt -= split; }
        const int col0 = colt + wc * 32 + 8 * fq, bcol0 = u.pn * 256 + wc * 32 + 8 * fq;
        f32x4 bv[2][2];
#pragma unroll
        for (int bj = 0; bj < 2; ++bj)
#pragma unroll
            for (int n = 0; n < 2; ++n) bv[bj][n] = bias ? *(const f32x4*)(bias + bcol0 + bj * 128 + 4 * n) : (f32x4){0.f, 0.f, 0.f, 0.f};
#pragma unroll
        for (int ai = 0; ai < 2; ++ai)
#pragma unroll
            for (int m = 0; m < 4; ++m) { const int r = row0 + ai * 128 + m * 16; const float rs = rstd_of(ssp, r); bf16* rowp = base + (size_t)r * ld + col0;
#pragma unroll
                for (int bj = 0; bj < 2; ++bj) { const f32x4 v0 = acc[ai][bj][m][0] * rs + bv[bj][0], v1 = acc[ai][bj][m][1] * rs + bv[bj][1];
                    v4u w; w.x = pg8::cvt_pk_bf16(v0[0], v0[1]); w.y = pg8::cvt_pk_bf16(v0[2], v0[3]); w.z = pg8::cvt_pk_bf16(v1[0], v1[1]); w.w = pg8::cvt_pk_bf16(v1[2], v1[3]);
                    *(v4u*)(rowp + bj * 128) = w; } }
    }
};
__device__ __forceinline__ float silu_mul(float g, float u) { return g * __builtin_amdgcn_rcpf(1.f + __builtin_amdgcn_exp2f(-g * LOG2E)) * u; }
struct EpiSwiglu {
    static constexpr bool PERM = true, AFTER_DRAIN = false;
    bf16* H; const float* ssp;
    __device__ __forceinline__ void operator()(const pg8::f32x4 (&acc)[2][2][4][2], const pg8::Unit& u, int wr, int wc, int fr, int fq) const {
        const int row0 = u.pm * 256 + wr * 64 + fr, col0 = u.pn * 128 + wc * 32 + 8 * fq;
#pragma unroll
        for (int ai = 0; ai < 2; ++ai)
#pragma unroll
            for (int m = 0; m < 4; ++m) { const int r = row0 + ai * 128 + m * 16; const float rs = rstd_of(ssp, r);
                const f32x4 g0 = acc[ai][0][m][0] * rs, g1 = acc[ai][0][m][1] * rs, u0 = acc[ai][1][m][0] * rs, u1 = acc[ai][1][m][1] * rs;
                v4u w; w.x = pg8::cvt_pk_bf16(silu_mul(g0[0], u0[0]), silu_mul(g0[1], u0[1])); w.y = pg8::cvt_pk_bf16(silu_mul(g0[2], u0[2]), silu_mul(g0[3], u0[3]));
                w.z = pg8::cvt_pk_bf16(silu_mul(g1[0], u1[0]), silu_mul(g1[1], u1[1])); w.w = pg8::cvt_pk_bf16(silu_mul(g1[2], u1[2]), silu_mul(g1[3], u1[3]));
                *(v4u*)(H + (size_t)r * DFF + col0) = w; }
    }
};
struct EpiResid {
    static constexpr bool PERM = false, AFTER_DRAIN = true;
    const float* base; float* out; bf16* xb; const float* bias; float* ssp;
    __device__ __forceinline__ void fused(pg8::f32x4 (&acc)[2][2][4][2], const pg8::Unit& u, int wr, int wc, int fr, int fq, PG8_LAS unsigned char* lds, int wid, int lane) const {
        PG8_LAS float* P = (PG8_LAS float*)lds;
        const int col0 = u.pn * 256 + wc * 32 + 4 * fq;
#pragma unroll
        for (int ai = 0; ai < 2; ++ai)
#pragma unroll
            for (int m = 0; m < 4; ++m) { const int rl = ai * 128 + wr * 64 + m * 16 + fr; const size_t off = (size_t)(u.pm * 256 + rl) * D + col0; float ss = 0.f;
#pragma unroll
                for (int bj = 0; bj < 2; ++bj)
#pragma unroll
                    for (int n = 0; n < 2; ++n) { const size_t c = off + bj * 128 + n * 16; f32x4 v = *(const f32x4*)(base + c) + acc[ai][bj][m][n];
                        if (bias) v = v + *(const f32x4*)(bias + col0 + bj * 128 + n * 16);
                        *(f32x4*)(out + c) = v; u32x2 w; w.x = pg8::cvt_pk_bf16(v[0], v[1]); w.y = pg8::cvt_pk_bf16(v[2], v[3]); *(u32x2*)(xb + c) = w;
                        ss += (v[0] * v[0] + v[1] * v[1]) + (v[2] * v[2] + v[3] * v[3]); }
                ss += __shfl_xor(ss, 16); ss += __shfl_xor(ss, 32);
                if (fq == 0) P[rl * 4 + wc] = ss;
                if (m & 1) asm volatile("" ::: "memory"); }
        asm volatile("s_waitcnt lgkmcnt(0)" ::: "memory"); __builtin_amdgcn_s_barrier(); asm volatile("" ::: "memory");
        const int tid = wid * 64 + lane;
        if (tid < 256) { const f32x4 p = *(const PG8_LAS f32x4*)(P + tid * 4); ssp[(size_t)(u.pm * 256 + tid) * 4 + u.pn] = (p.x + p.y) + (p.z + p.w); }
        asm volatile("s_waitcnt lgkmcnt(0)" ::: "memory"); __builtin_amdgcn_s_barrier(); asm volatile("" ::: "memory");
    }
};

struct Frame {
    LAS unsigned char* lds;
    volatile LAS unsigned* MISC;
    gu32* ctl;
    int tid, lane, wave;
    int vcu, G;
};
struct Args { const float* in[19]; float* out; unsigned char* ws; };

#define LAUNDER_TID(F) do { int t_ = (F).tid; asm volatile("" : "+v"(t_)); (F).tid = t_; (F).lane = t_ & 63; } while (0)
__device__ __forceinline__ void conv_item(const float* W, int ldw, int K, int nblk, const float* gain, float qscale, int qcols, bf16* WT, int rowmode, int row_off, LAS float* scr, int item, int lane) {
    const int kb = item / nblk, nb = item % nblk, k0 = 64 * kb, n0 = 32 * nb;
    const float ns = (n0 < qcols) ? qscale : 1.f;
#pragma unroll 8
    for (int i = 0; i < 32; ++i) { const int kk = 2 * i + (lane >> 5); const float gk = gain ? gain[k0 + kk] * ns : ns; scr[kk * 33 + (lane & 31)] = W[(size_t)(k0 + kk) * ldw + n0 + (lane & 31)] * gk; }
    LDS_WAIT(); asm volatile("" ::: "memory");
    int rbase;
    if (rowmode == 0) rbase = row_off + n0;
    else { int j = n0, add = 0; if (j >= DFF) { j -= DFF; add = 128; } rbase = 256 * (j / 128) + add + (j % 128); }
    const int c = lane & 7;
#pragma unroll
    for (int j = 0; j < 4; ++j) { const int n = (lane >> 3) + 8 * j; const LAS float* s = scr + (8 * c) * 33 + n;
        v4u o; o.x = pk2(s[0 * 33], s[1 * 33]); o.y = pk2(s[2 * 33], s[3 * 33]); o.z = pk2(s[4 * 33], s[5 * 33]); o.w = pk2(s[6 * 33], s[7 * 33]);
        *(GAS v4u*)(WT + (size_t)(rbase + n) * K + k0 + 8 * c) = o; }
    LDS_WAIT(); asm volatile("" ::: "memory");
}
__device__ __forceinline__ void p0_prologue(Frame& F, const Args& A) {
    LAUNDER_TID(F);
    LAS float* scr = (LAS float*)(F.lds + RING_OFF + F.wave * 16384);
    const int gw = F.vcu * NWAVES + F.wave, NGW = F.G * NWAVES;
    unsigned char* ws = A.ws;
    const float* a_norm = A.in[1]; const float* a_w_in = A.in[2]; const float* a_w_out = A.in[5]; const float* kv_norm = A.in[6]; const float* w_kv = A.in[7]; const float* b_kv = A.in[8];
    const float* b_norm = A.in[9]; const float* b_w_q = A.in[10]; const float* b_b_q = A.in[11]; const float* b_w_out = A.in[13]; const float* ffn_norm = A.in[15];
    const float* w_gate_up = A.in[16]; const float* w_down = A.in[17];
    constexpr int I_IN = 16 * 96, I_SQ = 16 * 32, I_KV = 16 * 8, I_GU = 16 * 176, I_DN = 44 * 32;
    constexpr int NITEMS = 2 * I_IN + 2 * I_SQ + (I_SQ + I_KV + I_SQ) + 2 * I_SQ + 4 * I_GU + 4 * I_DN;
    for (int it = gw; it < NITEMS; it += NGW) {
        int r = it;
        if (r < 2 * I_IN) { const int l = r / I_IN; r -= l * I_IN; conv_item(a_w_in + (size_t)l * D * INA, INA, D, 96, a_norm + l * D, QSCALE_A, 512, (bf16*)(ws + WS_WIN) + (size_t)l * 3072 * D, 0, 0, scr, r, F.lane); continue; } r -= 2 * I_IN;
        if (r < 2 * I_SQ) { const int l = r / I_SQ; r -= l * I_SQ; conv_item(a_w_out + (size_t)l * D * D, D, D, 32, nullptr, 1.f, 0, (bf16*)(ws + WS_WOUT) + (size_t)l * D * D, 0, 0, scr, r, F.lane); continue; } r -= 2 * I_SQ;
        if (r < I_SQ) { conv_item(b_w_q, D, D, 32, b_norm, C2, 1024, (bf16*)(ws + WS_WQ2), 0, 0, scr, r, F.lane); continue; } r -= I_SQ;
        if (r < I_KV) { conv_item(w_kv, 256, D, 8, kv_norm, 1.f, 0, (bf16*)(ws + WS_WQ2), 0, 1024, scr, r, F.lane); continue; } r -= I_KV;
        if (r < I_SQ) { conv_item(b_w_q + (size_t)D * D, D, D, 32, b_norm + D, C2, 1024, (bf16*)(ws + WS_WQ3), 0, 0, scr, r, F.lane); continue; } r -= I_SQ;
        if (r < 2 * I_SQ) { const int l = r / I_SQ; r -= l * I_SQ; conv_item(b_w_out + (size_t)l * D * D, D, D, 32, nullptr, 1.f, 0, (bf16*)(ws + WS_WBO) + (size_t)l * D * D, 0, 0, scr, r, F.lane); continue; } r -= 2 * I_SQ;
        if (r < 4 * I_GU) { const int l = r / I_GU; r -= l * I_GU; conv_item(w_gate_up + (size_t)l * D * 2 * DFF, 2 * DFF, D, 176, ffn_norm + l * D, 1.f, 0, (bf16*)(ws + WS_WGU) + (size_t)l * 2 * DFF * D, 1, 0, scr, r, F.lane); continue; } r -= 4 * I_GU;
        { const int l = r / I_DN; r -= l * I_DN; conv_item(w_down + (size_t)l * DFF * D, D, DFF, 32, nullptr, 1.f, 0, (bf16*)(ws + WS_WD) + (size_t)l * D * DFF, 0, 0, scr, r, F.lane); }
    }
    const float* x = A.in[0]; bf16* XB = (bf16*)(ws + WS_XB); float* SSP = (float*)(ws + WS_SSP);
    for (int m = gw; m < M; m += NGW) {
        const GAS f32x4* xr = (const GAS f32x4*)(x + (size_t)m * D) + F.lane; GAS u32x2* o8 = (GAS u32x2*)(XB + (size_t)m * D) + F.lane; float s = 0.f;
#pragma unroll
        for (int j = 0; j < 4; ++j) { const f32x4 v = xr[64 * j]; s += (v.x * v.x + v.y * v.y) + (v.z * v.z + v.w * v.w); u32x2 w; w.x = pk2(v.x, v.y); w.y = pk2(v.z, v.w); o8[64 * j] = w; }
        s = wave_sum(s);
        if (F.lane == 0) *(f32x4*)(SSP + (size_t)m * 4) = (f32x4){s, 0.f, 0.f, 0.f};
    }
    const int gt = F.vcu * (NWAVES * 64) + F.tid, NGT = F.G * NWAVES * 64;
    float* WGT = (float*)(ws + WS_WGT); float* BQ = (float*)(ws + WS_BQ);
    for (int i = gt; i < 2 * 8 * 1024; i += NGT) { const int l = i >> 13, j = (i >> 10) & 7, k = i & 1023; WGT[i] = a_w_in[(size_t)l * D * INA + (size_t)k * INA + 3072 + j] * a_norm[l * D + k]; }
    for (int i = gt; i < 2 * 1280; i += NGT) { const int l = i / 1280, c = i % 1280; BQ[i] = (c < 1024) ? b_b_q[l * D + c] * C2 : b_kv[c - 1024]; }
}

__device__ __forceinline__ float softcap15(float x) { return 15.f * tanhf(x * (1.f / 15.f)); }
__device__ __forceinline__ float logsigmoidf(float x) { return fminf(x, 0.f) - log1pf(expf(-fabsf(x))); }

__device__ __forceinline__ void gates_phase(Frame& F, const bf16* XB, const float* SSP, const float* WGTl, const float* bgl, float* GATES) {
    LAUNDER_TID(F);
    LAS float* Wl = (LAS float*)(F.lds + RING_OFF);
    for (int i = F.tid; i < 8 * 1024 / 4; i += NWAVES * 64) ((LAS f32x4*)Wl)[i] = ((const f32x4*)WGTl)[i];
    __syncthreads();
    for (int blk = F.vcu; blk < M / 64; blk += F.G) {
#pragma unroll 1
        for (int rr = 0; rr < 8; ++rr) {
            const int row = blk * 64 + F.wave * 8 + rr;
            float acc[8] = {0.f, 0.f, 0.f, 0.f, 0.f, 0.f, 0.f, 0.f};
#pragma unroll
            for (int i = 0; i < 4; ++i) { const int k = 4 * F.lane + 256 * i; const u32x2 xw = *(const u32x2*)(XB + (size_t)row * D + k);
                const float x0 = bflo(xw.x), x1 = bfhi(xw.x), x2 = bflo(xw.y), x3 = bfhi(xw.y);
#pragma unroll
                for (int j = 0; j < 8; ++j) { const f32x4 w = *(const LAS f32x4*)(Wl + j * 1024 + k); acc[j] += (x0 * w.x + x1 * w.y) + (x2 * w.z + x3 * w.w); } }
#pragma unroll
            for (int j = 0; j < 8; ++j) acc[j] = wave_sum(acc[j]);
            if (F.lane < 8) { float a = acc[0];
#pragma unroll
                for (int j = 1; j < 8; ++j) a = (F.lane == j) ? acc[j] : a;
                const float pre = softcap15(a * rstd_of(SSP, row) + bgl[F.lane]);
                GATES[(size_t)row * 8 + F.lane] = (F.lane < 4) ? pre : logsigmoidf(pre); }
        }
    }
    __syncthreads();
}

__device__ __forceinline__ void chunk_gates(Frame& F, const float* GATES, int c, int h, LAS float* bcum, LAS float* aval) {
    if (F.tid < 64) {
        const float lf = GATES[(size_t)(c * 64 + F.tid) * 8 + 4 + h], ig = GATES[(size_t)(c * 64 + F.tid) * 8 + h];
        float s = lf;
#pragma unroll
        for (int o = 1; o < 64; o <<= 1) { const float t = __shfl_up(s, o); if (F.lane >= o) s += t; }
        bcum[F.tid] = s; aval[F.tid] = ig - s;
    }
    __syncthreads();
}

__device__ __forceinline__ void ml_local_phase(Frame& F, const bf16* PROJ, const float* GATES, bf16* STATE, float* NST, float* CH) {
    LAUNDER_TID(F);
    LAS float* bcum = (LAS float*)(F.lds + RING_OFF); LAS float* aval = bcum + 64; LAS float* wsv = aval + 64;
    for (int unit = F.vcu; unit < NC * 4; unit += F.G) {
        const int c = unit >> 2, h = unit & 3;
        chunk_gates(F, GATES, c, h, bcum, aval);
        const float btot = bcum[63]; float amax = -INFINITY;
        for (int s = 0; s < 64; ++s) amax = fmaxf(amax, aval[s]);
        const float mloc = btot + amax;
        if (F.tid < 64) wsv[F.tid] = expf(btot + aval[F.tid] - mloc);
        __syncthreads();
        const bf16* kb = PROJ + (size_t)(c * 64) * 3072 + 512 + h * 128;
        const bf16* vb = PROJ + (size_t)(c * 64) * 3072 + 1024 + h * 256;
        const int v = F.tid >> 1, dh = F.tid & 1;
        float acc[64];
#pragma unroll
        for (int j = 0; j < 64; ++j) acc[j] = 0.f;
#pragma unroll 1
        for (int s = 0; s < 64; ++s) {
            const float wv = wsv[s] * bf2f(vb[(size_t)s * 3072 + v]);
            const v4u* kr = (const v4u*)(kb + (size_t)s * 3072 + dh * 64);
#pragma unroll
            for (int q = 0; q < 8; ++q) { const v4u kk = kr[q];
                acc[q * 8 + 0] += wv * bflo(kk.x); acc[q * 8 + 1] += wv * bfhi(kk.x); acc[q * 8 + 2] += wv * bflo(kk.y); acc[q * 8 + 3] += wv * bfhi(kk.y);
                acc[q * 8 + 4] += wv * bflo(kk.z); acc[q * 8 + 5] += wv * bfhi(kk.z); acc[q * 8 + 6] += wv * bflo(kk.w); acc[q * 8 + 7] += wv * bfhi(kk.w); }
        }
        bf16* st = STATE + ((size_t)(c * 4 + h) * 256 + v) * 128 + dh * 64;
#pragma unroll
        for (int q = 0; q < 8; ++q) { v4u o; o.x = pk2(acc[q * 8 + 0], acc[q * 8 + 1]); o.y = pk2(acc[q * 8 + 2], acc[q * 8 + 3]); o.z = pk2(acc[q * 8 + 4], acc[q * 8 + 5]); o.w = pk2(acc[q * 8 + 6], acc[q * 8 + 7]); *(v4u*)(st + q * 8) = o; }
        if (F.tid < 128) { float a = 0.f; for (int s = 0; s < 64; ++s) a += wsv[s] * bf2f(kb[(size_t)s * 3072 + F.tid]); NST[(size_t)(c * 4 + h) * 128 + F.tid] = a; }
        if (F.tid == 0) { CH[(c * 4 + h) * 2] = btot; CH[(c * 4 + h) * 2 + 1] = mloc; }
        __syncthreads();
    }
}

__device__ __forceinline__ void ml_scan_phase(Frame& F, bf16* STATE, float* NST, const float* CH, float* MS) {
    LAUNDER_TID(F);
    const int e = F.vcu * (NWAVES * 64) + F.tid;
    const int NT = F.G * NWAVES * 64;
    for (int el = e; el < 4 * 32768; el += NT) {
        const int h = el >> 15; bf16* base = STATE + (size_t)h * 32768 + (el & 32767);
        float m = 0.f, Cv = 0.f;
#pragma unroll 1
        for (int c0 = 0; c0 < NC; c0 += 8) {
            unsigned short u[8];
#pragma unroll
            for (int j = 0; j < 8; ++j) u[j] = base[(size_t)(c0 + j) * 131072];
#pragma unroll
            for (int j = 0; j < 8; ++j) { const int c = c0 + j; const float bt = CH[(c * 4 + h) * 2], ml = CH[(c * 4 + h) * 2 + 1];
                const float mn = fmaxf(bt + m, ml); const float f1 = expf(bt + m - mn), f2 = expf(ml - mn);
                base[(size_t)c * 131072] = (unsigned short)f2bf(Cv);
                Cv = f1 * Cv + f2 * bf2f(u[j]); m = mn; }
        }
    }
    if (e < 512) {
        const int h = e >> 7; float* base = NST + e; float m = 0.f, nv = 0.f;
#pragma unroll 1
        for (int c = 0; c < NC; ++c) { const float bt = CH[(c * 4 + h) * 2], ml = CH[(c * 4 + h) * 2 + 1];
            const float mn = fmaxf(bt + m, ml); const float f1 = expf(bt + m - mn), f2 = expf(ml - mn);
            const float u = base[(size_t)c * 512]; base[(size_t)c * 512] = nv; if ((e & 127) == 0) MS[c * 4 + h] = m;
            nv = f1 * nv + f2 * u; m = mn; }
    }
}

__device__ __forceinline__ void ml_out_phase(Frame& F, const bf16* PROJ, const float* GATES, const bf16* STATE, const float* NST, const float* MS, const float* hnorm, bf16* HG) {
    LAUNDER_TID(F);
    LAS float* bcum = (LAS float*)(F.lds + RING_OFF); LAS float* aval = bcum + 64; LAS float* mt = aval + 64; LAS float* et = mt + 64; LAS float* den = et + 64; LAS float* nq = den + 64;
    LAS float* red = nq + 64;
    LAS float* S = red + 64;
    const float scale = 1.f;
    for (int unit = F.vcu; unit < NC * 4; unit += F.G) {
        const int c = unit >> 2, h = unit & 3;
        chunk_gates(F, GATES, c, h, bcum, aval);
        const float mc = MS[c * 4 + h];
        if (F.tid < 64) { float am = -INFINITY; for (int s = 0; s <= F.tid; ++s) am = fmaxf(am, aval[s]); const float m_t = bcum[F.tid] + fmaxf(mc, am); mt[F.tid] = m_t; et[F.tid] = expf(bcum[F.tid] + mc - m_t); }
        __syncthreads();
        const bf16* qb = PROJ + (size_t)(c * 64) * 3072 + h * 128;
        const bf16* kb = PROJ + (size_t)(c * 64) * 3072 + 512 + h * 128;
        const bf16* vb = PROJ + (size_t)(c * 64) * 3072 + 1024 + h * 256;
        {
            const int t = F.tid >> 3;
#pragma unroll 1
            for (int j = 0; j < 8; ++j) { const int s = (F.tid & 7) * 8 + j; float a = 0.f;
                if (s <= t) { const v4u* qr = (const v4u*)(qb + (size_t)t * 3072); const v4u* kr = (const v4u*)(kb + (size_t)s * 3072);
#pragma unroll 4
                    for (int q = 0; q < 16; ++q) { const v4u a4 = qr[q], b4 = kr[q];
                        a += bflo(a4.x) * bflo(b4.x) + bfhi(a4.x) * bfhi(b4.x) + bflo(a4.y) * bflo(b4.y) + bfhi(a4.y) * bfhi(b4.y) + bflo(a4.z) * bflo(b4.z) + bfhi(a4.z) * bfhi(b4.z) + bflo(a4.w) * bflo(b4.w) + bfhi(a4.w) * bfhi(b4.w); }
                    a *= scale * expf(bcum[t] + aval[s] - mt[t]); }
                S[t * 65 + s] = a; }
        }
        if (F.tid < 64) { float a = 0.f; const float* nn = NST + (size_t)(c * 4 + h) * 128; for (int d = 0; d < 128; ++d) a += nn[d] * bf2f(qb[(size_t)F.tid * 3072 + d]); nq[F.tid] = a * scale; }
        __syncthreads();
        if (F.tid < 64) { float a = 0.f; for (int s = 0; s < 64; ++s) a += S[F.tid * 65 + s]; a += et[F.tid] * nq[F.tid]; den[F.tid] = fmaxf(fabsf(a), expf(-mt[F.tid])); }
        __syncthreads();
        const int v = F.tid & 255, th = F.tid >> 8;
        v4u Cc[16];
        { const v4u* st = (const v4u*)(STATE + ((size_t)(c * 4 + h) * 256 + v) * 128);
#pragma unroll
          for (int q = 0; q < 16; ++q) Cc[q] = st[q]; }
        const float gain = hnorm[h * 256 + v];
#pragma unroll 1
        for (int tt = 0; tt < 32; ++tt) {
            const int t = th * 32 + tt;
            float a = 0.f;
            for (int s = 0; s <= t; ++s) a += S[t * 65 + s] * bf2f(vb[(size_t)s * 3072 + v]);
            float b = 0.f; const v4u* qr = (const v4u*)(qb + (size_t)t * 3072);
#pragma unroll
            for (int q = 0; q < 16; ++q) { const v4u a4 = qr[q], b4 = Cc[q];
                b += bflo(a4.x) * bflo(b4.x) + bfhi(a4.x) * bfhi(b4.x) + bflo(a4.y) * bflo(b4.y) + bfhi(a4.y) * bfhi(b4.y) + bflo(a4.z) * bflo(b4.z) + bfhi(a4.z) * bfhi(b4.z) + bflo(a4.w) * bflo(b4.w) + bfhi(a4.w) * bfhi(b4.w); }
            const float hv = (a + et[t] * scale * b) / den[t];
            const float ss = wave_sum(hv * hv);
            __syncthreads();
            if (F.lane == 0) red[F.wave] = ss;
            __syncthreads();
            const float tot = (red[th * 4] + red[th * 4 + 1]) + (red[th * 4 + 2] + red[th * 4 + 3]);
            const float r = rsqrtf(tot * (1.f / 256.f) + RMS_EPS);
            const size_t row = (size_t)(c * 64 + t);
            const float o = bf2f(PROJ[row * 3072 + 2048 + h * 256 + v]);
            HG[row * D + h * 256 + v] = (bf16)f2bf(hv * r * gain / (1.f + expf(-o)));
        }
        __syncthreads();
    }
}

__device__ __forceinline__ void attn_phase(Frame& F, const bf16* Q, const bf16* KV, const float* sinks, bf16* O) {
    LAUNDER_TID(F);
    for (int unit = F.vcu; unit < 128 * 16; unit += F.G) {
        const int nb = unit >> 4, head = unit & 15, kvh = head >> 3;
        const int i = F.tid >> 2, part = F.tid & 3;
        const int qpos = nb * 128 + i;
        float q[16], o[16];
        { const v4u* qr = (const v4u*)(Q + (size_t)qpos * D + head * 64 + part * 16);
#pragma unroll
          for (int w = 0; w < 2; ++w) { const v4u a = qr[w]; q[w * 8 + 0] = bflo(a.x); q[w * 8 + 1] = bfhi(a.x); q[w * 8 + 2] = bflo(a.y); q[w * 8 + 3] = bfhi(a.y); q[w * 8 + 4] = bflo(a.z); q[w * 8 + 5] = bfhi(a.z); q[w * 8 + 6] = bflo(a.w); q[w * 8 + 7] = bfhi(a.w); } }
        float m = sinks[head] * LOG2E, l = 1.f;
#pragma unroll
        for (int d = 0; d < 16; ++d) o[d] = 0.f;
        const int j0 = (nb == 0) ? 128 : 0;
#pragma unroll 1
        for (int j = j0; j < 256; ++j) {
            const int kpos = (nb - 1) * 128 + j;
            const int rel = i + 128 - j;
            const bool valid = (rel >= 0) && (rel < 128);
            const v4u* kr = (const v4u*)(KV + (size_t)kpos * 256 + kvh * 64 + part * 16);
            const v4u* vr = (const v4u*)(KV + (size_t)kpos * 256 + 128 + kvh * 64 + part * 16);
            float kf[16], vf[16];
#pragma unroll
            for (int w = 0; w < 2; ++w) { const v4u a = kr[w]; kf[w * 8 + 0] = bflo(a.x); kf[w * 8 + 1] = bfhi(a.x); kf[w * 8 + 2] = bflo(a.y); kf[w * 8 + 3] = bfhi(a.y); kf[w * 8 + 4] = bflo(a.z); kf[w * 8 + 5] = bfhi(a.z); kf[w * 8 + 6] = bflo(a.w); kf[w * 8 + 7] = bfhi(a.w);
                const v4u b = vr[w]; vf[w * 8 + 0] = bflo(b.x); vf[w * 8 + 1] = bfhi(b.x); vf[w * 8 + 2] = bflo(b.y); vf[w * 8 + 3] = bfhi(b.y); vf[w * 8 + 4] = bflo(b.z); vf[w * 8 + 5] = bfhi(b.z); vf[w * 8 + 6] = bflo(b.w); vf[w * 8 + 7] = bfhi(b.w); }
            float s = 0.f;
#pragma unroll
            for (int d = 0; d < 16; ++d) s += q[d] * kf[d];
            s += __shfl_xor(s, 1); s += __shfl_xor(s, 2);
            if (valid) {
                const float mn = fmaxf(m, s), corr = __builtin_amdgcn_exp2f(m - mn), p = __builtin_amdgcn_exp2f(s - mn);
                l = l * corr + p;
#pragma unroll
                for (int d = 0; d < 16; ++d) o[d] = o[d] * corr + p * vf[d];
                m = mn;
            }
        }
        const float inv = 1.f / l;
        v4u w0, w1;
        w0.x = pk2(o[0] * inv, o[1] * inv); w0.y = pk2(o[2] * inv, o[3] * inv); w0.z = pk2(o[4] * inv, o[5] * inv); w0.w = pk2(o[6] * inv, o[7] * inv);
        w1.x = pk2(o[8] * inv, o[9] * inv); w1.y = pk2(o[10] * inv, o[11] * inv); w1.z = pk2(o[12] * inv, o[13] * inv); w1.w = pk2(o[14] * inv, o[15] * inv);
        v4u* op = (v4u*)(O + (size_t)qpos * D + head * 64 + part * 16); op[0] = w0; op[1] = w1;
    }
}

__device__ __forceinline__ void final_norm_phase(Frame& F, float* X, const float* SSP, const float* g) {
    LAUNDER_TID(F);
    const int gw = F.vcu * NWAVES + F.wave, NGW = F.G * NWAVES;
    for (int m = gw; m < M; m += NGW) {
        const float rs = rstd_of(SSP, m);
        GAS f32x4* xr = (GAS f32x4*)(X + (size_t)m * D) + F.lane; const f32x4* gg = (const f32x4*)g + F.lane;
#pragma unroll
        for (int j = 0; j < 4; ++j) { const f32x4 v = xr[64 * j], w = gg[64 * j]; xr[64 * j] = v * rs * w; }
    }
}

#ifndef PG8_SP2
#define PG8_SP2 true
#endif
#ifndef PG8_ALIGN
#define PG8_ALIGN true
#endif
__global__ void __launch_bounds__(NWAVES * 64, 2) yoco_fwd(Args args) {
    extern __shared__ __attribute__((aligned(16))) unsigned char lds[];
    Frame F;
    F.lds = (LAS unsigned char*)lds;
    F.MISC = (volatile LAS unsigned*)(F.lds + MISC_OFF);
    F.tid = threadIdx.x; F.lane = F.tid & 63; F.wave = __builtin_amdgcn_readfirstlane(F.tid >> 6);
    F.G = gridDim.x; { const int bx = blockIdx.x; F.vcu = (F.G % 8 == 0) ? (bx % 8) * (F.G / 8) + bx / 8 : bx; }
    unsigned char* ws = args.ws;
    F.ctl = (gu32*)(ws + WS_CTL);
    for (int u = F.tid; u < (LDS_BYTES - LDSCTL_OFF) / 4; u += NWAVES * 64) ((LAS unsigned*)(F.lds + LDSCTL_OFF))[u] = 0u;
    __syncthreads();
    XcdBarrier bar = xcd_barrier_post((unsigned*)(F.ctl + CW_BAR), F.MISC + 8);
#define GRID_BAR() xcd_barrier(bar)

    float* X = args.out;
    float* SSP = (float*)(ws + WS_SSP); float* GATES = (float*)(ws + WS_GATES); float* NST = (float*)(ws + WS_NST); float* CH = (float*)(ws + WS_CH); float* MS = (float*)(ws + WS_MS);
    bf16* XB = (bf16*)(ws + WS_XB); bf16* PROJ = (bf16*)(ws + WS_PROJ); bf16* KVb = (bf16*)(ws + WS_KV); bf16* HG = (bf16*)(ws + WS_HG); bf16* STATE = (bf16*)(ws + WS_STATE);
    bf16* Hb = PROJ; bf16* Qb = PROJ;

    p0_prologue(F, args);
    GRID_BAR();

    for (int l = 0; l < 4; ++l) {
        const float* resid_base = (l == 0) ? args.in[0] : X;
        if (l < 2) {
            {
                pg8::Gemm g{XB, (const bf16*)(ws + WS_WIN) + (size_t)l * 3072 * D, M, 3072, D}; pg8::StaticOrder S; S.init(M, 3072, F.G, (int)blockIdx.x);
                EpiProj E{PROJ, 3072, PROJ, 3072, 0, nullptr, SSP};
                pg8::gemm_phase<EpiProj, pg8::StaticOrder, PG8_ALIGN, PG8_SP2>(F.lds + RING_OFF, g, S, E);
                gates_phase(F, XB, SSP, (const float*)(ws + WS_WGT) + l * 8 * 1024, args.in[3] + l * 8, GATES);
            }
            GRID_BAR();
            ml_local_phase(F, PROJ, GATES, STATE, NST, CH);
            GRID_BAR();
            ml_scan_phase(F, STATE, NST, CH, MS);
            GRID_BAR();
            ml_out_phase(F, PROJ, GATES, STATE, NST, MS, args.in[4] + l * D, HG);
            GRID_BAR();
            {
                pg8::Gemm g{HG, (const bf16*)(ws + WS_WOUT) + (size_t)l * D * D, M, D, D}; pg8::StaticOrder S; S.init(M, D, F.G, (int)blockIdx.x);
                EpiResid E{resid_base, X, XB, nullptr, SSP};
                pg8::gemm_phase<EpiResid, pg8::StaticOrder, false, PG8_SP2>(F.lds + RING_OFF, g, S, E);
            }
            GRID_BAR();
        } else {
            const int j = l - 2;
            {
                const int N = (j == 0) ? 1280 : 1024;
                pg8::Gemm g{XB, (const bf16*)(ws + (j == 0 ? WS_WQ2 : WS_WQ3)), M, N, D}; pg8::StaticOrder S; S.init(M, N, F.G, (int)blockIdx.x);
                EpiProj E{Qb, D, KVb, 256, 1024, (const float*)(ws + WS_BQ) + j * 1280, SSP};
                pg8::gemm_phase<EpiProj, pg8::StaticOrder, PG8_ALIGN, PG8_SP2>(F.lds + RING_OFF, g, S, E);
            }
            GRID_BAR();
            attn_phase(F, Qb, KVb, args.in[12] + j * 16, HG);
            GRID_BAR();
            {
                pg8::Gemm g{HG, (const bf16*)(ws + WS_WBO) + (size_t)j * D * D, M, D, D}; pg8::StaticOrder S; S.init(M, D, F.G, (int)blockIdx.x);
                EpiResid E{resid_base, X, XB, args.in[14] + j * D, SSP};
                pg8::gemm_phase<EpiResid, pg8::StaticOrder, false, PG8_SP2>(F.lds + RING_OFF, g, S, E);
            }
            GRID_BAR();
        }
        {
            pg8::Gemm g{XB, (const bf16*)(ws + WS_WGU) + (size_t)l * 2 * DFF * D, M, 2 * DFF, D}; pg8::StaticOrder S; S.init(M, 2 * DFF, F.G, (int)blockIdx.x);
            EpiSwiglu E{Hb, SSP};
            pg8::gemm_phase<EpiSwiglu, pg8::StaticOrder, PG8_ALIGN, PG8_SP2>(F.lds + RING_OFF, g, S, E);
        }
        GRID_BAR();
        {
            pg8::Gemm g{Hb, (const bf16*)(ws + WS_WD) + (size_t)l * D * DFF, M, D, DFF}; pg8::StaticOrder S; S.init(M, D, F.G, (int)blockIdx.x);
            EpiResid E{X, X, XB, nullptr, SSP};
            pg8::gemm_phase<EpiResid, pg8::StaticOrder, false, PG8_SP2>(F.lds + RING_OFF, g, S, E);
        }
        GRID_BAR();
    }
    final_norm_phase(F, X, SSP, args.in[18]);
}

extern "C" void kernel_launch(void* const* d_in, const int* in_sizes, int n_in, void* d_out, int out_size, void* d_ws, size_t ws_size, hipStream_t stream) {
    static int grid = 0;
    if (grid == 0) {
        if (n_in != 19 || in_sizes[0] != M * D || out_size != M * D || ws_size < WS_END) { fprintf(stderr, "kernel_launch: unexpected shapes / workspace (n_in %d, ws %zu < %zu)\n", n_in, ws_size, (size_t)WS_END); grid = -1; return; }
        int dev = 0, cus = 0, per_cu = 0;
        if (hipGetDevice(&dev) != hipSuccess || hipDeviceGetAttribute(&cus, hipDeviceAttributeMultiprocessorCount, dev) != hipSuccess) { grid = -1; return; }
        if (hipFuncSetAttribute((const void*)yoco_fwd, hipFuncAttributeMaxDynamicSharedMemorySize, LDS_BYTES) != hipSuccess) { fprintf(stderr, "kernel_launch: hipFuncSetAttribute failed\n"); grid = -1; return; }
        if (hipOccupancyMaxActiveBlocksPerMultiprocessor(&per_cu, (const void*)yoco_fwd, NWAVES * 64, LDS_BYTES) != hipSuccess || per_cu < 1) { fprintf(stderr, "kernel_launch: occupancy query says %d blocks per CU\n", per_cu); (void)hipGetLastError(); grid = -1; return; }
        grid = cus;
        if (grid != 256) fprintf(stderr, "kernel_launch: %d CUs; this kernel is laid out for 256\n", grid);
    }
    if (grid < 0) return;
    if (hipMemsetAsync((char*)d_ws + WS_CTL, 0, CTL_ZERO_BYTES, stream) != hipSuccess) return;
    Args a{};
    for (int i = 0; i < 19; ++i) a.in[i] = (const float*)d_in[i];
    a.out = (float*)d_out; a.ws = (unsigned char*)d_ws;
    hipLaunchKernelGGL(yoco_fwd, dim3(grid), dim3(NWAVES * 64), LDS_BYTES, stream, a);
}
```

```cpp
#include <hip/hip_runtime.h>
#include <cstdio>
#include <cstdint>
#include <cmath>
namespace pg8 {
#define PG8_LAS __attribute__((address_space(3)))
typedef unsigned short bf16_t;
typedef short bf16x8 __attribute__((ext_vector_type(8)));
typedef float f32x4 __attribute__((ext_vector_type(4)));
typedef unsigned u32x4 __attribute__((ext_vector_type(4)));
constexpr int BM = 256, BK = 64, HALF = 128, HTB = HALF * BK * 2  , STAGE_BYTES = 8 * HTB, NXCD = 8, WGM = 8;

__host__ __device__ __forceinline__ int lds_byte(int r, int c) { const int st = (r >> 4) * 2 + (c >> 5), rr = r & 15, cc = c & 31, ob = rr * 64 + cc * 2; return st * 1024 + (ob ^ (((ob >> 9) & 1) << 5)); }
__host__ __device__ __forceinline__ void stage_rc(int b, int& R, int& C) { const int st = b / 1024, sb = b % 1024, swz = sb ^ (((sb >> 9) & 1) << 5); R = (st >> 1) * 16 + swz / 64; C = (st & 1) * 32 + (swz % 64) / 2; }
__host__ __device__ __forceinline__ int perm32(int rho) { const int n = rho >> 4, i = rho & 15; return 8 * (i >> 2) + 4 * n + (i & 3); }

struct Unit { int pm, pn; };
struct Gemm { const bf16_t* A; const bf16_t* Bt; int M, N, K; };

struct StaticOrder {
    int nM, nN, nwg, G, c;
    __host__ __device__ void init(int M, int N, int G_, int c_) { nM = M / BM; nN = N / BM; nwg = nM * nN; G = G_; c = c_; }
    __host__ __device__ bool next(int i, Unit& u) const {
        const long L = (long)i * G + c; if (L >= nwg) return false;
        int wgid = (int)L; { const int q = nwg / NXCD, r = nwg % NXCD, xcd = wgid % NXCD, off = wgid / NXCD; wgid = (xcd < r ? xcd * (q + 1) : r * (q + 1) + (xcd - r) * q) + off; }
        const int nig = WGM * nN, gid = wgid / nig, fm = gid * WGM, gsz = (nM - fm) < WGM ? (nM - fm) : WGM;
        u.pm = fm + ((wgid % nig) % gsz); u.pn = (wgid % nig) / gsz; return true;
    }
    __device__ __forceinline__ void a_ready(const Unit&) const {}
    __device__ __forceinline__ void done(const Unit&) const {}
};

__device__ __forceinline__ unsigned cvt_pk_bf16(float lo, float hi) { unsigned r; asm volatile("v_cvt_pk_bf16_f32 %0, %1, %2" : "=v"(r) : "v"(lo), "v"(hi)); return r; }
typedef float f32x2 __attribute__((ext_vector_type(2)));
template <class Epi, class Sched, bool ALIGN_EPI = false, bool SP2 = false>
__device__ __forceinline__ void gemm_phase(PG8_LAS unsigned char* lds, const Gemm g, const Sched& S, const Epi& E) {
    int tid_ = threadIdx.x; asm volatile("" : "+v"(tid_));
    const int tid = tid_, wid = __builtin_amdgcn_readfirstlane(tid >> 6), lane = tid & 63, wr = wid >> 2, wc = wid & 3, fr = lane & 15, fq = lane >> 4;
    const int K = g.K, nt = K / BK;
    unsigned voffA[2], voffB[2];
#pragma unroll
    for (int i = 0; i < 2; ++i) { int R, C; stage_rc(tid * 16 + i * 8192, R, C); const int Rb = Epi::PERM ? ((R & ~31) + perm32(R & 31)) : R;
        voffA[i] = (unsigned)(R * K + C) * 2u; voffB[i] = (unsigned)(Rb * K + C) * 2u; }
    const size_t kstep = (size_t)(BK * 2);
    const size_t hstep = (size_t)HALF * K * 2;
    const size_t tstep = 2 * hstep;
    const unsigned ldsw = (unsigned)wid * 1024u;
    const int aoff = lds_byte(wr * 64 + fr, fq * 8), boff = lds_byte(wc * 32 + fr, fq * 8);
#define PG8_SA(b, h) (((b) * 2 + (h)) * HTB)
#define PG8_SB(b, h) ((4 + (b) * 2 + (h)) * HTB)
#define PG8_STAGE(bufoff, gbase, voff) do { _Pragma("unroll") for (int _i = 0; _i < 2; ++_i) \
        __builtin_amdgcn_global_load_lds((const unsigned*)((const char*)(gbase) + (voff)[_i]), (PG8_LAS unsigned*)(lds + (bufoff) + ldsw + _i * 8192), 16, 0, 0); } while (0)
#define PG8_LDA(dst, b, h) do { _Pragma("unroll") for (int m = 0; m < 4; ++m) _Pragma("unroll") for (int k = 0; k < 2; ++k) dst[m][k] = *(const PG8_LAS bf16x8*)(lds + PG8_SA(b, h) + aoff + m * 2048 + k * 1024); } while (0)
#define PG8_LDB(dst, b, h) do { _Pragma("unroll") for (int n = 0; n < 2; ++n) _Pragma("unroll") for (int k = 0; k < 2; ++k) dst[n][k] = *(const PG8_LAS bf16x8*)(lds + PG8_SB(b, h) + boff + n * 2048 + k * 1024); } while (0)
#define PG8_MMA(ai, bj, At, Bt) do { __builtin_amdgcn_s_setprio(1); _Pragma("unroll") for (int m = 0; m < 4; ++m) _Pragma("unroll") for (int n = 0; n < 2; ++n) _Pragma("unroll") for (int k = 0; k < 2; ++k) \
        acc[ai][bj][m][n] = __builtin_amdgcn_mfma_f32_16x16x32_bf16(Bt[n][k], At[m][k], acc[ai][bj][m][n], 0, 0, 0); __builtin_amdgcn_s_setprio(0); } while (0)
#define PG8_WAIT_V(n) asm volatile("s_waitcnt vmcnt(" #n ")" ::: "memory")
#define PG8_WAIT_L(n) asm volatile("s_waitcnt lgkmcnt(" #n ")" ::: "memory")
#define PG8_BAR __builtin_amdgcn_s_barrier()
#define PG8_SCHED __builtin_amdgcn_sched_barrier(0)
    Unit cur, nxt; int ui = 0;
    if (!S.next(0, cur)) return;
    f32x4 acc[2][2][4][2];
#pragma unroll
    for (int a = 0; a < 2; ++a)
#pragma unroll
        for (int b = 0; b < 2; ++b)
#pragma unroll
            for (int m = 0; m < 4; ++m)
#pragma unroll
                for (int n = 0; n < 2; ++n) acc[a][b][m][n] = (f32x4){0.f, 0.f, 0.f, 0.f};
    bf16x8 At[4][2], B0[2][2], B1[2][2];
    const char* cA = (const char*)g.A + (size_t)cur.pm * tstep; const char* cB = (const char*)g.Bt + (size_t)cur.pn * tstep;
    S.a_ready(cur);
    if constexpr (SP2) {
        PG8_STAGE(PG8_SB(0, 0), cB, voffB); PG8_STAGE(PG8_SB(0, 1), cB + hstep, voffB); PG8_STAGE(PG8_SA(0, 0), cA, voffA); PG8_STAGE(PG8_SA(0, 1), cA + hstep, voffA);
        if (wr == 1) PG8_BAR;
        PG8_WAIT_V(2); PG8_BAR;
        PG8_STAGE(PG8_SB(1, 0), cB + kstep, voffB); PG8_STAGE(PG8_SA(1, 0), cA + kstep, voffA); PG8_STAGE(PG8_SB(1, 1), cB + hstep + kstep, voffB);
        PG8_WAIT_V(6); PG8_BAR;
    } else {
        PG8_STAGE(PG8_SB(0, 0), cB, voffB); PG8_STAGE(PG8_SA(0, 0), cA, voffA); PG8_STAGE(PG8_SB(0, 1), cB + hstep, voffB); PG8_STAGE(PG8_SA(0, 1), cA + hstep, voffA);
        if (wr == 1) PG8_BAR;
        PG8_WAIT_V(4); PG8_BAR;
        PG8_STAGE(PG8_SB(1, 0), cB + kstep, voffB); PG8_STAGE(PG8_SA(1, 0), cA + kstep, voffA); PG8_STAGE(PG8_SB(1, 1), cB + hstep + kstep, voffB);
        PG8_WAIT_V(6); PG8_BAR;
    }
    for (;;) {
        const bool has_next = S.next(ui + 1, nxt);
        const char* nA = has_next ? (const char*)g.A + (size_t)nxt.pm * tstep : cA; const char* nB = has_next ? (const char*)g.Bt + (size_t)nxt.pn * tstep : cB;
        for (int t = 0; t < nt; t += 2) {
            const bool last = (t == nt - 2);
            const char* a1 = cA + (size_t)(t + 1) * kstep;
            const char* a2 = last ? nA : cA + (size_t)(t + 2) * kstep; const char* b2 = last ? nB : cB + (size_t)(t + 2) * kstep;
            const char* a3 = a2 + kstep; const char* b3 = b2 + kstep;
            if (last && has_next) S.a_ready(nxt);
            if constexpr (SP2) {
            PG8_LDB(B0, 0, 0); PG8_LDB(B1, 0, 1); PG8_SCHED; PG8_LDA(At, 0, 0); PG8_STAGE(PG8_SA(1, 1), a1 + hstep, voffA);
            PG8_WAIT_V(8); PG8_WAIT_L(0); PG8_BAR; PG8_MMA(0, 0, At, B0); PG8_MMA(0, 1, At, B1); PG8_BAR; PG8_SCHED;
            PG8_LDA(At, 0, 1); PG8_STAGE(PG8_SB(0, 0), b2, voffB); PG8_STAGE(PG8_SB(0, 1), b2 + hstep, voffB); PG8_STAGE(PG8_SA(0, 0), a2, voffA);
            PG8_WAIT_V(8); PG8_WAIT_L(0); PG8_BAR; PG8_MMA(1, 0, At, B0); PG8_MMA(1, 1, At, B1); PG8_BAR; PG8_SCHED;
            PG8_LDB(B0, 1, 0); PG8_LDB(B1, 1, 1); PG8_SCHED; PG8_LDA(At, 1, 0); PG8_STAGE(PG8_SA(0, 1), a2 + hstep, voffA);
            PG8_WAIT_V(8); PG8_WAIT_L(0); PG8_BAR; PG8_MMA(0, 0, At, B0); PG8_MMA(0, 1, At, B1); PG8_BAR; PG8_SCHED;
            PG8_LDA(At, 1, 1); PG8_STAGE(PG8_SB(1, 0), b3, voffB); PG8_STAGE(PG8_SB(1, 1), b3 + hstep, voffB); PG8_STAGE(PG8_SA(1, 0), a3, voffA);
            PG8_WAIT_V(8); PG8_WAIT_L(0); PG8_BAR; PG8_MMA(1, 0, At, B0); PG8_MMA(1, 1, At, B1); PG8_BAR; PG8_SCHED;
            } else {
            PG8_LDB(B0, 0, 0); PG8_SCHED; PG8_LDA(At, 0, 0); PG8_STAGE(PG8_SA(1, 1), a1 + hstep, voffA);
            PG8_WAIT_L(8); PG8_BAR; PG8_WAIT_L(0); PG8_MMA(0, 0, At, B0); PG8_BAR; PG8_SCHED;
            PG8_LDB(B1, 0, 1); PG8_STAGE(PG8_SB(0, 0), b2, voffB);
            PG8_BAR; PG8_WAIT_L(0); PG8_MMA(0, 1, At, B1); PG8_BAR;
            PG8_LDA(At, 0, 1); PG8_STAGE(PG8_SA(0, 0), a2, voffA);
            PG8_BAR; PG8_WAIT_L(0); PG8_MMA(1, 0, At, B0); PG8_BAR; PG8_SCHED;
            PG8_STAGE(PG8_SB(0, 1), b2 + hstep, voffB);
            PG8_WAIT_V(6); PG8_BAR; PG8_MMA(1, 1, At, B1); PG8_BAR;
            PG8_LDB(B0, 1, 0); PG8_SCHED; PG8_LDA(At, 1, 0); PG8_STAGE(PG8_SA(0, 1), a2 + hstep, voffA);
            PG8_WAIT_L(8); PG8_BAR; PG8_WAIT_L(0); PG8_MMA(0, 0, At, B0); PG8_BAR; PG8_SCHED;
            PG8_LDB(B1, 1, 1); PG8_STAGE(PG8_SB(1, 0), b3, voffB);
            PG8_BAR; PG8_WAIT_L(0); PG8_MMA(0, 1, At, B1); PG8_BAR;
            PG8_LDA(At, 1, 1); PG8_STAGE(PG8_SA(1, 0), a3, voffA);
            PG8_BAR; PG8_WAIT_L(0); PG8_MMA(1, 0, At, B0); PG8_BAR; PG8_SCHED;
            PG8_STAGE(PG8_SB(1, 1), b3 + hstep, voffB);
            PG8_WAIT_V(6); PG8_BAR; PG8_MMA(1, 1, At, B1); PG8_BAR;
            }
        }
        if constexpr (ALIGN_EPI) { if (wr == 0) PG8_BAR; }
        if constexpr (!Epi::AFTER_DRAIN) { E(acc, cur, wr, wc, fr, fq); S.done(cur); }
        if (!has_next) break;
#pragma unroll
        for (int a = 0; a < 2; ++a)
#pragma unroll
            for (int b = 0; b < 2; ++b)
#pragma unroll
                for (int m = 0; m < 4; ++m)
#pragma unroll
                    for (int n = 0; n < 2; ++n) acc[a][b][m][n] = (f32x4){0.f, 0.f, 0.f, 0.f};
        cur = nxt; cA = nA; cB = nB; ++ui;
        if constexpr (ALIGN_EPI) { if (wr == 1) PG8_BAR; }
    }
    PG8_WAIT_V(0);
    if constexpr (!ALIGN_EPI) { if (wr == 0) PG8_BAR; }
    PG8_BAR;
    if constexpr (Epi::AFTER_DRAIN) { E.fused(acc, cur, wr, wc, fr, fq, lds, wid, lane); S.done(cur); }
#undef PG8_SA
#undef PG8_SB
#undef PG8_STAGE
#undef PG8_LDA
#undef PG8_LDB
#undef PG8_MMA
#undef PG8_WAIT_V
#undef PG8_WAIT_L
#undef PG8_BAR
#undef PG8_SCHED
}
}
#define GAS __attribute__((address_space(1)))
#define LAS __attribute__((address_space(3)))
typedef unsigned short bf16;
typedef unsigned v4u __attribute__((ext_vector_type(4)));
typedef float f32x4 __attribute__((ext_vector_type(4)));
typedef short bf16x8 __attribute__((ext_vector_type(8)));
typedef GAS unsigned gu32;
typedef GAS unsigned long long gu64;
#define RLX_AGENT __ATOMIC_RELAXED, __HIP_MEMORY_SCOPE_AGENT
#define LDS_WAIT() asm volatile("s_waitcnt lgkmcnt(0)" ::: "memory")
#define VM_WAIT() asm volatile("s_waitcnt vmcnt(0)" ::: "memory")
__device__ __forceinline__ unsigned long long rt() { return __builtin_amdgcn_s_memrealtime(); }
__device__ __forceinline__ unsigned f2bf(float f) { unsigned u = __builtin_bit_cast(unsigned, f); return (u + 0x7fffu + ((u >> 16) & 1u)) >> 16; }
__device__ __forceinline__ unsigned pk2(float lo, float hi) { return f2bf(lo) | (f2bf(hi) << 16); }

#define XB_TMO      128
#define XB_XCNT(j)  (256  + 64 * (j))
#define XB_XSUB(j)  (1280 + 64 * (j))
#define XB_XGEN(j)  (2304 + 64 * (j))
#define XB_TOP      3328
#define XB_TOPGEN   3392
#define XCD_BAR_WORDS 3456
#define XB_SPIN_CAP (1u << 18)

__device__ __forceinline__ unsigned xb_ld(unsigned* p)              { return __hip_atomic_load(p, __ATOMIC_RELAXED, __HIP_MEMORY_SCOPE_AGENT); }
__device__ __forceinline__ unsigned xb_add(unsigned* p, unsigned v) { return __hip_atomic_fetch_add(p, v, __ATOMIC_RELAXED, __HIP_MEMORY_SCOPE_AGENT); }
__device__ __forceinline__ unsigned xb_xcc_id() { return (unsigned)__builtin_amdgcn_s_getreg((3 << 11) | 20) & 0xFu; }
#define XB_SPIN(cond, bar) do { unsigned _sp = 0; while (cond) { __builtin_amdgcn_s_sleep(1); \
    if ((++_sp & 255u) == 0u) { if (xb_ld(&(bar)[XB_TMO])) break; if (_sp > XB_SPIN_CAP) { atomicAdd(&(bar)[XB_TMO], 1u); break; } } } } while (0)

struct XcdBarrier {
    unsigned* bar; unsigned x;
    volatile LAS unsigned* st;
};

__device__ __forceinline__ XcdBarrier xcd_barrier_post(unsigned* bar, volatile LAS unsigned* st) {
    XcdBarrier b; b.bar = bar; b.x = xb_xcc_id(); b.st = st;
    if (threadIdx.x == 0) (void)xb_add(&bar[XB_XCNT(b.x)], 1u);
    return b;
}
__device__ __forceinline__ void xcd_barrier_complete(unsigned* bar, unsigned x, unsigned& nloc, unsigned& nx) {
    const unsigned G = gridDim.x * gridDim.y * gridDim.z;
    unsigned sum, cnt, mine, sp = 0u;
    for (;;) {
        sum = 0u; cnt = 0u; mine = 0u;
#pragma unroll
        for (unsigned j = 0; j < 16; ++j) { const unsigned c = xb_ld(&bar[XB_XCNT(j)]); sum += c; cnt += (c > 0u) ? 1u : 0u; mine = (j == x) ? c : mine; }
        if (sum == G) break;
        __builtin_amdgcn_s_sleep(1);
        if ((++sp & 255u) == 0u) { if (xb_ld(&bar[XB_TMO])) break; if (sp > XB_SPIN_CAP) { atomicAdd(&bar[XB_TMO], 1u); break; } }
    }
    nloc = mine > 0u ? mine : 1u; nx = cnt > 0u ? cnt : 1u;
}

__device__ __forceinline__ void xcd_barrier(const XcdBarrier& b) {
    asm volatile("s_waitcnt vmcnt(0)" ::: "memory");
    __syncthreads();
    if (threadIdx.x == 0) {
        unsigned* bar = b.bar;
        __builtin_amdgcn_s_waitcnt(0);
        unsigned nloc = b.st[0], nx = b.st[1];
        if (nloc == 0u) { xcd_barrier_complete(bar, b.x, nloc, nx); b.st[0] = nloc; b.st[1] = nx; }
        const unsigned old = xb_add(&bar[XB_XSUB(b.x)], 1u);
        const unsigned gen = old / nloc;
        if (old + 1u == (gen + 1u) * nloc) {
            __builtin_amdgcn_fence(__ATOMIC_RELEASE, "agent");
            asm volatile("s_waitcnt vmcnt(0)" ::: "memory");
            const unsigned og = xb_add(&bar[XB_TOP], 1u);
            const unsigned tg = og / nx;
            if (og + 1u == (tg + 1u) * nx) xb_add(&bar[XB_TOPGEN], 1u);
            else XB_SPIN(xb_ld(&bar[XB_TOPGEN]) == tg, bar);
            __builtin_amdgcn_fence(__ATOMIC_ACQUIRE, "agent");
            xb_add(&bar[XB_XGEN(b.x)], 1u);
            asm volatile("s_waitcnt vmcnt(0)" ::: "memory");
        } else {
            XB_SPIN(xb_ld(&bar[XB_XGEN(b.x)]) == gen, bar);
            __builtin_amdgcn_fence(__ATOMIC_ACQUIRE, "agent");
            asm volatile("s_waitcnt vmcnt(0)" ::: "memory");
        }
    }
    __syncthreads();
}

constexpr int NWAVES = 8;
constexpr int M = 16384, D = 1024, DFF = 2816, INA = 3080, NC = 256;
constexpr float RMS_EPS = 1e-6f;
constexpr float LOG2E = 1.4426950408889634f;
constexpr float QSCALE_A = 0.08838834764831845f;
constexpr float C2 = 0.125f * LOG2E;

constexpr size_t MiB = 1u << 20;
constexpr size_t WS_CTL = 0, CTL_ZERO_BYTES = 1 * MiB;
constexpr size_t WS_SSP = 1 * MiB;
constexpr size_t WS_GATES = WS_SSP + 256 * 1024;
constexpr size_t WS_NST = 2 * MiB;
constexpr size_t WS_CH = WS_NST + 512 * 1024;
constexpr size_t WS_MS = WS_CH + 16 * 1024;
constexpr size_t WS_WGT = WS_MS + 16 * 1024;
constexpr size_t WS_BQ = WS_WGT + 64 * 1024;
constexpr size_t WS_WIN = 3 * MiB;
constexpr size_t WS_WOUT = 15 * MiB;
constexpr size_t WS_WQ2 = 19 * MiB;
constexpr size_t WS_WQ3 = WS_WQ2 + 1280 * 1024 * 2;
constexpr size_t WS_WBO = 24 * MiB;
constexpr size_t WS_WGU = 28 * MiB;
constexpr size_t WS_WD = 72 * MiB;
constexpr size_t WS_XB = 94 * MiB;
constexpr size_t WS_PROJ = 126 * MiB;
constexpr size_t WS_KV = 222 * MiB;
constexpr size_t WS_HG = 230 * MiB;
constexpr size_t WS_STATE = 262 * MiB;
constexpr size_t WS_END = 326 * MiB;
constexpr int CW_BAR = 4096;

constexpr int RING_OFF = 0, RING_BYTES = 131072;
constexpr int LDSCTL_OFF = RING_BYTES, MISC_OFF = LDSCTL_OFF + 320;
constexpr int LDS_BYTES = 147456;

typedef float f32x2 __attribute__((ext_vector_type(2)));
typedef unsigned u32x2 __attribute__((ext_vector_type(2)));
__device__ __forceinline__ float bf2f(unsigned short b) { return __builtin_bit_cast(float, (unsigned)b << 16); }
__device__ __forceinline__ float bflo(unsigned w) { return __builtin_bit_cast(float, w << 16); }
__device__ __forceinline__ float bfhi(unsigned w) { return __builtin_bit_cast(float, w & 0xffff0000u); }
__device__ __forceinline__ float wave_sum(float v) {
#pragma unroll
    for (int o = 1; o < 64; o <<= 1) v += __shfl_xor(v, o);
    return v;
}
__device__ __forceinline__ float rstd_of(const float* ssp, int row) { const f32x4 p = *(const f32x4*)(ssp + (size_t)row * 4); return rsqrtf(((p.x + p.y) + (p.z + p.w)) * (1.f / D) + RMS_EPS); }

struct EpiProj {
    static constexpr bool PERM = true, AFTER_DRAIN = false;
    bf16* O0; int ld0; bf16* O1; int ld1; int split; const float* bias; const float* ssp;
    __device__ __forceinline__ void operator()(const pg8::f32x4 (&acc)[2][2][4][2], const pg8::Unit& u, int wr, int wc, int fr, int fq) const {
        const int row0 = u.pm * 256 + wr * 64 + fr; int colt = u.pn * 256; bf16* base = O0; int ld = ld0;
        if (split && colt >= split) { base = O1; ld = ld1; colt -= split; }
        const int col0 = colt + wc * 32 + 8 * fq, bcol0 = u.pn * 256 + wc * 32 + 8 * fq;
        f32x4 bv[2][2];
#pragma unroll
        for (int bj = 0; bj < 2; ++bj)
#pragma unroll
            for (int n = 0; n < 2; ++n) bv[bj][n] = bias ? *(const f32x4*)(bias + bcol0 + bj * 128 + 4 * n) : (f32x4){0.f, 0.f, 0.f, 0.f};
#pragma unroll
        for (int ai = 0; ai < 2; ++ai)
#pragma unroll
            for (int m = 0; m < 4; ++m) { const int r = row0 + ai * 128 + m * 16; const float rs = rstd_of(ssp, r); bf16* rowp = base + (size_t)r * ld + col0;
#pragma unroll
                for (int bj = 0; bj < 2; ++bj) { const f32x4 v0 = acc[ai][bj][m][0] * rs + bv[bj][0], v1 = acc[ai][bj][m][1] * rs + bv[bj][1];
                    v4u w; w.x = pg8::cvt_pk_bf16(v0[0], v0[1]); w.y = pg8::cvt_pk_bf16(v0[2], v0[3]); w.z = pg8::cvt_pk_bf16(v1[0], v1[1]); w.w = pg8::cvt_pk_bf16(v1[2], v1[3]);
                    *(v4u*)(rowp + bj * 128) = w; } }
    }
};
__device__ __forceinline__ float silu_mul(float g, float u) { return g * __builtin_amdgcn_rcpf(1.f + __builtin_amdgcn_exp2f(-g * LOG2E)) * u; }
struct EpiSwiglu {
    static constexpr bool PERM = true, AFTER_DRAIN = false;
    bf16* H; const float* ssp;
    __device__ __forceinline__ void operator()(const pg8::f32x4 (&acc)[2][2][4][2], const pg8::Unit& u, int wr, int wc, int fr, int fq) const {
        const int row0 = u.pm * 256 + wr * 64 + fr, col0 = u.pn * 128 + wc * 32 + 8 * fq;
#pragma unroll
        for (int ai = 0; ai < 2; ++ai)
#pragma unroll
            for (int m = 0; m < 4; ++m) { const int r = row0 + ai * 128 + m * 16; const float rs = rstd_of(ssp, r);
                const f32x4 g0 = acc[ai][0][m][0] * rs, g1 = acc[ai][0][m][1] * rs, u0 = acc[ai][1][m][0] * rs, u1 = acc[ai][1][m][1] * rs;
                v4u w; w.x = pg8::cvt_pk_bf16(silu_mul(g0[0], u0[0]), silu_mul(g0[1], u0[1])); w.y = pg8::cvt_pk_bf16(silu_mul(g0[2], u0[2]), silu_mul(g0[3], u0[3]));
                w.z = pg8::cvt_pk_bf16(silu_mul(g1[0], u1[0]), silu_mul(g1[1], u1[1])); w.w = pg8::cvt_pk_bf16(silu_mul(g1[2], u1[2]), silu_mul(g1[3], u1[3]));
                *(v4u*)(H + (size_t)r * DFF + col0) = w; }
    }
};
struct EpiResid {
    static constexpr bool PERM = false, AFTER_DRAIN = true;
    const float* base; float* out; bf16* xb; const float* bias; float* ssp;
    __device__ __forceinline__ void fused(pg8::f32x4 (&acc)[2][2][4][2], const pg8::Unit& u, int wr, int wc, int fr, int fq, PG8_LAS unsigned char* lds, int wid, int lane) const {
        PG8_LAS float* P = (PG8_LAS float*)lds;
        const int col0 = u.pn * 256 + wc * 32 + 4 * fq;
#pragma unroll
        for (int ai = 0; ai < 2; ++ai)
#pragma unroll
            for (int m = 0; m < 4; ++m) { const int rl = ai * 128 + wr * 64 + m * 16 + fr; const size_t off = (size_t)(u.pm * 256 + rl) * D + col0; float ss = 0.f;
#pragma unroll
                for (int bj = 0; bj < 2; ++bj)
#pragma unroll
                    for (int n = 0; n < 2; ++n) { const size_t c = off + bj * 128 + n * 16; f32x4 v = *(const f32x4*)(base + c) + acc[ai][bj][m][n];
                        if (bias) v = v + *(const f32x4*)(bias + col0 + bj * 128 + n * 16);
                        *(f32x4*)(out + c) = v; u32x2 w; w.x = pg8::cvt_pk_bf16(v[0], v[1]); w.y = pg8::cvt_pk_bf16(v[2], v[3]); *(u32x2*)(xb + c) = w;
                        ss += (v[0] * v[0] + v[1] * v[1]) + (v[2] * v[2] + v[3] * v[3]); }
                ss += __shfl_xor(ss, 16); ss += __shfl_xor(ss, 32);
                if (fq == 0) P[rl * 4 + wc] = ss;
                if (m & 1) asm volatile("" ::: "memory"); }
        asm volatile("s_waitcnt lgkmcnt(0)" ::: "memory"); __builtin_amdgcn_s_barrier(); asm volatile("" ::: "memory");
        const int tid = wid * 64 + lane;
        if (tid < 256) { const f32x4 p = *(const PG8_LAS f32x4*)(P + tid * 4); ssp[(size_t)(u.pm * 256 + tid) * 4 + u.pn] = (p.x + p.y) + (p.z + p.w); }
        asm volatile("s_waitcnt lgkmcnt(0)" ::: "memory"); __builtin_amdgcn_s_barrier(); asm volatile("" ::: "memory");
    }
};

struct Frame {
    LAS unsigned char* lds;
    volatile LAS unsigned* MISC;
    gu32* ctl;
    int tid, lane, wave;
    int vcu, G;
};
struct Args { const float* in[19]; float* out; unsigned char* ws; };

#define LAUNDER_TID(F) do { int t_ = (F).tid; asm volatile("" : "+v"(t_)); (F).tid = t_; (F).lane = t_ & 63; } while (0)
__device__ __forceinline__ void conv_item(const float* W, int ldw, int K, int nblk, const float* gain, float qscale, int qcols, bf16* WT, int rowmode, int row_off, LAS float* scr, int item, int lane) {
    const int kb = item / nblk, nb = item % nblk, k0 = 64 * kb, n0 = 32 * nb;
    const float ns = (n0 < qcols) ? qscale : 1.f;
#pragma unroll 8
    for (int i = 0; i < 32; ++i) { const int kk = 2 * i + (lane >> 5); const float gk = gain ? gain[k0 + kk] * ns : ns; scr[kk * 33 + (lane & 31)] = W[(size_t)(k0 + kk) * ldw + n0 + (lane & 31)] * gk; }
    LDS_WAIT(); asm volatile("" ::: "memory");
    int rbase;
    if (rowmode == 0) rbase = row_off + n0;
    else { int j = n0, add = 0; if (j >= DFF) { j -= DFF; add = 128; } rbase = 256 * (j / 128) + add + (j % 128); }
    const int c = lane & 7;
#pragma unroll
    for (int j = 0; j < 4; ++j) { const int n = (lane >> 3) + 8 * j; const LAS float* s = scr + (8 * c) * 33 + n;
        v4u o; o.x = pk2(s[0 * 33], s[1 * 33]); o.y = pk2(s[2 * 33], s[3 * 33]); o.z = pk2(s[4 * 33], s[5 * 33]); o.w = pk2(s[6 * 33], s[7 * 33]);
        *(GAS v4u*)(WT + (size_t)(rbase + n) * K + k0 + 8 * c) = o; }
    LDS_WAIT(); asm volatile("" ::: "memory");
}
__device__ __forceinline__ void p0_prologue(Frame& F, const Args& A) {
    LAUNDER_TID(F);
    LAS float* scr = (LAS float*)(F.lds + RING_OFF + F.wave * 16384);
    const int gw = F.vcu * NWAVES + F.wave, NGW = F.G * NWAVES;
    unsigned char* ws = A.ws;
    const float* a_norm = A.in[1]; const float* a_w_in = A.in[2]; const float* a_w_out = A.in[5]; const float* kv_norm = A.in[6]; const float* w_kv = A.in[7]; const float* b_kv = A.in[8];
    const float* b_norm = A.in[9]; const float* b_w_q = A.in[10]; const float* b_b_q = A.in[11]; const float* b_w_out = A.in[13]; const float* ffn_norm = A.in[15];
    const float* w_gate_up = A.in[16]; const float* w_down = A.in[17];
    constexpr int I_IN = 16 * 96, I_SQ = 16 * 32, I_KV = 16 * 8, I_GU = 16 * 176, I_DN = 44 * 32;
    constexpr int NITEMS = 2 * I_IN + 2 * I_SQ + (I_SQ + I_KV + I_SQ) + 2 * I_SQ + 4 * I_GU + 4 * I_DN;
    for (int it = gw; it < NITEMS; it += NGW) {
        int r = it;
        if (r < 2 * I_IN) { const int l = r / I_IN; r -= l * I_IN; conv_item(a_w_in + (size_t)l * D * INA, INA, D, 96, a_norm + l * D, QSCALE_A, 512, (bf16*)(ws + WS_WIN) + (size_t)l * 3072 * D, 0, 0, scr, r, F.lane); continue; } r -= 2 * I_IN;
        if (r < 2 * I_SQ) { const int l = r / I_SQ; r -= l * I_SQ; conv_item(a_w_out + (size_t)l * D * D, D, D, 32, nullptr, 1.f, 0, (bf16*)(ws + WS_WOUT) + (size_t)l * D * D, 0, 0, scr, r, F.lane); continue; } r -= 2 * I_SQ;
        if (r < I_SQ) { conv_item(b_w_q, D, D, 32, b_norm, C2, 1024, (bf16*)(ws + WS_WQ2), 0, 0, scr, r, F.lane); continue; } r -= I_SQ;
        if (r < I_KV) { conv_item(w_kv, 256, D, 8, kv_norm, 1.f, 0, (bf16*)(ws + WS_WQ2), 0, 1024, scr, r, F.lane); continue; } r -= I_KV;
        if (r < I_SQ) { conv_item(b_w_q + (size_t)D * D, D, D, 32, b_norm + D, C2, 1024, (bf16*)(ws + WS_WQ3), 0, 0, scr, r, F.lane); continue; } r -= I_SQ;
        if (r < 2 * I_SQ) { const int l = r / I_SQ; r -= l * I_SQ; conv_item(b_w_out + (size_t)l * D * D, D, D, 32, nullptr, 1.f, 0, (bf16*)(ws + WS_WBO) + (size_t)l * D * D, 0, 0, scr, r, F.lane); continue; } r -= 2 * I_SQ;
        if (r < 4 * I_GU) { const int l = r / I_GU; r -= l * I_GU; conv_item(w_gate_up + (size_t)l * D * 2 * DFF, 2 * DFF, D, 176, ffn_norm + l * D, 1.f, 0, (bf16*)(ws + WS_WGU) + (size_t)l * 2 * DFF * D, 1, 0, scr, r, F.lane); continue; } r -= 4 * I_GU;
        { const int l = r / I_DN; r -= l * I_DN; conv_item(w_down + (size_t)l * DFF * D, D, DFF, 32, nullptr, 1.f, 0, (bf16*)(ws + WS_WD) + (size_t)l * D * DFF, 0, 0, scr, r, F.lane); }
    }
    const float* x = A.in[0]; bf16* XB = (bf16*)(ws + WS_XB); float* SSP = (float*)(ws + WS_SSP);
    for (int m = gw; m < M; m += NGW) {
        const GAS f32x4* xr = (const GAS f32x4*)(x + (size_t)m * D) + F.lane; GAS u32x2* o8 = (GAS u32x2*)(XB + (size_t)m * D) + F.lane; float s = 0.f;
#pragma unroll
        for (int j = 0; j < 4; ++j) { const f32x4 v = xr[64 * j]; s += (v.x * v.x + v.y * v.y) + (v.z * v.z + v.w * v.w); u32x2 w; w.x = pk2(v.x, v.y); w.y = pk2(v.z, v.w); o8[64 * j] = w; }
        s = wave_sum(s);
        if (F.lane == 0) *(f32x4*)(SSP + (size_t)m * 4) = (f32x4){s, 0.f, 0.f, 0.f};
    }
    const int gt = F.vcu * (NWAVES * 64) + F.tid, NGT = F.G * NWAVES * 64;
    float* WGT = (float*)(ws + WS_WGT); float* BQ = (float*)(ws + WS_BQ);
    for (int i = gt; i < 2 * 8 * 1024; i += NGT) { const int l = i >> 13, j = (i >> 10) & 7, k = i & 1023; WGT[i] = a_w_in[(size_t)l * D * INA + (size_t)k * INA + 3072 + j] * a_norm[l * D + k]; }
    for (int i = gt; i < 2 * 1280; i += NGT) { const int l = i / 1280, c = i % 1280; BQ[i] = (c < 1024) ? b_b_q[l * D + c] * C2 : b_kv[c - 1024]; }
}

__device__ __forceinline__ float softcap15(float x) { return 15.f * tanhf(x * (1.f / 15.f)); }
__device__ __forceinline__ float logsigmoidf(float x) { return fminf(x, 0.f) - log1pf(expf(-fabsf(x))); }

__device__ __forceinline__ void gates_phase(Frame& F, const bf16* XB, const float* SSP, const float* WGTl, const float* bgl, float* GATES) {
    LAUNDER_TID(F);
    LAS float* Wl = (LAS float*)(F.lds + RING_OFF);
    for (int i = F.tid; i < 8 * 1024 / 4; i += NWAVES * 64) ((LAS f32x4*)Wl)[i] = ((const f32x4*)WGTl)[i];
    __syncthreads();
    for (int blk = F.vcu; blk < M / 64; blk += F.G) {
#pragma unroll 1
        for (int rr = 0; rr < 8; ++rr) {
            const int row = blk * 64 + F.wave * 8 + rr;
            float acc[8] = {0.f, 0.f, 0.f, 0.f, 0.f, 0.f, 0.f, 0.f};
#pragma unroll
            for (int i = 0; i < 4; ++i) { const int k = 4 * F.lane + 256 * i; const u32x2 xw = *(const u32x2*)(XB + (size_t)row * D + k);
                const float x0 = bflo(xw.x), x1 = bfhi(xw.x), x2 = bflo(xw.y), x3 = bfhi(xw.y);
#pragma unroll
                for (int j = 0; j < 8; ++j) { const f32x4 w = *(const LAS f32x4*)(Wl + j * 1024 + k); acc[j] += (x0 * w.x + x1 * w.y) + (x2 * w.z + x3 * w.w); } }
#pragma unroll
            for (int j = 0; j < 8; ++j) acc[j] = wave_sum(acc[j]);
            if (F.lane < 8) { float a = acc[0];
#pragma unroll
                for (int j = 1; j < 8; ++j) a = (F.lane == j) ? acc[j] : a;
                const float pre = softcap15(a * rstd_of(SSP, row) + bgl[F.lane]);
                GATES[(size_t)row * 8 + F.lane] = (F.lane < 4) ? pre : logsigmoidf(pre); }
        }
    }
    __syncthreads();
}

__device__ __forceinline__ void chunk_gates(Frame& F, const float* GATES, int c, int h, LAS float* bcum, LAS float* aval) {
    if (F.tid < 64) {
        const float lf = GATES[(size_t)(c * 64 + F.tid) * 8 + 4 + h], ig = GATES[(size_t)(c * 64 + F.tid) * 8 + h];
        float s = lf;
#pragma unroll
        for (int o = 1; o < 64; o <<= 1) { const float t = __shfl_up(s, o); if (F.lane >= o) s += t; }
        bcum[F.tid] = s; aval[F.tid] = ig - s;
    }
    __syncthreads();
}

__device__ __forceinline__ void ml_local_phase(Frame& F, const bf16* PROJ, const float* GATES, bf16* STATE, float* NST, float* CH) {
    LAUNDER_TID(F);
    LAS float* bcum = (LAS float*)(F.lds + RING_OFF); LAS float* aval = bcum + 64; LAS float* wsv = aval + 64;
    for (int unit = F.vcu; unit < NC * 4; unit += F.G) {
        const int c = unit >> 2, h = unit & 3;
        chunk_gates(F, GATES, c, h, bcum, aval);
        const float btot = bcum[63]; float amax = -INFINITY;
        for (int s = 0; s < 64; ++s) amax = fmaxf(amax, aval[s]);
        const float mloc = btot + amax;
        if (F.tid < 64) wsv[F.tid] = expf(btot + aval[F.tid] - mloc);
        __syncthreads();
        const bf16* kb = PROJ + (size_t)(c * 64) * 3072 + 512 + h * 128;
        const bf16* vb = PROJ + (size_t)(c * 64) * 3072 + 1024 + h * 256;
        const int v = F.tid >> 1, dh = F.tid & 1;
        float acc[64];
#pragma unroll
        for (int j = 0; j < 64; ++j) acc[j] = 0.f;
#pragma unroll 1
        for (int s = 0; s < 64; ++s) {
            const float wv = wsv[s] * bf2f(vb[(size_t)s * 3072 + v]);
            const v4u* kr = (const v4u*)(kb + (size_t)s * 3072 + dh * 64);
#pragma unroll
            for (int q = 0; q < 8; ++q) { const v4u kk = kr[q];
                acc[q * 8 + 0] += wv * bflo(kk.x); acc[q * 8 + 1] += wv * bfhi(kk.x); acc[q * 8 + 2] += wv * bflo(kk.y); acc[q * 8 + 3] += wv * bfhi(kk.y);
                acc[q * 8 + 4] += wv * bflo(kk.z); acc[q * 8 + 5] += wv * bfhi(kk.z); acc[q * 8 + 6] += wv * bflo(kk.w); acc[q * 8 + 7] += wv * bfhi(kk.w); }
        }
        bf16* st = STATE + ((size_t)(c * 4 + h) * 256 + v) * 128 + dh * 64;
#pragma unroll
        for (int q = 0; q < 8; ++q) { v4u o; o.x = pk2(acc[q * 8 + 0], acc[q * 8 + 1]); o.y = pk2(acc[q * 8 + 2], acc[q * 8 + 3]); o.z = pk2(acc[q * 8 + 4], acc[q * 8 + 5]); o.w = pk2(acc[q * 8 + 6], acc[q * 8 + 7]); *(v4u*)(st + q * 8) = o; }
        if (F.tid < 128) { float a = 0.f; for (int s = 0; s < 64; ++s) a += wsv[s] * bf2f(kb[(size_t)s * 3072 + F.tid]); NST[(size_t)(c * 4 + h) * 128 + F.tid] = a; }
        if (F.tid == 0) { CH[(c * 4 + h) * 2] = btot; CH[(c * 4 + h) * 2 + 1] = mloc; }
        __syncthreads();
    }
}

__device__ __forceinline__ void ml_scan_phase(Frame& F, bf16* STATE, float* NST, const float* CH, float* MS) {
    LAUNDER_TID(F);
    const int e = F.vcu * (NWAVES * 64) + F.tid;
    const int NT = F.G * NWAVES * 64;
    for (int el = e; el < 4 * 32768; el += NT) {
        const int h = el >> 15; bf16* base = STATE + (size_t)h * 32768 + (el & 32767);
        float m = 0.f, Cv = 0.f;
#pragma unroll 1
        for (int c0 = 0; c0 < NC; c0 += 8) {
            unsigned short u[8];
#pragma unroll
            for (int j = 0; j < 8; ++j) u[j] = base[(size_t)(c0 + j) * 131072];
#pragma unroll
            for (int j = 0; j < 8; ++j) { const int c = c0 + j; const float bt = CH[(c * 4 + h) * 2], ml = CH[(c * 4 + h) * 2 + 1];
                const float mn = fmaxf(bt + m, ml); const float f1 = expf(bt + m - mn), f2 = expf(ml - mn);
                base[(size_t)c * 131072] = (unsigned short)f2bf(Cv);
                Cv = f1 * Cv + f2 * bf2f(u[j]); m = mn; }
        }
    }
    if (e < 512) {
        const int h = e >> 7; float* base = NST + e; float m = 0.f, nv = 0.f;
#pragma unroll 1
        for (int c = 0; c < NC; ++c) { const float bt = CH[(c * 4 + h) * 2], ml = CH[(c * 4 + h) * 2 + 1];
            const float mn = fmaxf(bt + m, ml); const float f1 = expf(bt + m - mn), f2 = expf(ml - mn);
            const float u = base[(size_t)c * 512]; base[(size_t)c * 512] = nv; if ((e & 127) == 0) MS[c * 4 + h] = m;
            nv = f1 * nv + f2 * u; m = mn; }
    }
}

__device__ __forceinline__ void ml_out_phase(Frame& F, const bf16* PROJ, const float* GATES, const bf16* STATE, const float* NST, const float* MS, const float* hnorm, bf16* HG) {
    LAUNDER_TID(F);
    LAS float* bcum = (LAS float*)(F.lds + RING_OFF); LAS float* aval = bcum + 64; LAS float* mt = aval + 64; LAS float* et = mt + 64; LAS float* den = et + 64; LAS float* nq = den + 64;
    LAS float* red = nq + 64;
    LAS float* S = red + 64;
    const float scale = 1.f;
    for (int unit = F.vcu; unit < NC * 4; unit += F.G) {
        const int c = unit >> 2, h = unit & 3;
        chunk_gates(F, GATES, c, h, bcum, aval);
        const float mc = MS[c * 4 + h];
        if (F.tid < 64) { float am = -INFINITY; for (int s = 0; s <= F.tid; ++s) am = fmaxf(am, aval[s]); const float m_t = bcum[F.tid] + fmaxf(mc, am); mt[F.tid] = m_t; et[F.tid] = expf(bcum[F.tid] + mc - m_t); }
        __syncthreads();
        const bf16* qb = PROJ + (size_t)(c * 64) * 3072 + h * 128;
        const bf16* kb = PROJ + (size_t)(c * 64) * 3072 + 512 + h * 128;
        const bf16* vb = PROJ + (size_t)(c * 64) * 3072 + 1024 + h * 256;
        {
            const int t = F.tid >> 3;
#pragma unroll 1
            for (int j = 0; j < 8; ++j) { const int s = (F.tid & 7) * 8 + j; float a = 0.f;
                if (s <= t) { const v4u* qr = (const v4u*)(qb + (size_t)t * 3072); const v4u* kr = (const v4u*)(kb + (size_t)s * 3072);
#pragma unroll 4
                    for (int q = 0; q < 16; ++q) { const v4u a4 = qr[q], b4 = kr[q];
                        a += bflo(a4.x) * bflo(b4.x) + bfhi(a4.x) * bfhi(b4.x) + bflo(a4.y) * bflo(b4.y) + bfhi(a4.y) * bfhi(b4.y) + bflo(a4.z) * bflo(b4.z) + bfhi(a4.z) * bfhi(b4.z) + bflo(a4.w) * bflo(b4.w) + bfhi(a4.w) * bfhi(b4.w); }
                    a *= scale * expf(bcum[t] + aval[s] - mt[t]); }
                S[t * 65 + s] = a; }
        }
        if (F.tid < 64) { float a = 0.f; const float* nn = NST + (size_t)(c * 4 + h) * 128; for (int d = 0; d < 128; ++d) a += nn[d] * bf2f(qb[(size_t)F.tid * 3072 + d]); nq[F.tid] = a * scale; }
        __syncthreads();
        if (F.tid < 64) { float a = 0.f; for (int s = 0; s < 64; ++s) a += S[F.tid * 65 + s]; a += et[F.tid] * nq[F.tid]; den[F.tid] = fmaxf(fabsf(a), expf(-mt[F.tid])); }
        __syncthreads();
        const int v = F.tid & 255, th = F.tid >> 8;
        v4u Cc[16];
        { const v4u* st = (const v4u*)(STATE + ((size_t)(c * 4 + h) * 256 + v) * 128);
#pragma unroll
          for (int q = 0; q < 16; ++q) Cc[q] = st[q]; }
        const float gain = hnorm[h * 256 + v];
#pragma unroll 1
        for (int tt = 0; tt < 32; ++tt) {
            const int t = th * 32 + tt;
            float a = 0.f;
            for (int s = 0; s <= t; ++s) a += S[t * 65 + s] * bf2f(vb[(size_t)s * 3072 + v]);
            float b = 0.f; const v4u* qr = (const v4u*)(qb + (size_t)t * 3072);
#pragma unroll
            for (int q = 0; q < 16; ++q) { const v4u a4 = qr[q], b4 = Cc[q];
                b += bflo(a4.x) * bflo(b4.x) + bfhi(a4.x) * bfhi(b4.x) + bflo(a4.y) * bflo(b4.y) + bfhi(a4.y) * bfhi(b4.y) + bflo(a4.z) * bflo(b4.z) + bfhi(a4.z) * bfhi(b4.z) + bflo(a4.w) * bflo(b4.w) + bfhi(a4.w) * bfhi(b4.w); }
            const float hv = (a + et[t] * scale * b) / den[t];
            const float ss = wave_sum(hv * hv);
            __syncthreads();
            if (F.lane == 0) red[F.wave] = ss;
            __syncthreads();
            const float tot = (red[th * 4] + red[th * 4 + 1]) + (red[th * 4 + 2] + red[th * 4 + 3]);
            const float r = rsqrtf(tot * (1.f / 256.f) + RMS_EPS);
            const size_t row = (size_t)(c * 64 + t);
            const float o = bf2f(PROJ[row * 3072 + 2048 + h * 256 + v]);
            HG[row * D + h * 256 + v] = (bf16)f2bf(hv * r * gain / (1.f + expf(-o)));
        }
        __syncthreads();
    }
}

__device__ __forceinline__ void attn_phase(Frame& F, const bf16* Q, const bf16* KV, const float* sinks, bf16* O) {
    LAUNDER_TID(F);
    for (int unit = F.vcu; unit < 128 * 16; unit += F.G) {
        const int nb = unit >> 4, head = unit & 15, kvh = head >> 3;
        const int i = F.tid >> 2, part = F.tid & 3;
        const int qpos = nb * 128 + i;
        float q[16], o[16];
        { const v4u* qr = (const v4u*)(Q + (size_t)qpos * D + head * 64 + part * 16);
#pragma unroll
          for (int w = 0; w < 2; ++w) { const v4u a = qr[w]; q[w * 8 + 0] = bflo(a.x); q[w * 8 + 1] = bfhi(a.x); q[w * 8 + 2] = bflo(a.y); q[w * 8 + 3] = bfhi(a.y); q[w * 8 + 4] = bflo(a.z); q[w * 8 + 5] = bfhi(a.z); q[w * 8 + 6] = bflo(a.w); q[w * 8 + 7] = bfhi(a.w); } }
        float m = sinks[head] * LOG2E, l = 1.f;
#pragma unroll
        for (int d = 0; d < 16; ++d) o[d] = 0.f;
        const int j0 = (nb == 0) ? 128 : 0;
#pragma unroll 1
        for (int j = j0; j < 256; ++j) {
            const int kpos = (nb - 1) * 128 + j;
            const int rel = i + 128 - j;
            const bool valid = (rel >= 0) && (rel < 128);
            const v4u* kr = (const v4u*)(KV + (size_t)kpos * 256 + kvh * 64 + part * 16);
            const v4u* vr = (const v4u*)(KV + (size_t)kpos * 256 + 128 + kvh * 64 + part * 16);
            float kf[16], vf[16];
#pragma unroll
            for (int w = 0; w < 2; ++w) { const v4u a = kr[w]; kf[w * 8 + 0] = bflo(a.x); kf[w * 8 + 1] = bfhi(a.x); kf[w * 8 + 2] = bflo(a.y); kf[w * 8 + 3] = bfhi(a.y); kf[w * 8 + 4] = bflo(a.z); kf[w * 8 + 5] = bfhi(a.z); kf[w * 8 + 6] = bflo(a.w); kf[w * 8 + 7] = bfhi(a.w);
                const v4u b = vr[w]; vf[w * 8 + 0] = bflo(b.x); vf[w * 8 + 1] = bfhi(b.x); vf[w * 8 + 2] = bflo(b.y); vf[w * 8 + 3] = bfhi(b.y); vf[w * 8 + 4] = bflo(b.z); vf[w * 8 + 5] = bfhi(b.z); vf[w * 8 + 6] = bflo(b.w); vf[w * 8 + 7] = bfhi(b.w); }
            float s = 0.f;
#pragma unroll
            for (int d = 0; d < 16; ++d) s += q[d] * kf[d];
            s += __shfl_xor(s, 1); s += __shfl_xor(s, 2);
            if (valid) {
                const float mn = fmaxf(m, s), corr = __builtin_amdgcn_exp2f(m - mn), p = __builtin_amdgcn_exp2f(s - mn);
                l = l * corr + p;
#pragma unroll
                for (int d = 0; d < 16; ++d) o[d] = o[d] * corr + p * vf[d];
                m = mn;
            }
        }
        const float inv = 1.f / l;
        v4u w0, w1;
        w0.x = pk2(o[0] * inv, o[1] * inv); w0.y = pk2(o[2] * inv, o[3] * inv); w0.z = pk2(o[4] * inv, o[5] * inv); w0.w = pk2(o[6] * inv, o[7] * inv);
        w1.x = pk2(o[8] * inv, o[9] * inv); w1.y = pk2(o[10] * inv, o[11] * inv); w1.z = pk2(o[12] * inv, o[13] * inv); w1.w = pk2(o[14] * inv, o[15] * inv);
        v4u* op = (v4u*)(O + (size_t)qpos * D + head * 64 + part * 16); op[0] = w0; op[1] = w1;
    }
}

__device__ __forceinline__ void final_norm_phase(Frame& F, float* X, const float* SSP, const float* g) {
    LAUNDER_TID(F);
    const int gw = F.vcu * NWAVES + F.wave, NGW = F.G * NWAVES;
    for (int m = gw; m < M; m += NGW) {
        const float rs = rstd_of(SSP, m);
        GAS f32x4* xr = (GAS f32x4*)(X + (size_t)m * D) + F.lane; const f32x4* gg = (const f32x4*)g + F.lane;
#pragma unroll
        for (int j = 0; j < 4; ++j) { const f32x4 v = xr[64 * j], w = gg[64 * j]; xr[64 * j] = v * rs * w; }
    }
}


typedef float f32x16 __attribute__((ext_vector_type(16)));
typedef short s16x4 __attribute__((ext_vector_type(4)));
typedef short v4i16_t __attribute__((ext_vector_type(4)));
__device__ __forceinline__ s16x4 tr16(const LAS unsigned char* p) { return __builtin_bit_cast(s16x4, __builtin_amdgcn_ds_read_tr16_b64_v4i16((LAS v4i16_t*)p)); }
__device__ __forceinline__ bf16x8 cat8(s16x4 a, s16x4 b) { return (bf16x8){a[0], a[1], a[2], a[3], b[0], b[1], b[2], b[3]}; }
__device__ __forceinline__ unsigned cvtpk(float lo, float hi) { return pg8::cvt_pk_bf16(lo, hi); }
__device__ __forceinline__ bf16x8 pack8(const f32x16& p, int s) {
    v4u w; w.x = cvtpk(p[8 * s + 0], p[8 * s + 1]); w.y = cvtpk(p[8 * s + 2], p[8 * s + 3]); w.z = cvtpk(p[8 * s + 4], p[8 * s + 5]); w.w = cvtpk(p[8 * s + 6], p[8 * s + 7]);
    return __builtin_bit_cast(bf16x8, w);
}
#define MFMA32(a, b, c) __builtin_amdgcn_mfma_f32_32x32x16_bf16((a), (b), (c), 0, 0, 0)
#define CROW(r, hi) (((r) & 3) + 8 * ((r) >> 2) + 4 * (hi))

__device__ __forceinline__ void attn_phase_mfma(Frame& F, const bf16* Q, const bf16* KV, const float* sinks, bf16* O) {
    LAUNDER_TID(F);
    LAS unsigned char* Kl = F.lds + RING_OFF;
    LAS unsigned char* Vl = Kl + 32768;
    const int lane = F.lane, r32 = lane & 31, hi = lane >> 5;
    for (int unit = F.vcu; unit < 256; unit += F.G) {
        const int nb = unit >> 1, kvh = unit & 1, head = kvh * 8 + F.wave;
#pragma unroll
        for (int i = 0; i < 4; ++i) { const int p = F.tid + 512 * i, key = p >> 3, c = p & 7, kpos = (nb - 1) * 128 + key;
            if (kpos >= 0) { const v4u kk = *(const v4u*)(KV + (size_t)kpos * 256 + kvh * 64 + c * 8); const v4u vv = *(const v4u*)(KV + (size_t)kpos * 256 + 128 + kvh * 64 + c * 8);
                *(LAS v4u*)(Kl + key * 128 + ((c ^ ((key >> 1) & 7)) << 4)) = kk; *(LAS v4u*)(Vl + (c >> 2) * 16384 + key * 64 + (c & 3) * 16) = vv; } }
        __syncthreads();
        const float sk = sinks[head] * LOG2E;
#pragma unroll 1
        for (int qb = 0; qb < 4; ++qb) {
            const int qpos = nb * 128 + qb * 32 + r32;
            bf16x8 qf[4];
#pragma unroll
            for (int kk = 0; kk < 4; ++kk) qf[kk] = *(const bf16x8*)(Q + (size_t)qpos * D + head * 64 + kk * 16 + hi * 8);
            f32x16 sacc[5];
#pragma unroll
            for (int t = 0; t < 5; ++t) {
#pragma unroll
                for (int r = 0; r < 16; ++r) sacc[t][r] = 0.f;
                if (nb > 0 || qb + t >= 4) { const int key = (qb + t) * 32 + r32;
#pragma unroll
                    for (int kk = 0; kk < 4; ++kk) { const int c = 2 * kk + hi; const bf16x8 kf = *(const LAS bf16x8*)(Kl + key * 128 + ((c ^ ((key >> 1) & 7)) << 4)); sacc[t] = MFMA32(kf, qf[kk], sacc[t]); } }
            }
            float mx = sk;
#pragma unroll
            for (int t = 0; t < 5; ++t) { const bool live = (nb > 0 || qb + t >= 4);
#pragma unroll
                for (int r = 0; r < 16; ++r) { const int cr = CROW(r, hi); bool valid = live; if (t == 0) valid = valid && (cr > r32); if (t == 4) valid = valid && (cr <= r32);
                    const float s = valid ? sacc[t][r] : -INFINITY; sacc[t][r] = s; mx = fmaxf(mx, s); } }
            mx = fmaxf(mx, __shfl_xor(mx, 32));
            float l = 0.f;
#pragma unroll
            for (int t = 0; t < 5; ++t)
#pragma unroll
                for (int r = 0; r < 16; ++r) { const float p = __builtin_amdgcn_exp2f(sacc[t][r] - mx); sacc[t][r] = p; l += p; }
            l += __shfl_xor(l, 32); l += __builtin_amdgcn_exp2f(sk - mx);
            f32x16 oacc[2];
#pragma unroll
            for (int r = 0; r < 16; ++r) { oacc[0][r] = 0.f; oacc[1][r] = 0.f; }
#pragma unroll
            for (int t = 0; t < 5; ++t) if (nb > 0 || qb + t >= 4) {
#pragma unroll
                for (int s = 0; s < 2; ++s) { const bf16x8 pf = pack8(sacc[t], s);
#pragma unroll
                    for (int dt = 0; dt < 2; ++dt) { const LAS unsigned char* vp = Vl + dt * 16384 + ((qb + t) * 32 + 16 * s + 4 * hi + ((lane & 15) >> 2)) * 64 + ((lane >> 4) & 1) * 32 + (lane & 3) * 8;
                        const bf16x8 vf = cat8(tr16(vp), tr16(vp + 8 * 64)); oacc[dt] = MFMA32(vf, pf, oacc[dt]); } } }
            const float inv = 1.f / l;
            bf16* orow = O + (size_t)qpos * D + head * 64 + 4 * hi;
#pragma unroll
            for (int dt = 0; dt < 2; ++dt)
#pragma unroll
                for (int gq = 0; gq < 4; ++gq) { u32x2 w; w.x = cvtpk(oacc[dt][4 * gq] * inv, oacc[dt][4 * gq + 1] * inv); w.y = cvtpk(oacc[dt][4 * gq + 2] * inv, oacc[dt][4 * gq + 3] * inv);
                    *(u32x2*)(orow + 32 * dt + 8 * gq) = w; }
        }
        __syncthreads();
    }
}

__device__ __forceinline__ void ml_local_phase_mfma(Frame& F, const bf16* PROJ, const float* GATES, bf16* STATE, float* NST, float* CH) {
    LAUNDER_TID(F);
    LAS unsigned char* Kl = F.lds + RING_OFF;
    LAS unsigned char* Vl = Kl + 16384;
    LAS float* bcum = (LAS float*)(Vl + 32768); LAS float* aval = bcum + 64; LAS float* wsv = aval + 64;
    const int lane = F.lane, r32 = lane & 31, hi = lane >> 5;
    for (int unit = F.vcu; unit < NC * 4; unit += F.G) {
        const int c = unit >> 2, h = unit & 3;
        chunk_gates(F, GATES, c, h, bcum, aval);
        const float btot = bcum[63]; float amax = -INFINITY;
        for (int s = 0; s < 64; ++s) amax = fmaxf(amax, aval[s]);
        const float mloc = btot + amax;
        if (F.tid < 64) wsv[F.tid] = expf(btot + aval[F.tid] - mloc);
        __syncthreads();
        const bf16* kb = PROJ + (size_t)(c * 64) * 3072 + 512 + h * 128;
        const bf16* vb = PROJ + (size_t)(c * 64) * 3072 + 1024 + h * 256;
#pragma unroll
        for (int i = 0; i < 2; ++i) { const int p = F.tid + 512 * i, s = p >> 4, cc = p & 15; const v4u kk = *(const v4u*)(kb + (size_t)s * 3072 + cc * 8); const float w = wsv[s];
            v4u o; o.x = pk2(bflo(kk.x) * w, bfhi(kk.x) * w); o.y = pk2(bflo(kk.y) * w, bfhi(kk.y) * w); o.z = pk2(bflo(kk.z) * w, bfhi(kk.z) * w); o.w = pk2(bflo(kk.w) * w, bfhi(kk.w) * w);
            *(LAS v4u*)(Kl + (cc >> 2) * 4096 + s * 64 + (cc & 3) * 16) = o; }
#pragma unroll
        for (int i = 0; i < 4; ++i) { const int p = F.tid + 512 * i, s = p >> 5, cc = p & 31; const v4u vv = *(const v4u*)(vb + (size_t)s * 3072 + cc * 8);
            *(LAS v4u*)(Vl + (cc >> 2) * 4096 + s * 64 + (cc & 3) * 16) = vv; }
        if (F.tid < 128) { float a = 0.f; for (int s = 0; s < 64; ++s) a += wsv[s] * bf2f(kb[(size_t)s * 3072 + F.tid]); NST[(size_t)(c * 4 + h) * 128 + F.tid] = a; }
        if (F.tid == 0) { CH[(c * 4 + h) * 2] = btot; CH[(c * 4 + h) * 2 + 1] = mloc; }
        __syncthreads();
        f32x16 acc[4];
#pragma unroll
        for (int dt = 0; dt < 4; ++dt)
#pragma unroll
            for (int r = 0; r < 16; ++r) acc[dt][r] = 0.f;
        const int troff = (4 * hi + ((lane & 15) >> 2)) * 64 + ((lane >> 4) & 1) * 32 + (lane & 3) * 8;
#pragma unroll
        for (int ks = 0; ks < 4; ++ks) {
            const LAS unsigned char* vp = Vl + F.wave * 4096 + ks * 16 * 64 + troff;
            const bf16x8 vf = cat8(tr16(vp), tr16(vp + 8 * 64));
#pragma unroll
            for (int dt = 0; dt < 4; ++dt) { const LAS unsigned char* kp = Kl + dt * 4096 + ks * 16 * 64 + troff;
                const bf16x8 kf = cat8(tr16(kp), tr16(kp + 8 * 64));
                acc[dt] = MFMA32(kf, vf, acc[dt]); }
        }
        bf16* st = STATE + ((size_t)(c * 4 + h) * 256 + F.wave * 32 + r32) * 128 + 4 * hi;
#pragma unroll
        for (int dt = 0; dt < 4; ++dt)
#pragma unroll
            for (int gq = 0; gq < 4; ++gq) { u32x2 w; w.x = cvtpk(acc[dt][4 * gq], acc[dt][4 * gq + 1]); w.y = cvtpk(acc[dt][4 * gq + 2], acc[dt][4 * gq + 3]); *(u32x2*)(st + 32 * dt + 8 * gq) = w; }
        __syncthreads();
    }
}

__device__ __forceinline__ void ml_out_phase_mfma(Frame& F, const bf16* PROJ, const float* GATES, const bf16* STATE, const float* NST, const float* MS, const float* hnorm, bf16* HG) {
    LAUNDER_TID(F);
    LAS unsigned char* Vl = F.lds + RING_OFF;
    LAS float* bcum = (LAS float*)(Vl + 32768); LAS float* aval = bcum + 64; LAS float* mt = aval + 64; LAS float* et = mt + 64; LAS float* nst = et + 64  ; LAS float* red = nst + 128  ;
    const int lane = F.lane, r32 = lane & 31, hi = lane >> 5, tb = F.wave >> 2, vq = F.wave & 3;
    for (int unit = F.vcu; unit < NC * 4; unit += F.G) {
        const int c = unit >> 2, h = unit & 3;
        const float mc = MS[c * 4 + h];
        if (F.tid < 64) {
            const float lf = GATES[(size_t)(c * 64 + F.tid) * 8 + 4 + h], ig = GATES[(size_t)(c * 64 + F.tid) * 8 + h];
            float s = lf;
#pragma unroll
            for (int o = 1; o < 64; o <<= 1) { const float t = __shfl_up(s, o); if (lane >= o) s += t; }
            const float a = ig - s; float am = a;
#pragma unroll
            for (int o = 1; o < 64; o <<= 1) { const float t = __shfl_up(am, o); if (lane >= o) am = fmaxf(am, t); }
            const float m_t = s + fmaxf(mc, am);
            bcum[F.tid] = s; aval[F.tid] = a; mt[F.tid] = m_t; et[F.tid] = expf(s + mc - m_t);
        }
        if (F.tid >= 64 && F.tid < 192) nst[F.tid - 64] = NST[(size_t)(c * 4 + h) * 128 + F.tid - 64];
        const bf16* qb = PROJ + (size_t)(c * 64) * 3072 + h * 128;
        const bf16* kb = PROJ + (size_t)(c * 64) * 3072 + 512 + h * 128;
        const bf16* vb = PROJ + (size_t)(c * 64) * 3072 + 1024 + h * 256;
#pragma unroll
        for (int i = 0; i < 4; ++i) { const int p = F.tid + 512 * i, s = p >> 5, cc = p & 31; const v4u vv = *(const v4u*)(vb + (size_t)s * 3072 + cc * 8);
            *(LAS v4u*)(Vl + (cc >> 2) * 4096 + s * 64 + (cc & 3) * 16) = vv; }
        const int t = tb * 32 + r32;
        bf16x8 qf[8];
#pragma unroll
        for (int kk = 0; kk < 8; ++kk) qf[kk] = *(const bf16x8*)(qb + (size_t)t * 3072 + kk * 16 + hi * 8);
        f32x16 sacc[2];
#pragma unroll
        for (int sb = 0; sb < 2; ++sb) {
#pragma unroll
            for (int r = 0; r < 16; ++r) sacc[sb][r] = 0.f;
            if (sb <= tb) {
#pragma unroll
                for (int kk = 0; kk < 8; ++kk) { const bf16x8 kf = *(const bf16x8*)(kb + (size_t)(sb * 32 + r32) * 3072 + kk * 16 + hi * 8); sacc[sb] = MFMA32(kf, qf[kk], sacc[sb]); } }
        }
        __syncthreads();
        const float b_t = bcum[t], m_t = mt[t], e_t = et[t];
        float dsum = 0.f;
#pragma unroll
        for (int sb = 0; sb < 2; ++sb)
#pragma unroll
            for (int gq = 0; gq < 4; ++gq) { const f32x4 a4 = *(const LAS f32x4*)(aval + sb * 32 + 8 * gq + 4 * hi);
#pragma unroll
                for (int i = 0; i < 4; ++i) { const int r = 4 * gq + i, cr = 8 * gq + 4 * hi + i; const bool valid = (sb < tb) || (sb == tb && cr <= r32);
                    const float w = valid ? sacc[sb][r] * expf(b_t + a4[i] - m_t) : 0.f; sacc[sb][r] = w; dsum += w; } }
        float nq = 0.f;
#pragma unroll
        for (int kk = 0; kk < 8; ++kk) { const v4u qw = __builtin_bit_cast(v4u, qf[kk]); const f32x4 n0 = *(const LAS f32x4*)(nst + kk * 16 + hi * 8), n1 = *(const LAS f32x4*)(nst + kk * 16 + hi * 8 + 4);
            nq += (bflo(qw.x) * n0.x + bfhi(qw.x) * n0.y) + (bflo(qw.y) * n0.z + bfhi(qw.y) * n0.w) + (bflo(qw.z) * n1.x + bfhi(qw.z) * n1.y) + (bflo(qw.w) * n1.z + bfhi(qw.w) * n1.w); }
        dsum += __shfl_xor(dsum, 32); nq += __shfl_xor(nq, 32);
        const float dd = fmaxf(fabsf(dsum + e_t * nq), expf(-m_t));
        const float dinv = 1.f / dd;
        f32x16 hacc[2];
        const int troff = (4 * hi + ((lane & 15) >> 2)) * 64 + ((lane >> 4) & 1) * 32 + (lane & 3) * 8;
        float ss = 0.f;
#pragma unroll
        for (int vt = 0; vt < 2; ++vt) {
            f32x16 ia, xa;
#pragma unroll
            for (int r = 0; r < 16; ++r) { ia[r] = 0.f; xa[r] = 0.f; }
#pragma unroll
            for (int sb = 0; sb < 2; ++sb) if (sb <= tb) {
#pragma unroll
                for (int s16 = 0; s16 < 2; ++s16) { const LAS unsigned char* vp = Vl + (vq * 2 + vt) * 4096 + (sb * 32 + s16 * 16) * 64 + troff;
                    const bf16x8 vf = cat8(tr16(vp), tr16(vp + 8 * 64)); ia = MFMA32(vf, pack8(sacc[sb], s16), ia); } }
            const bf16* cb = STATE + ((size_t)(c * 4 + h) * 256 + vq * 64 + vt * 32 + r32) * 128 + hi * 8;
#pragma unroll
            for (int kk = 0; kk < 8; ++kk) { const bf16x8 cf = *(const bf16x8*)(cb + kk * 16); xa = MFMA32(cf, qf[kk], xa); }
#pragma unroll
            for (int r = 0; r < 16; ++r) { const float hv = (ia[r] + e_t * xa[r]) * dinv; hacc[vt][r] = hv; ss += hv * hv; }
        }
        ss += __shfl_xor(ss, 32);
        if (hi == 0) red[(tb * 4 + vq) * 32 + r32] = ss;
        __syncthreads();
        const float tot = (red[(tb * 4 + 0) * 32 + r32] + red[(tb * 4 + 1) * 32 + r32]) + (red[(tb * 4 + 2) * 32 + r32] + red[(tb * 4 + 3) * 32 + r32]);
        const float rn = rsqrtf(tot * (1.f / 256.f) + RMS_EPS);
        const size_t row = (size_t)(c * 64 + t);
#pragma unroll
        for (int vt = 0; vt < 2; ++vt)
#pragma unroll
            for (int gq = 0; gq < 4; ++gq) { const int v0 = h * 256 + vq * 64 + vt * 32 + 8 * gq + 4 * hi;
                const f32x4 gn = *(const f32x4*)(hnorm + v0); const u32x2 ow = *(const u32x2*)(PROJ + row * 3072 + 2048 + v0);
                const float o0 = bflo(ow.x), o1 = bfhi(ow.x), o2 = bflo(ow.y), o3 = bfhi(ow.y);
                const float y0 = hacc[vt][4 * gq] * rn * gn.x / (1.f + expf(-o0)), y1 = hacc[vt][4 * gq + 1] * rn * gn.y / (1.f + expf(-o1));
                const float y2 = hacc[vt][4 * gq + 2] * rn * gn.z / (1.f + expf(-o2)), y3 = hacc[vt][4 * gq + 3] * rn * gn.w / (1.f + expf(-o3));
                u32x2 w; w.x = cvtpk(y0, y1); w.y = cvtpk(y2, y3); *(u32x2*)(HG + row * D + v0) = w; }
        __syncthreads();
    }
}

#ifndef ATTN_MFMA
#define ATTN_MFMA 1
#endif
#ifndef MLL_MFMA
#define MLL_MFMA 1
#endif
#ifndef MLO_MFMA
#define MLO_MFMA 1
#endif
#ifndef PG8_SP2
#define PG8_SP2 true
#endif
#ifndef PG8_ALIGN
#define PG8_ALIGN true
#endif
__global__ void __launch_bounds__(NWAVES * 64, 2) yoco_fwd(Args args) {
    extern __shared__ __attribute__((aligned(16))) unsigned char lds[];
    Frame F;
    F.lds = (LAS unsigned char*)lds;
    F.MISC = (volatile LAS unsigned*)(F.lds + MISC_OFF);
    F.tid = threadIdx.x; F.lane = F.tid & 63; F.wave = __builtin_amdgcn_readfirstlane(F.tid >> 6);
    F.G = gridDim.x; { const int bx = blockIdx.x; F.vcu = (F.G % 8 == 0) ? (bx % 8) * (F.G / 8) + bx / 8 : bx; }
    unsigned char* ws = args.ws;
    F.ctl = (gu32*)(ws + WS_CTL);
    for (int u = F.tid; u < (LDS_BYTES - LDSCTL_OFF) / 4; u += NWAVES * 64) ((LAS unsigned*)(F.lds + LDSCTL_OFF))[u] = 0u;
    __syncthreads();
    XcdBarrier bar = xcd_barrier_post((unsigned*)(F.ctl + CW_BAR), F.MISC + 8);
#define GRID_BAR() xcd_barrier(bar)

    float* X = args.out;
    float* SSP = (float*)(ws + WS_SSP); float* GATES = (float*)(ws + WS_GATES); float* NST = (float*)(ws + WS_NST); float* CH = (float*)(ws + WS_CH); float* MS = (float*)(ws + WS_MS);
    bf16* XB = (bf16*)(ws + WS_XB); bf16* PROJ = (bf16*)(ws + WS_PROJ); bf16* KVb = (bf16*)(ws + WS_KV); bf16* HG = (bf16*)(ws + WS_HG); bf16* STATE = (bf16*)(ws + WS_STATE);
    bf16* Hb = PROJ; bf16* Qb = PROJ;

    p0_prologue(F, args);
    GRID_BAR();

    for (int l = 0; l < 4; ++l) {
        const float* resid_base = (l == 0) ? args.in[0] : X;
        if (l < 2) {
            {
                pg8::Gemm g{XB, (const bf16*)(ws + WS_WIN) + (size_t)l * 3072 * D, M, 3072, D}; pg8::StaticOrder S; S.init(M, 3072, F.G, (int)blockIdx.x);
                EpiProj E{PROJ, 3072, PROJ, 3072, 0, nullptr, SSP};
                pg8::gemm_phase<EpiProj, pg8::StaticOrder, PG8_ALIGN, PG8_SP2>(F.lds + RING_OFF, g, S, E);
                gates_phase(F, XB, SSP, (const float*)(ws + WS_WGT) + l * 8 * 1024, args.in[3] + l * 8, GATES);
            }
            GRID_BAR();
#if MLL_MFMA
            ml_local_phase_mfma(F, PROJ, GATES, STATE, NST, CH);
#else
            ml_local_phase(F, PROJ, GATES, STATE, NST, CH);
#endif
            GRID_BAR();
            ml_scan_phase(F, STATE, NST, CH, MS);
            GRID_BAR();
#if MLO_MFMA
            ml_out_phase_mfma(F, PROJ, GATES, STATE, NST, MS, args.in[4] + l * D, HG);
#else
            ml_out_phase(F, PROJ, GATES, STATE, NST, MS, args.in[4] + l * D, HG);
#endif
            GRID_BAR();
            {
                pg8::Gemm g{HG, (const bf16*)(ws + WS_WOUT) + (size_t)l * D * D, M, D, D}; pg8::StaticOrder S; S.init(M, D, F.G, (int)blockIdx.x);
                EpiResid E{resid_base, X, XB, nullptr, SSP};
                pg8::gemm_phase<EpiResid, pg8::StaticOrder, false, PG8_SP2>(F.lds + RING_OFF, g, S, E);
            }
            GRID_BAR();
        } else {
            const int j = l - 2;
            {
                const int N = (j == 0) ? 1280 : 1024;
                pg8::Gemm g{XB, (const bf16*)(ws + (j == 0 ? WS_WQ2 : WS_WQ3)), M, N, D}; pg8::StaticOrder S; S.init(M, N, F.G, (int)blockIdx.x);
                EpiProj E{Qb, D, KVb, 256, 1024, (const float*)(ws + WS_BQ) + j * 1280, SSP};
                pg8::gemm_phase<EpiProj, pg8::StaticOrder, PG8_ALIGN, PG8_SP2>(F.lds + RING_OFF, g, S, E);
            }
            GRID_BAR();
#if ATTN_MFMA
            attn_phase_mfma(F, Qb, KVb, args.in[12] + j * 16, HG);
#else
            attn_phase(F, Qb, KVb, args.in[12] + j * 16, HG);
#endif
            GRID_BAR();
            {
                pg8::Gemm g{HG, (const bf16*)(ws + WS_WBO) + (size_t)j * D * D, M, D, D}; pg8::StaticOrder S; S.init(M, D, F.G, (int)blockIdx.x);
                EpiResid E{resid_base, X, XB, args.in[14] + j * D, SSP};
                pg8::gemm_phase<EpiResid, pg8::StaticOrder, false, PG8_SP2>(F.lds + RING_OFF, g, S, E);
            }
            GRID_BAR();
        }
        {
            pg8::Gemm g{XB, (const bf16*)(ws + WS_WGU) + (size_t)l * 2 * DFF * D, M, 2 * DFF, D}; pg8::StaticOrder S; S.init(M, 2 * DFF, F.G, (int)blockIdx.x);
            EpiSwiglu E{Hb, SSP};
            pg8::gemm_phase<EpiSwiglu, pg8::StaticOrder, PG8_ALIGN, PG8_SP2>(F.lds + RING_OFF, g, S, E);
        }
        GRID_BAR();
        {
            pg8::Gemm g{Hb, (const bf16*)(ws + WS_WD) + (size_t)l * D * DFF, M, D, DFF}; pg8::StaticOrder S; S.init(M, D, F.G, (int)blockIdx.x);
            EpiResid E{X, X, XB, nullptr, SSP};
            pg8::gemm_phase<EpiResid, pg8::StaticOrder, false, PG8_SP2>(F.lds + RING_OFF, g, S, E);
        }
        GRID_BAR();
    }
    final_norm_phase(F, X, SSP, args.in[18]);
}

extern "C" void kernel_launch(void* const* d_in, const int* in_sizes, int n_in, void* d_out, int out_size, void* d_ws, size_t ws_size, hipStream_t stream) {
    static int grid = 0;
    if (grid == 0) {
        if (n_in != 19 || in_sizes[0] != M * D || out_size != M * D || ws_size < WS_END) { fprintf(stderr, "kernel_launch: unexpected shapes / workspace (n_in %d, ws %zu < %zu)\n", n_in, ws_size, (size_t)WS_END); grid = -1; return; }
        int dev = 0, cus = 0, per_cu = 0;
        if (hipGetDevice(&dev) != hipSuccess || hipDeviceGetAttribute(&cus, hipDeviceAttributeMultiprocessorCount, dev) != hipSuccess) { grid = -1; return; }
        if (hipFuncSetAttribute((const void*)yoco_fwd, hipFuncAttributeMaxDynamicSharedMemorySize, LDS_BYTES) != hipSuccess) { fprintf(stderr, "kernel_launch: hipFuncSetAttribute failed\n"); grid = -1; return; }
        if (hipOccupancyMaxActiveBlocksPerMultiprocessor(&per_cu, (const void*)yoco_fwd, NWAVES * 64, LDS_BYTES) != hipSuccess || per_cu < 1) { fprintf(stderr, "kernel_launch: occupancy query says %d blocks per CU\n", per_cu); (void)hipGetLastError(); grid = -1; return; }
        grid = cus;
        if (grid != 256) fprintf(stderr, "kernel_launch: %d CUs; this kernel is laid out for 256\n", grid);
    }
    if (grid < 0) return;
    if (hipMemsetAsync((char*)d_ws + WS_CTL, 0, CTL_ZERO_BYTES, stream) != hipSuccess) return;
    Args a{};
    for (int i = 0; i < 19; ++i) a.in[i] = (const float*)d_in[i];
    a.out = (float*)d_out; a.ws = (unsigned char*)d_ws;
    hipLaunchKernelGGL(yoco_fwd, dim3(grid), dim3(NWAVES * 64), LDS_BYTES, stream, a);
}
```

```cpp
#include <hip/hip_runtime.h>
#include <cstdio>
#include <cstdint>
#include <cmath>
namespace pg8 {
#define PG8_LAS __attribute__((address_space(3)))
typedef unsigned short bf16_t;
typedef short bf16x8 __attribute__((ext_vector_type(8)));
typedef float f32x4 __attribute__((ext_vector_type(4)));
typedef unsigned u32x4 __attribute__((ext_vector_type(4)));
constexpr int BM = 256, BK = 64, HALF = 128, HTB = HALF * BK * 2  , STAGE_BYTES = 8 * HTB, NXCD = 8, WGM = 8;

__host__ __device__ __forceinline__ int lds_byte(int r, int c) { const int st = (r >> 4) * 2 + (c >> 5), rr = r & 15, cc = c & 31, ob = rr * 64 + cc * 2; return st * 1024 + (ob ^ (((ob >> 9) & 1) << 5)); }
__host__ __device__ __forceinline__ void stage_rc(int b, int& R, int& C) { const int st = b / 1024, sb = b % 1024, swz = sb ^ (((sb >> 9) & 1) << 5); R = (st >> 1) * 16 + swz / 64; C = (st & 1) * 32 + (swz % 64) / 2; }
__host__ __device__ __forceinline__ int perm32(int rho) { const int n = rho >> 4, i = rho & 15; return 8 * (i >> 2) + 4 * n + (i & 3); }

struct Unit { int pm, pn; };
struct Gemm { const bf16_t* A; const bf16_t* Bt; int M, N, K; };

struct StaticOrder {
    int nM, nN, nwg, G, c;
    __host__ __device__ void init(int M, int N, int G_, int c_) { nM = M / BM; nN = N / BM; nwg = nM * nN; G = G_; c = c_; }
    __host__ __device__ bool next(int i, Unit& u) const {
        const long L = (long)i * G + c; if (L >= nwg) return false;
        int wgid = (int)L; { const int q = nwg / NXCD, r = nwg % NXCD, xcd = wgid % NXCD, off = wgid / NXCD; wgid = (xcd < r ? xcd * (q + 1) : r * (q + 1) + (xcd - r) * q) + off; }
        const int nig = WGM * nN, gid = wgid / nig, fm = gid * WGM, gsz = (nM - fm) < WGM ? (nM - fm) : WGM;
        u.pm = fm + ((wgid % nig) % gsz); u.pn = (wgid % nig) / gsz; return true;
    }
    __device__ __forceinline__ void a_ready(const Unit&) const {}
    __device__ __forceinline__ void done(const Unit&) const {}
};

__device__ __forceinline__ unsigned cvt_pk_bf16(float lo, float hi) { unsigned r; asm volatile("v_cvt_pk_bf16_f32 %0, %1, %2" : "=v"(r) : "v"(lo), "v"(hi)); return r; }
typedef float f32x2 __attribute__((ext_vector_type(2)));
template <class Epi, class Sched, bool ALIGN_EPI = false, bool SP2 = false>
__device__ __forceinline__ void gemm_phase(PG8_LAS unsigned char* lds, const Gemm g, const Sched& S, const Epi& E) {
    int tid_ = threadIdx.x; asm volatile("" : "+v"(tid_));
    const int tid = tid_, wid = __builtin_amdgcn_readfirstlane(tid >> 6), lane = tid & 63, wr = wid >> 2, wc = wid & 3, fr = lane & 15, fq = lane >> 4;
    const int K = g.K, nt = K / BK;
    unsigned voffA[2], voffB[2];
#pragma unroll
    for (int i = 0; i < 2; ++i) { int R, C; stage_rc(tid * 16 + i * 8192, R, C); const int Rb = Epi::PERM ? ((R & ~31) + perm32(R & 31)) : R;
        voffA[i] = (unsigned)(R * K + C) * 2u; voffB[i] = (unsigned)(Rb * K + C) * 2u; }
    const size_t kstep = (size_t)(BK * 2);
    const size_t hstep = (size_t)HALF * K * 2;
    const size_t tstep = 2 * hstep;
    const unsigned ldsw = (unsigned)wid * 1024u;
    const int aoff = lds_byte(wr * 64 + fr, fq * 8), boff = lds_byte(wc * 32 + fr, fq * 8);
#define PG8_SA(b, h) (((b) * 2 + (h)) * HTB)
#define PG8_SB(b, h) ((4 + (b) * 2 + (h)) * HTB)
#define PG8_STAGE(bufoff, gbase, voff) do { _Pragma("unroll") for (int _i = 0; _i < 2; ++_i) \
        __builtin_amdgcn_global_load_lds((const unsigned*)((const char*)(gbase) + (voff)[_i]), (PG8_LAS unsigned*)(lds + (bufoff) + ldsw + _i * 8192), 16, 0, 0); } while (0)
#define PG8_LDA(dst, b, h) do { _Pragma("unroll") for (int m = 0; m < 4; ++m) _Pragma("unroll") for (int k = 0; k < 2; ++k) dst[m][k] = *(const PG8_LAS bf16x8*)(lds + PG8_SA(b, h) + aoff + m * 2048 + k * 1024); } while (0)
#define PG8_LDB(dst, b, h) do { _Pragma("unroll") for (int n = 0; n < 2; ++n) _Pragma("unroll") for (int k = 0; k < 2; ++k) dst[n][k] = *(const PG8_LAS bf16x8*)(lds + PG8_SB(b, h) + boff + n * 2048 + k * 1024); } while (0)
#define PG8_MMA(ai, bj, At, Bt) do { __builtin_amdgcn_s_setprio(1); _Pragma("unroll") for (int m = 0; m < 4; ++m) _Pragma("unroll") for (int n = 0; n < 2; ++n) _Pragma("unroll") for (int k = 0; k < 2; ++k) \
        acc[ai][bj][m][n] = __builtin_amdgcn_mfma_f32_16x16x32_bf16(Bt[n][k], At[m][k], acc[ai][bj][m][n], 0, 0, 0); __builtin_amdgcn_s_setprio(0); } while (0)
#define PG8_WAIT_V(n) asm volatile("s_waitcnt vmcnt(" #n ")" ::: "memory")
#define PG8_WAIT_L(n) asm volatile("s_waitcnt lgkmcnt(" #n ")" ::: "memory")
#define PG8_BAR __builtin_amdgcn_s_barrier()
#define PG8_SCHED __builtin_amdgcn_sched_barrier(0)
    Unit cur, nxt; int ui = 0;
    if (!S.next(0, cur)) return;
    f32x4 acc[2][2][4][2];
#pragma unroll
    for (int a = 0; a < 2; ++a)
#pragma unroll
        for (int b = 0; b < 2; ++b)
#pragma unroll
            for (int m = 0; m < 4; ++m)
#pragma unroll
                for (int n = 0; n < 2; ++n) acc[a][b][m][n] = (f32x4){0.f, 0.f, 0.f, 0.f};
    bf16x8 At[4][2], B0[2][2], B1[2][2];
    const char* cA = (const char*)g.A + (size_t)cur.pm * tstep; const char* cB = (const char*)g.Bt + (size_t)cur.pn * tstep;
    S.a_ready(cur);
    if constexpr (SP2) {
        PG8_STAGE(PG8_SB(0, 0), cB, voffB); PG8_STAGE(PG8_SB(0, 1), cB + hstep, voffB); PG8_STAGE(PG8_SA(0, 0), cA, voffA); PG8_STAGE(PG8_SA(0, 1), cA + hstep, voffA);
        if (wr == 1) PG8_BAR;
        PG8_WAIT_V(2); PG8_BAR;
        PG8_STAGE(PG8_SB(1, 0), cB + kstep, voffB); PG8_STAGE(PG8_SA(1, 0), cA + kstep, voffA); PG8_STAGE(PG8_SB(1, 1), cB + hstep + kstep, voffB);
        PG8_WAIT_V(6); PG8_BAR;
    } else {
        PG8_STAGE(PG8_SB(0, 0), cB, voffB); PG8_STAGE(PG8_SA(0, 0), cA, voffA); PG8_STAGE(PG8_SB(0, 1), cB + hstep, voffB); PG8_STAGE(PG8_SA(0, 1), cA + hstep, voffA);
        if (wr == 1) PG8_BAR;
        PG8_WAIT_V(4); PG8_BAR;
        PG8_STAGE(PG8_SB(1, 0), cB + kstep, voffB); PG8_STAGE(PG8_SA(1, 0), cA + kstep, voffA); PG8_STAGE(PG8_SB(1, 1), cB + hstep + kstep, voffB);
        PG8_WAIT_V(6); PG8_BAR;
    }
    for (;;) {
        const bool has_next = S.next(ui + 1, nxt);
        const char* nA = has_next ? (const char*)g.A + (size_t)nxt.pm * tstep : cA; const char* nB = has_next ? (const char*)g.Bt + (size_t)nxt.pn * tstep : cB;
        for (int t = 0; t < nt; t += 2) {
            const bool last = (t == nt - 2);
            const char* a1 = cA + (size_t)(t + 1) * kstep;
            const char* a2 = last ? nA : cA + (size_t)(t + 2) * kstep; const char* b2 = last ? nB : cB + (size_t)(t + 2) * kstep;
            const char* a3 = a2 + kstep; const char* b3 = b2 + kstep;
            if (last && has_next) S.a_ready(nxt);
            if constexpr (SP2) {
            PG8_LDB(B0, 0, 0); PG8_LDB(B1, 0, 1); PG8_SCHED; PG8_LDA(At, 0, 0); PG8_STAGE(PG8_SA(1, 1), a1 + hstep, voffA);
            PG8_WAIT_V(8); PG8_WAIT_L(0); PG8_BAR; PG8_MMA(0, 0, At, B0); PG8_MMA(0, 1, At, B1); PG8_BAR; PG8_SCHED;
            PG8_LDA(At, 0, 1); PG8_STAGE(PG8_SB(0, 0), b2, voffB); PG8_STAGE(PG8_SB(0, 1), b2 + hstep, voffB); PG8_STAGE(PG8_SA(0, 0), a2, voffA);
            PG8_WAIT_V(8); PG8_WAIT_L(0); PG8_BAR; PG8_MMA(1, 0, At, B0); PG8_MMA(1, 1, At, B1); PG8_BAR; PG8_SCHED;
            PG8_LDB(B0, 1, 0); PG8_LDB(B1, 1, 1); PG8_SCHED; PG8_LDA(At, 1, 0); PG8_STAGE(PG8_SA(0, 1), a2 + hstep, voffA);
            PG8_WAIT_V(8); PG8_WAIT_L(0); PG8_BAR; PG8_MMA(0, 0, At, B0); PG8_MMA(0, 1, At, B1); PG8_BAR; PG8_SCHED;
            PG8_LDA(At, 1, 1); PG8_STAGE(PG8_SB(1, 0), b3, voffB); PG8_STAGE(PG8_SB(1, 1), b3 + hstep, voffB); PG8_STAGE(PG8_SA(1, 0), a3, voffA);
            PG8_WAIT_V(8); PG8_WAIT_L(0); PG8_BAR; PG8_MMA(1, 0, At, B0); PG8_MMA(1, 1, At, B1); PG8_BAR; PG8_SCHED;
            } else {
            PG8_LDB(B0, 0, 0); PG8_SCHED; PG8_LDA(At, 0, 0); PG8_STAGE(PG8_SA(1, 1), a1 + hstep, voffA);
            PG8_WAIT_L(8); PG8_BAR; PG8_WAIT_L(0); PG8_MMA(0, 0, At, B0); PG8_BAR; PG8_SCHED;
            PG8_LDB(B1, 0, 1); PG8_STAGE(PG8_SB(0, 0), b2, voffB);
            PG8_BAR; PG8_WAIT_L(0); PG8_MMA(0, 1, At, B1); PG8_BAR;
            PG8_LDA(At, 0, 1); PG8_STAGE(PG8_SA(0, 0), a2, voffA);
            PG8_BAR; PG8_WAIT_L(0); PG8_MMA(1, 0, At, B0); PG8_BAR; PG8_SCHED;
            PG8_STAGE(PG8_SB(0, 1), b2 + hstep, voffB);
            PG8_WAIT_V(6); PG8_BAR; PG8_MMA(1, 1, At, B1); PG8_BAR;
            PG8_LDB(B0, 1, 0); PG8_SCHED; PG8_LDA(At, 1, 0); PG8_STAGE(PG8_SA(0, 1), a2 + hstep, voffA);
            PG8_WAIT_L(8); PG8_BAR; PG8_WAIT_L(0); PG8_MMA(0, 0, At, B0); PG8_BAR; PG8_SCHED;
            PG8_LDB(B1, 1, 1); PG8_STAGE(PG8_SB(1, 0), b3, voffB);
            PG8_BAR; PG8_WAIT_L(0); PG8_MMA(0, 1, At, B1); PG8_BAR;
            PG8_LDA(At, 1, 1); PG8_STAGE(PG8_SA(1, 0), a3, voffA);
            PG8_BAR; PG8_WAIT_L(0); PG8_MMA(1, 0, At, B0); PG8_BAR; PG8_SCHED;
            PG8_STAGE(PG8_SB(1, 1), b3 + hstep, voffB);
            PG8_WAIT_V(6); PG8_BAR; PG8_MMA(1, 1, At, B1); PG8_BAR;
            }
        }
        if constexpr (ALIGN_EPI) { if (wr == 0) PG8_BAR; }
        if constexpr (!Epi::AFTER_DRAIN) { E(acc, cur, wr, wc, fr, fq); S.done(cur); }
        if (!has_next) break;
#pragma unroll
        for (int a = 0; a < 2; ++a)
#pragma unroll
            for (int b = 0; b < 2; ++b)
#pragma unroll
                for (int m = 0; m < 4; ++m)
#pragma unroll
                    for (int n = 0; n < 2; ++n) acc[a][b][m][n] = (f32x4){0.f, 0.f, 0.f, 0.f};
        cur = nxt; cA = nA; cB = nB; ++ui;
        if constexpr (ALIGN_EPI) { if (wr == 1) PG8_BAR; }
    }
    PG8_WAIT_V(0);
    if constexpr (!ALIGN_EPI) { if (wr == 0) PG8_BAR; }
    PG8_BAR;
    if constexpr (Epi::AFTER_DRAIN) { E.fused(acc, cur, wr, wc, fr, fq, lds, wid, lane); S.done(cur); }
#undef PG8_SA
#undef PG8_SB
#undef PG8_STAGE
#undef PG8_LDA
#undef PG8_LDB
#undef PG8_MMA
#undef PG8_WAIT_V
#undef PG8_WAIT_L
#undef PG8_BAR
#undef PG8_SCHED
}
}
#define GAS __attribute__((address_space(1)))
#define LAS __attribute__((address_space(3)))
typedef unsigned short bf16;
typedef unsigned v4u __attribute__((ext_vector_type(4)));
typedef float f32x4 __attribute__((ext_vector_type(4)));
typedef short bf16x8 __attribute__((ext_vector_type(8)));
typedef GAS unsigned gu32;
typedef GAS unsigned long long gu64;
#define RLX_AGENT __ATOMIC_RELAXED, __HIP_MEMORY_SCOPE_AGENT
#define LDS_WAIT() asm volatile("s_waitcnt lgkmcnt(0)" ::: "memory")
#define VM_WAIT() asm volatile("s_waitcnt vmcnt(0)" ::: "memory")
__device__ __forceinline__ unsigned long long rt() { return __builtin_amdgcn_s_memrealtime(); }
__device__ __forceinline__ unsigned f2bf(float f) { unsigned u = __builtin_bit_cast(unsigned, f); return (u + 0x7fffu + ((u >> 16) & 1u)) >> 16; }
__device__ __forceinline__ unsigned pk2(float lo, float hi) { return f2bf(lo) | (f2bf(hi) << 16); }

#define XB_TMO      128
#define XB_XCNT(j)  (256  + 64 * (j))
#define XB_XSUB(j)  (1280 + 64 * (j))
#define XB_XGEN(j)  (2304 + 64 * (j))
#define XB_TOP      3328
#define XB_TOPGEN   3392
#define XCD_BAR_WORDS 3456
#define XB_SPIN_CAP (1u << 18)

__device__ __forceinline__ unsigned xb_ld(unsigned* p)              { return __hip_atomic_load(p, __ATOMIC_RELAXED, __HIP_MEMORY_SCOPE_AGENT); }
__device__ __forceinline__ unsigned xb_add(unsigned* p, unsigned v) { return __hip_atomic_fetch_add(p, v, __ATOMIC_RELAXED, __HIP_MEMORY_SCOPE_AGENT); }
__device__ __forceinline__ unsigned xb_xcc_id() { return (unsigned)__builtin_amdgcn_s_getreg((3 << 11) | 20) & 0xFu; }
#define XB_SPIN(cond, bar) do { unsigned _sp = 0; while (cond) { __builtin_amdgcn_s_sleep(1); \
    if ((++_sp & 255u) == 0u) { if (xb_ld(&(bar)[XB_TMO])) break; if (_sp > XB_SPIN_CAP) { atomicAdd(&(bar)[XB_TMO], 1u); break; } } } } while (0)

struct XcdBarrier {
    unsigned* bar; unsigned x;
    volatile LAS unsigned* st;
};

__device__ __forceinline__ XcdBarrier xcd_barrier_post(unsigned* bar, volatile LAS unsigned* st) {
    XcdBarrier b; b.bar = bar; b.x = xb_xcc_id(); b.st = st;
    if (threadIdx.x == 0) (void)xb_add(&bar[XB_XCNT(b.x)], 1u);
    return b;
}
__device__ __forceinline__ void xcd_barrier_complete(unsigned* bar, unsigned x, unsigned& nloc, unsigned& nx) {
    const unsigned G = gridDim.x * gridDim.y * gridDim.z;
    unsigned sum, cnt, mine, sp = 0u;
    for (;;) {
        sum = 0u; cnt = 0u; mine = 0u;
#pragma unroll
        for (unsigned j = 0; j < 16; ++j) { const unsigned c = xb_ld(&bar[XB_XCNT(j)]); sum += c; cnt += (c > 0u) ? 1u : 0u; mine = (j == x) ? c : mine; }
        if (sum == G) break;
        __builtin_amdgcn_s_sleep(1);
        if ((++sp & 255u) == 0u) { if (xb_ld(&bar[XB_TMO])) break; if (sp > XB_SPIN_CAP) { atomicAdd(&bar[XB_TMO], 1u); break; } }
    }
    nloc = mine > 0u ? mine : 1u; nx = cnt > 0u ? cnt : 1u;
}

__device__ __forceinline__ void xcd_barrier(const XcdBarrier& b) {
    asm volatile("s_waitcnt vmcnt(0)" ::: "memory");
    __syncthreads();
    if (threadIdx.x == 0) {
        unsigned* bar = b.bar;
        __builtin_amdgcn_s_waitcnt(0);
        unsigned nloc = b.st[0], nx = b.st[1];
        if (nloc == 0u) { xcd_barrier_complete(bar, b.x, nloc, nx); b.st[0] = nloc; b.st[1] = nx; }
        const unsigned old = xb_add(&bar[XB_XSUB(b.x)], 1u);
        const unsigned gen = old / nloc;
        if (old + 1u == (gen + 1u) * nloc) {
            __builtin_amdgcn_fence(__ATOMIC_RELEASE, "agent");
            asm volatile("s_waitcnt vmcnt(0)" ::: "memory");
            const unsigned og = xb_add(&bar[XB_TOP], 1u);
            const unsigned tg = og / nx;
            if (og + 1u == (tg + 1u) * nx) xb_add(&bar[XB_TOPGEN], 1u);
            else XB_SPIN(xb_ld(&bar[XB_TOPGEN]) == tg, bar);
            __builtin_amdgcn_fence(__ATOMIC_ACQUIRE, "agent");
            xb_add(&bar[XB_XGEN(b.x)], 1u);
            asm volatile("s_waitcnt vmcnt(0)" ::: "memory");
        } else {
            XB_SPIN(xb_ld(&bar[XB_XGEN(b.x)]) == gen, bar);
            __builtin_amdgcn_fence(__ATOMIC_ACQUIRE, "agent");
            asm volatile("s_waitcnt vmcnt(0)" ::: "memory");
        }
    }
    __syncthreads();
}

constexpr int NWAVES = 8;
constexpr int M = 16384, D = 1024, DFF = 2816, INA = 3080, NC = 256;
constexpr float RMS_EPS = 1e-6f;
constexpr float LOG2E = 1.4426950408889634f;
constexpr float QSCALE_A = 0.08838834764831845f;
constexpr float C2 = 0.125f * LOG2E;

constexpr size_t MiB = 1u << 20;
constexpr size_t WS_CTL = 0, CTL_ZERO_BYTES = 1 * MiB;
constexpr size_t WS_SSP = 1 * MiB;
constexpr size_t WS_GATES = WS_SSP + 256 * 1024;
constexpr size_t WS_NST = 2 * MiB;
constexpr size_t WS_CH = WS_NST + 512 * 1024;
constexpr size_t WS_MS = WS_CH + 16 * 1024;
constexpr size_t WS_WGT = WS_MS + 16 * 1024;
constexpr size_t WS_BQ = WS_WGT + 64 * 1024;
constexpr size_t WS_WIN = 3 * MiB;
constexpr size_t WS_WOUT = 15 * MiB;
constexpr size_t WS_WQ2 = 19 * MiB;
constexpr size_t WS_WQ3 = WS_WQ2 + 1280 * 1024 * 2;
constexpr size_t WS_WBO = 24 * MiB;
constexpr size_t WS_WGU = 28 * MiB;
constexpr size_t WS_WD = 72 * MiB;
constexpr size_t WS_XB = 94 * MiB;
constexpr size_t WS_PROJ = 126 * MiB;
constexpr size_t WS_KV = 222 * MiB;
constexpr size_t WS_HG = 230 * MiB;
constexpr size_t WS_STATE = 262 * MiB;
constexpr size_t WS_END = 326 * MiB;
constexpr int CW_BAR = 4096;

constexpr int RING_OFF = 0, RING_BYTES = 131072;
constexpr int LDSCTL_OFF = RING_BYTES, MISC_OFF = LDSCTL_OFF + 320;
constexpr int LDS_BYTES = 147456;

typedef float f32x2 __attribute__((ext_vector_type(2)));
typedef unsigned u32x2 __attribute__((ext_vector_type(2)));
__device__ __forceinline__ float bf2f(unsigned short b) { return __builtin_bit_cast(float, (unsigned)b << 16); }
__device__ __forceinline__ float bflo(unsigned w) { return __builtin_bit_cast(float, w << 16); }
__device__ __forceinline__ float bfhi(unsigned w) { return __builtin_bit_cast(float, w & 0xffff0000u); }
__device__ __forceinline__ float wave_sum(float v) {
#pragma unroll
    for (int o = 1; o < 64; o <<= 1) v += __shfl_xor(v, o);
    return v;
}
__device__ __forceinline__ float rstd_of(const float* ssp, int row) { const f32x4 p = *(const f32x4*)(ssp + (size_t)row * 4); return rsqrtf(((p.x + p.y) + (p.z + p.w)) * (1.f / D) + RMS_EPS); }

struct EpiProj {
    static constexpr bool PERM = true, AFTER_DRAIN = false;
    bf16* O0; int ld0; bf16* O1; int ld1; int split; const float* bias; const float* ssp;
    __device__ __forceinline__ void operator()(const pg8::f32x4 (&acc)[2][2][4][2], const pg8::Unit& u, int wr, int wc, int fr, int fq) const {
        const int row0 = u.pm * 256 + wr * 64 + fr; int colt = u.pn * 256; bf16* base = O0; int ld = ld0;
        if (split && colt >= split) { base = O1; ld = ld1; colt -= split; }
        const int col0 = colt + wc * 32 + 8 * fq, bcol0 = u.pn * 256 + wc * 32 + 8 * fq;
        f32x4 bv[2][2];
#pragma unroll
        for (int bj = 0; bj < 2; ++bj)
#pragma unroll
            for (int n = 0; n < 2; ++n) bv[bj][n] = bias ? *(const f32x4*)(bias + bcol0 + bj * 128 + 4 * n) : (f32x4){0.f, 0.f, 0.f, 0.f};
#pragma unroll
        for (int ai = 0; ai < 2; ++ai)
#pragma unroll
            for (int m = 0; m < 4; ++m) { const int r = row0 + ai * 128 + m * 16; const float rs = rstd_of(ssp, r); bf16* rowp = base + (size_t)r * ld + col0;
#pragma unroll
                for (int bj = 0; bj < 2; ++bj) { const f32x4 v0 = acc[ai][bj][m][0] * rs + bv[bj][0], v1 = acc[ai][bj][m][1] * rs + bv[bj][1];
                    v4u w; w.x = pg8::cvt_pk_bf16(v0[0], v0[1]); w.y = pg8::cvt_pk_bf16(v0[2], v0[3]); w.z = pg8::cvt_pk_bf16(v1[0], v1[1]); w.w = pg8::cvt_pk_bf16(v1[2], v1[3]);
                    *(v4u*)(rowp + bj * 128) = w; } }
    }
};
__device__ __forceinline__ float silu_mul(float g, float u) { return g * __builtin_amdgcn_rcpf(1.f + __builtin_amdgcn_exp2f(-g * LOG2E)) * u; }
struct EpiSwiglu {
    static constexpr bool PERM = true, AFTER_DRAIN = false;
    bf16* H; const float* ssp;
    __device__ __forceinline__ void operator()(const pg8::f32x4 (&acc)[2][2][4][2], const pg8::Unit& u, int wr, int wc, int fr, int fq) const {
        const int row0 = u.pm * 256 + wr * 64 + fr, col0 = u.pn * 128 + wc * 32 + 8 * fq;
#pragma unroll
        for (int ai = 0; ai < 2; ++ai)
#pragma unroll
            for (int m = 0; m < 4; ++m) { const int r = row0 + ai * 128 + m * 16; const float rs = rstd_of(ssp, r);
                const f32x4 g0 = acc[ai][0][m][0] * rs, g1 = acc[ai][0][m][1] * rs, u0 = acc[ai][1][m][0] * rs, u1 = acc[ai][1][m][1] * rs;
                v4u w; w.x = pg8::cvt_pk_bf16(silu_mul(g0[0], u0[0]), silu_mul(g0[1], u0[1])); w.y = pg8::cvt_pk_bf16(silu_mul(g0[2], u0[2]), silu_mul(g0[3], u0[3]));
                w.z = pg8::cvt_pk_bf16(silu_mul(g1[0], u1[0]), silu_mul(g1[1], u1[1])); w.w = pg8::cvt_pk_bf16(silu_mul(g1[2], u1[2]), silu_mul(g1[3], u1[3]));
                *(v4u*)(H + (size_t)r * DFF + col0) = w; }
    }
};
struct EpiResid {
    static constexpr bool PERM = false, AFTER_DRAIN = true;
    const float* base; float* out; bf16* xb; const float* bias; float* ssp;
    __device__ __forceinline__ void fused(pg8::f32x4 (&acc)[2][2][4][2], const pg8::Unit& u, int wr, int wc, int fr, int fq, PG8_LAS unsigned char* lds, int wid, int lane) const {
        PG8_LAS float* P = (PG8_LAS float*)lds;
        const int col0 = u.pn * 256 + wc * 32 + 4 * fq;
#pragma unroll
        for (int ai = 0; ai < 2; ++ai)
#pragma unroll
            for (int m = 0; m < 4; ++m) { const int rl = ai * 128 + wr * 64 + m * 16 + fr; const size_t off = (size_t)(u.pm * 256 + rl) * D + col0; float ss = 0.f;
#pragma unroll
                for (int bj = 0; bj < 2; ++bj)
#pragma unroll
                    for (int n = 0; n < 2; ++n) { const size_t c = off + bj * 128 + n * 16; f32x4 v = *(const f32x4*)(base + c) + acc[ai][bj][m][n];
                        if (bias) v = v + *(const f32x4*)(bias + col0 + bj * 128 + n * 16);
                        *(f32x4*)(out + c) = v; u32x2 w; w.x = pg8::cvt_pk_bf16(v[0], v[1]); w.y = pg8::cvt_pk_bf16(v[2], v[3]); *(u32x2*)(xb + c) = w;
                        ss += (v[0] * v[0] + v[1] * v[1]) + (v[2] * v[2] + v[3] * v[3]); }
                ss += __shfl_xor(ss, 16); ss += __shfl_xor(ss, 32);
                if (fq == 0) P[rl * 4 + wc] = ss;
                if (m & 1) asm volatile("" ::: "memory"); }
        asm volatile("s_waitcnt lgkmcnt(0)" ::: "memory"); __builtin_amdgcn_s_barrier(); asm volatile("" ::: "memory");
        const int tid = wid * 64 + lane;
        if (tid < 256) { const f32x4 p = *(const PG8_LAS f32x4*)(P + tid * 4); ssp[(size_t)(u.pm * 256 + tid) * 4 + u.pn] = (p.x + p.y) + (p.z + p.w); }
        asm volatile("s_waitcnt lgkmcnt(0)" ::: "memory"); __builtin_amdgcn_s_barrier(); asm volatile("" ::: "memory");
    }
};

struct Frame {
    LAS unsigned char* lds;
    volatile LAS unsigned* MISC;
    gu32* ctl;
    int tid, lane, wave;
    int vcu, G;
};
struct Args { const float* in[19]; float* out; unsigned char* ws; };

#define LAUNDER_TID(F) do { int t_ = (F).tid; asm volatile("" : "+v"(t_)); (F).tid = t_; (F).lane = t_ & 63; } while (0)
__device__ __forceinline__ void conv_item(const float* W, int ldw, int K, int nblk, const float* gain, float qscale, int qcols, bf16* WT, int rowmode, int row_off, LAS float* scr, int item, int lane) {
    const int kb = item / nblk, nb = item % nblk, k0 = 64 * kb, n0 = 32 * nb;
    const float ns = (n0 < qcols) ? qscale : 1.f;
    {
        f32x4 wv[8];
#pragma unroll
        for (int i = 0; i < 8; ++i) wv[i] = *(const f32x4*)(W + (size_t)(k0 + 8 * i + (lane >> 3)) * ldw + n0 + 4 * (lane & 7));
#pragma unroll
        for (int i = 0; i < 8; ++i) { const int kk = 8 * i + (lane >> 3); const float gk = gain ? gain[k0 + kk] * ns : ns; LAS float* d = scr + kk * 33 + 4 * (lane & 7);
            d[0] = wv[i].x * gk; d[1] = wv[i].y * gk; d[2] = wv[i].z * gk; d[3] = wv[i].w * gk; }
    }
    LDS_WAIT(); asm volatile("" ::: "memory");
    int rbase;
    if (rowmode == 0) rbase = row_off + n0;
    else { int j = n0, add = 0; if (j >= DFF) { j -= DFF; add = 128; } rbase = 256 * (j / 128) + add + (j % 128); }
    const int c = lane & 7;
#pragma unroll
    for (int j = 0; j < 4; ++j) { const int n = (lane >> 3) + 8 * j; const LAS float* s = scr + (8 * c) * 33 + n;
        v4u o; o.x = pk2(s[0 * 33], s[1 * 33]); o.y = pk2(s[2 * 33], s[3 * 33]); o.z = pk2(s[4 * 33], s[5 * 33]); o.w = pk2(s[6 * 33], s[7 * 33]);
        *(GAS v4u*)(WT + (size_t)(rbase + n) * K + k0 + 8 * c) = o; }
    LDS_WAIT(); asm volatile("" ::: "memory");
}
__device__ __forceinline__ void p0_prologue(Frame& F, const Args& A) {
    LAUNDER_TID(F);
    LAS float* scr = (LAS float*)(F.lds + RING_OFF + F.wave * 16384);
    const int gw = F.vcu * NWAVES + F.wave, NGW = F.G * NWAVES;
    unsigned char* ws = A.ws;
    const float* a_norm = A.in[1]; const float* a_w_in = A.in[2]; const float* a_w_out = A.in[5]; const float* kv_norm = A.in[6]; const float* w_kv = A.in[7]; const float* b_kv = A.in[8];
    const float* b_norm = A.in[9]; const float* b_w_q = A.in[10]; const float* b_b_q = A.in[11]; const float* b_w_out = A.in[13]; const float* ffn_norm = A.in[15];
    const float* w_gate_up = A.in[16]; const float* w_down = A.in[17];
    constexpr int I_IN = 16 * 96, I_SQ = 16 * 32, I_KV = 16 * 8, I_GU = 16 * 176, I_DN = 44 * 32;
    constexpr int NITEMS = 2 * I_IN + 2 * I_SQ + (I_SQ + I_KV + I_SQ) + 2 * I_SQ + 4 * I_GU + 4 * I_DN;
    for (int it = gw; it < NITEMS; it += NGW) {
        int r = it;
        if (r < 2 * I_IN) { const int l = r / I_IN; r -= l * I_IN; conv_item(a_w_in + (size_t)l * D * INA, INA, D, 96, a_norm + l * D, QSCALE_A, 512, (bf16*)(ws + WS_WIN) + (size_t)l * 3072 * D, 0, 0, scr, r, F.lane); continue; } r -= 2 * I_IN;
        if (r < 2 * I_SQ) { const int l = r / I_SQ; r -= l * I_SQ; conv_item(a_w_out + (size_t)l * D * D, D, D, 32, nullptr, 1.f, 0, (bf16*)(ws + WS_WOUT) + (size_t)l * D * D, 0, 0, scr, r, F.lane); continue; } r -= 2 * I_SQ;
        if (r < I_SQ) { conv_item(b_w_q, D, D, 32, b_norm, C2, 1024, (bf16*)(ws + WS_WQ2), 0, 0, scr, r, F.lane); continue; } r -= I_SQ;
        if (r < I_KV) { conv_item(w_kv, 256, D, 8, kv_norm, 1.f, 0, (bf16*)(ws + WS_WQ2), 0, 1024, scr, r, F.lane); continue; } r -= I_KV;
        if (r < I_SQ) { conv_item(b_w_q + (size_t)D * D, D, D, 32, b_norm + D, C2, 1024, (bf16*)(ws + WS_WQ3), 0, 0, scr, r, F.lane); continue; } r -= I_SQ;
        if (r < 2 * I_SQ) { const int l = r / I_SQ; r -= l * I_SQ; conv_item(b_w_out + (size_t)l * D * D, D, D, 32, nullptr, 1.f, 0, (bf16*)(ws + WS_WBO) + (size_t)l * D * D, 0, 0, scr, r, F.lane); continue; } r -= 2 * I_SQ;
        if (r < 4 * I_GU) { const int l = r / I_GU; r -= l * I_GU; conv_item(w_gate_up + (size_t)l * D * 2 * DFF, 2 * DFF, D, 176, ffn_norm + l * D, 1.f, 0, (bf16*)(ws + WS_WGU) + (size_t)l * 2 * DFF * D, 1, 0, scr, r, F.lane); continue; } r -= 4 * I_GU;
        { const int l = r / I_DN; r -= l * I_DN; conv_item(w_down + (size_t)l * DFF * D, D, DFF, 32, nullptr, 1.f, 0, (bf16*)(ws + WS_WD) + (size_t)l * D * DFF, 0, 0, scr, r, F.lane); }
    }
    const float* x = A.in[0]; bf16* XB = (bf16*)(ws + WS_XB); float* SSP = (float*)(ws + WS_SSP);
    for (int m = gw; m < M; m += NGW) {
        const GAS f32x4* xr = (const GAS f32x4*)(x + (size_t)m * D) + F.lane; GAS u32x2* o8 = (GAS u32x2*)(XB + (size_t)m * D) + F.lane; float s = 0.f;
#pragma unroll
        for (int j = 0; j < 4; ++j) { const f32x4 v = xr[64 * j]; s += (v.x * v.x + v.y * v.y) + (v.z * v.z + v.w * v.w); u32x2 w; w.x = pk2(v.x, v.y); w.y = pk2(v.z, v.w); o8[64 * j] = w; }
        s = wave_sum(s);
        if (F.lane == 0) *(f32x4*)(SSP + (size_t)m * 4) = (f32x4){s, 0.f, 0.f, 0.f};
    }
    const int gt = F.vcu * (NWAVES * 64) + F.tid, NGT = F.G * NWAVES * 64;
    float* WGT = (float*)(ws + WS_WGT); float* BQ = (float*)(ws + WS_BQ);
    for (int i = gt; i < 2 * 8 * 1024; i += NGT) { const int l = i >> 13, j = (i >> 10) & 7, k = i & 1023; WGT[i] = a_w_in[(size_t)l * D * INA + (size_t)k * INA + 3072 + j] * a_norm[l * D + k]; }
    for (int i = gt; i < 2 * 1280; i += NGT) { const int l = i / 1280, c = i % 1280; BQ[i] = (c < 1024) ? b_b_q[l * D + c] * C2 : b_kv[c - 1024]; }
}

__device__ __forceinline__ float softcap15(float x) { return 15.f * tanhf(x * (1.f / 15.f)); }
__device__ __forceinline__ float logsigmoidf(float x) { return fminf(x, 0.f) - log1pf(expf(-fabsf(x))); }

__device__ __forceinline__ void gates_phase(Frame& F, const bf16* XB, const float* SSP, const float* WGTl, const float* bgl, float* GATES) {
    LAUNDER_TID(F);
    LAS float* Wl = (LAS float*)(F.lds + RING_OFF);
    for (int i = F.tid; i < 8 * 1024 / 4; i += NWAVES * 64) ((LAS f32x4*)Wl)[i] = ((const f32x4*)WGTl)[i];
    __syncthreads();
    for (int blk = F.vcu; blk < M / 64; blk += F.G) {
#pragma unroll 1
        for (int rr = 0; rr < 8; ++rr) {
            const int row = blk * 64 + F.wave * 8 + rr;
            float acc[8] = {0.f, 0.f, 0.f, 0.f, 0.f, 0.f, 0.f, 0.f};
#pragma unroll
            for (int i = 0; i < 4; ++i) { const int k = 4 * F.lane + 256 * i; const u32x2 xw = *(const u32x2*)(XB + (size_t)row * D + k);
                const float x0 = bflo(xw.x), x1 = bfhi(xw.x), x2 = bflo(xw.y), x3 = bfhi(xw.y);
#pragma unroll
                for (int j = 0; j < 8; ++j) { const f32x4 w = *(const LAS f32x4*)(Wl + j * 1024 + k); acc[j] += (x0 * w.x + x1 * w.y) + (x2 * w.z + x3 * w.w); } }
#pragma unroll
            for (int j = 0; j < 8; ++j) acc[j] = wave_sum(acc[j]);
            if (F.lane < 8) { float a = acc[0];
#pragma unroll
                for (int j = 1; j < 8; ++j) a = (F.lane == j) ? acc[j] : a;
                const float pre = softcap15(a * rstd_of(SSP, row) + bgl[F.lane]);
                GATES[(size_t)row * 8 + F.lane] = (F.lane < 4) ? pre : logsigmoidf(pre); }
        }
    }
    __syncthreads();
}

__device__ __forceinline__ void chunk_gates(Frame& F, const float* GATES, int c, int h, LAS float* bcum, LAS float* aval) {
    if (F.tid < 64) {
        const float lf = GATES[(size_t)(c * 64 + F.tid) * 8 + 4 + h], ig = GATES[(size_t)(c * 64 + F.tid) * 8 + h];
        float s = lf;
#pragma unroll
        for (int o = 1; o < 64; o <<= 1) { const float t = __shfl_up(s, o); if (F.lane >= o) s += t; }
        bcum[F.tid] = s; aval[F.tid] = ig - s;
    }
    __syncthreads();
}

__device__ __forceinline__ void ml_local_phase(Frame& F, const bf16* PROJ, const float* GATES, bf16* STATE, float* NST, float* CH) {
    LAUNDER_TID(F);
    LAS float* bcum = (LAS float*)(F.lds + RING_OFF); LAS float* aval = bcum + 64; LAS float* wsv = aval + 64;
    for (int unit = F.vcu; unit < NC * 4; unit += F.G) {
        const int c = unit >> 2, h = unit & 3;
        chunk_gates(F, GATES, c, h, bcum, aval);
        const float btot = bcum[63]; float amax = -INFINITY;
        for (int s = 0; s < 64; ++s) amax = fmaxf(amax, aval[s]);
        const float mloc = btot + amax;
        if (F.tid < 64) wsv[F.tid] = expf(btot + aval[F.tid] - mloc);
        __syncthreads();
        const bf16* kb = PROJ + (size_t)(c * 64) * 3072 + 512 + h * 128;
        const bf16* vb = PROJ + (size_t)(c * 64) * 3072 + 1024 + h * 256;
        const int v = F.tid >> 1, dh = F.tid & 1;
        float acc[64];
#pragma unroll
        for (int j = 0; j < 64; ++j) acc[j] = 0.f;
#pragma unroll 1
        for (int s = 0; s < 64; ++s) {
            const float wv = wsv[s] * bf2f(vb[(size_t)s * 3072 + v]);
            const v4u* kr = (const v4u*)(kb + (size_t)s * 3072 + dh * 64);
#pragma unroll
            for (int q = 0; q < 8; ++q) { const v4u kk = kr[q];
                acc[q * 8 + 0] += wv * bflo(kk.x); acc[q * 8 + 1] += wv * bfhi(kk.x); acc[q * 8 + 2] += wv * bflo(kk.y); acc[q * 8 + 3] += wv * bfhi(kk.y);
                acc[q * 8 + 4] += wv * bflo(kk.z); acc[q * 8 + 5] += wv * bfhi(kk.z); acc[q * 8 + 6] += wv * bflo(kk.w); acc[q * 8 + 7] += wv * bfhi(kk.w); }
        }
        bf16* st = STATE + ((size_t)(c * 4 + h) * 256 + v) * 128 + dh * 64;
#pragma unroll
        for (int q = 0; q < 8; ++q) { v4u o; o.x = pk2(acc[q * 8 + 0], acc[q * 8 + 1]); o.y = pk2(acc[q * 8 + 2], acc[q * 8 + 3]); o.z = pk2(acc[q * 8 + 4], acc[q * 8 + 5]); o.w = pk2(acc[q * 8 + 6], acc[q * 8 + 7]); *(v4u*)(st + q * 8) = o; }
        if (F.tid < 128) { float a = 0.f; for (int s = 0; s < 64; ++s) a += wsv[s] * bf2f(kb[(size_t)s * 3072 + F.tid]); NST[(size_t)(c * 4 + h) * 128 + F.tid] = a; }
        if (F.tid == 0) { CH[(c * 4 + h) * 2] = btot; CH[(c * 4 + h) * 2 + 1] = mloc; }
        __syncthreads();
    }
}

__device__ __forceinline__ void ml_scan_phase(Frame& F, bf16* STATE, float* NST, const float* CH, float* MS) {
    LAUNDER_TID(F);
    LAS float* f1 = (LAS float*)(F.lds + RING_OFF); LAS float* f2 = f1 + 256;
    const int h = F.vcu >> 6;
    if (F.tid < 64) {
        float bt[4], ml[4];
#pragma unroll
        for (int j = 0; j < 4; ++j) { const int c = 4 * F.lane + j; bt[j] = CH[(c * 4 + h) * 2]; ml[j] = CH[(c * 4 + h) * 2 + 1]; }
        float B = bt[0], Mx = ml[0];
#pragma unroll
        for (int j = 1; j < 4; ++j) { Mx = fmaxf(Mx + bt[j], ml[j]); B += bt[j]; }
#pragma unroll
        for (int o = 1; o < 64; o <<= 1) { const float Bp = __shfl_up(B, o), Mp = __shfl_up(Mx, o); if (F.lane >= o) { Mx = fmaxf(Mp + B, Mx); B = Bp + B; } }
        const float Bq = __shfl_up(B, 1), Mq = __shfl_up(Mx, 1);
        float m = (F.lane == 0) ? 0.f : fmaxf(Bq, Mq);
#pragma unroll
        for (int j = 0; j < 4; ++j) { const int c = 4 * F.lane + j; const float mn = fmaxf(bt[j] + m, ml[j]);
            f1[c] = expf(bt[j] + m - mn); f2[c] = expf(ml[j] - mn); if ((F.vcu & 63) == 0) MS[c * 4 + h] = m; m = mn; }
    }
    __syncthreads();
    if (F.tid < 256) {
        unsigned* base = (unsigned*)(STATE + (size_t)h * 32768) + ((F.vcu & 63) * 256 + F.tid);
        float c0v = 0.f, c1v = 0.f;
#pragma unroll 1
        for (int cb = 0; cb < NC; cb += 16) {
            unsigned u[16];
#pragma unroll
            for (int j = 0; j < 16; ++j) u[j] = base[(size_t)(cb + j) * 65536];
#pragma unroll
            for (int j = 0; j < 16; ++j) { const float a = f1[cb + j], b = f2[cb + j];
                base[(size_t)(cb + j) * 65536] = pg8::cvt_pk_bf16(c0v, c1v);
                c0v = a * c0v + b * bflo(u[j]); c1v = a * c1v + b * bfhi(u[j]); }
        }
    } else if ((F.vcu & 63) == 0 && F.tid < 384) {
        float* base = NST + h * 128 + (F.tid - 256); float nv = 0.f;
#pragma unroll 1
        for (int cb = 0; cb < NC; cb += 8) {
            float u[8];
#pragma unroll
            for (int j = 0; j < 8; ++j) u[j] = base[(size_t)(cb + j) * 512];
#pragma unroll
            for (int j = 0; j < 8; ++j) { base[(size_t)(cb + j) * 512] = nv; nv = f1[cb + j] * nv + f2[cb + j] * u[j]; }
        }
    }
    __syncthreads();
}

__device__ __forceinline__ void ml_out_phase(Frame& F, const bf16* PROJ, const float* GATES, const bf16* STATE, const float* NST, const float* MS, const float* hnorm, bf16* HG) {
    LAUNDER_TID(F);
    LAS float* bcum = (LAS float*)(F.lds + RING_OFF); LAS float* aval = bcum + 64; LAS float* mt = aval + 64; LAS float* et = mt + 64; LAS float* den = et + 64; LAS float* nq = den + 64;
    LAS float* red = nq + 64;
    LAS float* S = red + 64;
    const float scale = 1.f;
    for (int unit = F.vcu; unit < NC * 4; unit += F.G) {
        const int c = unit >> 2, h = unit & 3;
        chunk_gates(F, GATES, c, h, bcum, aval);
        const float mc = MS[c * 4 + h];
        if (F.tid < 64) { float am = -INFINITY; for (int s = 0; s <= F.tid; ++s) am = fmaxf(am, aval[s]); const float m_t = bcum[F.tid] + fmaxf(mc, am); mt[F.tid] = m_t; et[F.tid] = expf(bcum[F.tid] + mc - m_t); }
        __syncthreads();
        const bf16* qb = PROJ + (size_t)(c * 64) * 3072 + h * 128;
        const bf16* kb = PROJ + (size_t)(c * 64) * 3072 + 512 + h * 128;
        const bf16* vb = PROJ + (size_t)(c * 64) * 3072 + 1024 + h * 256;
        {
            const int t = F.tid >> 3;
#pragma unroll 1
            for (int j = 0; j < 8; ++j) { const int s = (F.tid & 7) * 8 + j; float a = 0.f;
                if (s <= t) { const v4u* qr = (const v4u*)(qb + (size_t)t * 3072); const v4u* kr = (const v4u*)(kb + (size_t)s * 3072);
#pragma unroll 4
                    for (int q = 0; q < 16; ++q) { const v4u a4 = qr[q], b4 = kr[q];
                        a += bflo(a4.x) * bflo(b4.x) + bfhi(a4.x) * bfhi(b4.x) + bflo(a4.y) * bflo(b4.y) + bfhi(a4.y) * bfhi(b4.y) + bflo(a4.z) * bflo(b4.z) + bfhi(a4.z) * bfhi(b4.z) + bflo(a4.w) * bflo(b4.w) + bfhi(a4.w) * bfhi(b4.w); }
                    a *= scale * expf(bcum[t] + aval[s] - mt[t]); }
                S[t * 65 + s] = a; }
        }
        if (F.tid < 64) { float a = 0.f; const float* nn = NST + (size_t)(c * 4 + h) * 128; for (int d = 0; d < 128; ++d) a += nn[d] * bf2f(qb[(size_t)F.tid * 3072 + d]); nq[F.tid] = a * scale; }
        __syncthreads();
        if (F.tid < 64) { float a = 0.f; for (int s = 0; s < 64; ++s) a += S[F.tid * 65 + s]; a += et[F.tid] * nq[F.tid]; den[F.tid] = fmaxf(fabsf(a), expf(-mt[F.tid])); }
        __syncthreads();
        const int v = F.tid & 255, th = F.tid >> 8;
        v4u Cc[16];
        { const v4u* st = (const v4u*)(STATE + ((size_t)(c * 4 + h) * 256 + v) * 128);
#pragma unroll
          for (int q = 0; q < 16; ++q) Cc[q] = st[q]; }
        const float gain = hnorm[h * 256 + v];
#pragma unroll 1
        for (int tt = 0; tt < 32; ++tt) {
            const int t = th * 32 + tt;
            float a = 0.f;
            for (int s = 0; s <= t; ++s) a += S[t * 65 + s] * bf2f(vb[(size_t)s * 3072 + v]);
            float b = 0.f; const v4u* qr = (const v4u*)(qb + (size_t)t * 3072);
#pragma unroll
            for (int q = 0; q < 16; ++q) { const v4u a4 = qr[q], b4 = Cc[q];
                b += bflo(a4.x) * bflo(b4.x) + bfhi(a4.x) * bfhi(b4.x) + bflo(a4.y) * bflo(b4.y) + bfhi(a4.y) * bfhi(b4.y) + bflo(a4.z) * bflo(b4.z) + bfhi(a4.z) * bfhi(b4.z) + bflo(a4.w) * bflo(b4.w) + bfhi(a4.w) * bfhi(b4.w); }
            const float hv = (a + et[t] * scale * b) / den[t];
            const float ss = wave_sum(hv * hv);
            __syncthreads();
            if (F.lane == 0) red[F.wave] = ss;
            __syncthreads();
            const float tot = (red[th * 4] + red[th * 4 + 1]) + (red[th * 4 + 2] + red[th * 4 + 3]);
            const float r = rsqrtf(tot * (1.f / 256.f) + RMS_EPS);
            const size_t row = (size_t)(c * 64 + t);
            const float o = bf2f(PROJ[row * 3072 + 2048 + h * 256 + v]);
            HG[row * D + h * 256 + v] = (bf16)f2bf(hv * r * gain / (1.f + expf(-o)));
        }
        __syncthreads();
    }
}

__device__ __forceinline__ void attn_phase(Frame& F, const bf16* Q, const bf16* KV, const float* sinks, bf16* O) {
    LAUNDER_TID(F);
    for (int unit = F.vcu; unit < 128 * 16; unit += F.G) {
        const int nb = unit >> 4, head = unit & 15, kvh = head >> 3;
        const int i = F.tid >> 2, part = F.tid & 3;
        const int qpos = nb * 128 + i;
        float q[16], o[16];
        { const v4u* qr = (const v4u*)(Q + (size_t)qpos * D + head * 64 + part * 16);
#pragma unroll
          for (int w = 0; w < 2; ++w) { const v4u a = qr[w]; q[w * 8 + 0] = bflo(a.x); q[w * 8 + 1] = bfhi(a.x); q[w * 8 + 2] = bflo(a.y); q[w * 8 + 3] = bfhi(a.y); q[w * 8 + 4] = bflo(a.z); q[w * 8 + 5] = bfhi(a.z); q[w * 8 + 6] = bflo(a.w); q[w * 8 + 7] = bfhi(a.w); } }
        float m = sinks[head] * LOG2E, l = 1.f;
#pragma unroll
        for (int d = 0; d < 16; ++d) o[d] = 0.f;
        const int j0 = (nb == 0) ? 128 : 0;
#pragma unroll 1
        for (int j = j0; j < 256; ++j) {
            const int kpos = (nb - 1) * 128 + j;
            const int rel = i + 128 - j;
            const bool valid = (rel >= 0) && (rel < 128);
            const v4u* kr = (const v4u*)(KV + (size_t)kpos * 256 + kvh * 64 + part * 16);
            const v4u* vr = (const v4u*)(KV + (size_t)kpos * 256 + 128 + kvh * 64 + part * 16);
            float kf[16], vf[16];
#pragma unroll
            for (int w = 0; w < 2; ++w) { const v4u a = kr[w]; kf[w * 8 + 0] = bflo(a.x); kf[w * 8 + 1] = bfhi(a.x); kf[w * 8 + 2] = bflo(a.y); kf[w * 8 + 3] = bfhi(a.y); kf[w * 8 + 4] = bflo(a.z); kf[w * 8 + 5] = bfhi(a.z); kf[w * 8 + 6] = bflo(a.w); kf[w * 8 + 7] = bfhi(a.w);
                const v4u b = vr[w]; vf[w * 8 + 0] = bflo(b.x); vf[w * 8 + 1] = bfhi(b.x); vf[w * 8 + 2] = bflo(b.y); vf[w * 8 + 3] = bfhi(b.y); vf[w * 8 + 4] = bflo(b.z); vf[w * 8 + 5] = bfhi(b.z); vf[w * 8 + 6] = bflo(b.w); vf[w * 8 + 7] = bfhi(b.w); }
            float s = 0.f;
#pragma unroll
            for (int d = 0; d < 16; ++d) s += q[d] * kf[d];
            s += __shfl_xor(s, 1); s += __shfl_xor(s, 2);
            if (valid) {
                const float mn = fmaxf(m, s), corr = __builtin_amdgcn_exp2f(m - mn), p = __builtin_amdgcn_exp2f(s - mn);
                l = l * corr + p;
#pragma unroll
                for (int d = 0; d < 16; ++d) o[d] = o[d] * corr + p * vf[d];
                m = mn;
            }
        }
        const float inv = 1.f / l;
        v4u w0, w1;
        w0.x = pk2(o[0] * inv, o[1] * inv); w0.y = pk2(o[2] * inv, o[3] * inv); w0.z = pk2(o[4] * inv, o[5] * inv); w0.w = pk2(o[6] * inv, o[7] * inv);
        w1.x = pk2(o[8] * inv, o[9] * inv); w1.y = pk2(o[10] * inv, o[11] * inv); w1.z = pk2(o[12] * inv, o[13] * inv); w1.w = pk2(o[14] * inv, o[15] * inv);
        v4u* op = (v4u*)(O + (size_t)qpos * D + head * 64 + part * 16); op[0] = w0; op[1] = w1;
    }
}

__device__ __forceinline__ void final_norm_phase(Frame& F, float* X, const float* SSP, const float* g) {
    LAUNDER_TID(F);
    const int gw = F.vcu * NWAVES + F.wave, NGW = F.G * NWAVES;
    for (int m = gw; m < M; m += NGW) {
        const float rs = rstd_of(SSP, m);
        GAS f32x4* xr = (GAS f32x4*)(X + (size_t)m * D) + F.lane; const f32x4* gg = (const f32x4*)g + F.lane;
#pragma unroll
        for (int j = 0; j < 4; ++j) { const f32x4 v = xr[64 * j], w = gg[64 * j]; xr[64 * j] = v * rs * w; }
    }
}


typedef float f32x16 __attribute__((ext_vector_type(16)));
typedef short s16x4 __attribute__((ext_vector_type(4)));
typedef short v4i16_t __attribute__((ext_vector_type(4)));
__device__ __forceinline__ s16x4 tr16(const LAS unsigned char* p) { return __builtin_bit_cast(s16x4, __builtin_amdgcn_ds_read_tr16_b64_v4i16((LAS v4i16_t*)p)); }
__device__ __forceinline__ bf16x8 cat8(s16x4 a, s16x4 b) { return (bf16x8){a[0], a[1], a[2], a[3], b[0], b[1], b[2], b[3]}; }
__device__ __forceinline__ unsigned cvtpk(float lo, float hi) { return pg8::cvt_pk_bf16(lo, hi); }
__device__ __forceinline__ bf16x8 pack8(const f32x16& p, int s) {
    v4u w; w.x = cvtpk(p[8 * s + 0], p[8 * s + 1]); w.y = cvtpk(p[8 * s + 2], p[8 * s + 3]); w.z = cvtpk(p[8 * s + 4], p[8 * s + 5]); w.w = cvtpk(p[8 * s + 6], p[8 * s + 7]);
    return __builtin_bit_cast(bf16x8, w);
}
#define MFMA32(a, b, c) __builtin_amdgcn_mfma_f32_32x32x16_bf16((a), (b), (c), 0, 0, 0)
#define CROW(r, hi) (((r) & 3) + 8 * ((r) >> 2) + 4 * (hi))

__device__ __forceinline__ void attn_phase_mfma(Frame& F, const bf16* Q, const bf16* KV, const float* sinks, bf16* O) {
    LAUNDER_TID(F);
    LAS unsigned char* Kl = F.lds + RING_OFF;
    LAS unsigned char* Vl = Kl + 32768;
    const int lane = F.lane, r32 = lane & 31, hi = lane >> 5;
    for (int unit = F.vcu; unit < 256; unit += F.G) {
        const int nb = unit >> 1, kvh = unit & 1, head = kvh * 8 + F.wave;
#pragma unroll
        for (int i = 0; i < 4; ++i) { const int p = F.tid + 512 * i, key = p >> 3, c = p & 7, kpos = (nb - 1) * 128 + key;
            if (kpos >= 0) { const v4u kk = *(const v4u*)(KV + (size_t)kpos * 256 + kvh * 64 + c * 8); const v4u vv = *(const v4u*)(KV + (size_t)kpos * 256 + 128 + kvh * 64 + c * 8);
                *(LAS v4u*)(Kl + key * 128 + ((c ^ ((key >> 1) & 7)) << 4)) = kk; *(LAS v4u*)(Vl + (c >> 2) * 16384 + key * 64 + (c & 3) * 16) = vv; } }
        __syncthreads();
        const float sk = sinks[head] * LOG2E;
#pragma unroll 1
        for (int qb = 0; qb < 4; ++qb) {
            const int qpos = nb * 128 + qb * 32 + r32;
            bf16x8 qf[4];
#pragma unroll
            for (int kk = 0; kk < 4; ++kk) qf[kk] = *(const bf16x8*)(Q + (size_t)qpos * D + head * 64 + kk * 16 + hi * 8);
            f32x16 sacc[5];
#pragma unroll
            for (int t = 0; t < 5; ++t) {
#pragma unroll
                for (int r = 0; r < 16; ++r) sacc[t][r] = 0.f;
                if (nb > 0 || qb + t >= 4) { const int key = (qb + t) * 32 + r32;
#pragma unroll
                    for (int kk = 0; kk < 4; ++kk) { const int c = 2 * kk + hi; const bf16x8 kf = *(const LAS bf16x8*)(Kl + key * 128 + ((c ^ ((key >> 1) & 7)) << 4)); sacc[t] = MFMA32(kf, qf[kk], sacc[t]); } }
            }
            float mx = sk;
#pragma unroll
            for (int t = 0; t < 5; ++t) { const bool live = (nb > 0 || qb + t >= 4);
#pragma unroll
                for (int r = 0; r < 16; ++r) { const int cr = CROW(r, hi); bool valid = live; if (t == 0) valid = valid && (cr > r32); if (t == 4) valid = valid && (cr <= r32);
                    const float s = valid ? sacc[t][r] : -INFINITY; sacc[t][r] = s; mx = fmaxf(mx, s); } }
            mx = fmaxf(mx, __shfl_xor(mx, 32));
            float l = 0.f;
#pragma unroll
            for (int t = 0; t < 5; ++t)
#pragma unroll
                for (int r = 0; r < 16; ++r) { const float p = __builtin_amdgcn_exp2f(sacc[t][r] - mx); sacc[t][r] = p; l += p; }
            l += __shfl_xor(l, 32); l += __builtin_amdgcn_exp2f(sk - mx);
            f32x16 oacc[2];
#pragma unroll
            for (int r = 0; r < 16; ++r) { oacc[0][r] = 0.f; oacc[1][r] = 0.f; }
#pragma unroll
            for (int t = 0; t < 5; ++t) if (nb > 0 || qb + t >= 4) {
#pragma unroll
                for (int s = 0; s < 2; ++s) { const bf16x8 pf = pack8(sacc[t], s);
#pragma unroll
                    for (int dt = 0; dt < 2; ++dt) { const LAS unsigned char* vp = Vl + dt * 16384 + ((qb + t) * 32 + 16 * s + 4 * hi + ((lane & 15) >> 2)) * 64 + ((lane >> 4) & 1) * 32 + (lane & 3) * 8;
                        const bf16x8 vf = cat8(tr16(vp), tr16(vp + 8 * 64)); oacc[dt] = MFMA32(vf, pf, oacc[dt]); } } }
            const float inv = 1.f / l;
            bf16* orow = O + (size_t)qpos * D + head * 64 + 4 * hi;
#pragma unroll
            for (int dt = 0; dt < 2; ++dt)
#pragma unroll
                for (int gq = 0; gq < 4; ++gq) { u32x2 w; w.x = cvtpk(oacc[dt][4 * gq] * inv, oacc[dt][4 * gq + 1] * inv); w.y = cvtpk(oacc[dt][4 * gq + 2] * inv, oacc[dt][4 * gq + 3] * inv);
                    *(u32x2*)(orow + 32 * dt + 8 * gq) = w; }
        }
        __syncthreads();
    }
}

__device__ __forceinline__ void ml_local_phase_mfma(Frame& F, const bf16* PROJ, const float* GATES, bf16* STATE, float* NST, float* CH) {
    LAUNDER_TID(F);
    LAS unsigned char* Kl = F.lds + RING_OFF;
    LAS unsigned char* Vl = Kl + 16384;
    LAS float* bcum = (LAS float*)(Vl + 32768); LAS float* aval = bcum + 64; LAS float* wsv = aval + 64;
    const int lane = F.lane, r32 = lane & 31, hi = lane >> 5;
    for (int unit = F.vcu; unit < NC * 4; unit += F.G) {
        const int c = unit >> 2, h = unit & 3;
        chunk_gates(F, GATES, c, h, bcum, aval);
        const float btot = bcum[63]; float amax = -INFINITY;
        for (int s = 0; s < 64; ++s) amax = fmaxf(amax, aval[s]);
        const float mloc = btot + amax;
        if (F.tid < 64) wsv[F.tid] = expf(btot + aval[F.tid] - mloc);
        __syncthreads();
        const bf16* kb = PROJ + (size_t)(c * 64) * 3072 + 512 + h * 128;
        const bf16* vb = PROJ + (size_t)(c * 64) * 3072 + 1024 + h * 256;
#pragma unroll
        for (int i = 0; i < 2; ++i) { const int p = F.tid + 512 * i, s = p >> 4, cc = p & 15; const v4u kk = *(const v4u*)(kb + (size_t)s * 3072 + cc * 8); const float w = wsv[s];
            v4u o; o.x = pk2(bflo(kk.x) * w, bfhi(kk.x) * w); o.y = pk2(bflo(kk.y) * w, bfhi(kk.y) * w); o.z = pk2(bflo(kk.z) * w, bfhi(kk.z) * w); o.w = pk2(bflo(kk.w) * w, bfhi(kk.w) * w);
            *(LAS v4u*)(Kl + (cc >> 2) * 4096 + s * 64 + (cc & 3) * 16) = o; }
#pragma unroll
        for (int i = 0; i < 4; ++i) { const int p = F.tid + 512 * i, s = p >> 5, cc = p & 31; const v4u vv = *(const v4u*)(vb + (size_t)s * 3072 + cc * 8);
            *(LAS v4u*)(Vl + (cc >> 2) * 4096 + s * 64 + (cc & 3) * 16) = vv; }
        if (F.tid == 0) { CH[(c * 4 + h) * 2] = btot; CH[(c * 4 + h) * 2 + 1] = mloc; }
        __syncthreads();
        if (F.tid >= 384) { const int d = F.tid - 384; float a = 0.f; const LAS unsigned short* kc = (const LAS unsigned short*)(Kl + (d >> 5) * 4096 + (d & 31) * 2);
#pragma unroll 16
            for (int s = 0; s < 64; ++s) a += bf2f(kc[s * 32]);
            NST[(size_t)(c * 4 + h) * 128 + d] = a; }
        f32x16 acc[4];
#pragma unroll
        for (int dt = 0; dt < 4; ++dt)
#pragma unroll
            for (int r = 0; r < 16; ++r) acc[dt][r] = 0.f;
        const int troff = (4 * hi + ((lane & 15) >> 2)) * 64 + ((lane >> 4) & 1) * 32 + (lane & 3) * 8;
#pragma unroll
        for (int ks = 0; ks < 4; ++ks) {
            const LAS unsigned char* vp = Vl + F.wave * 4096 + ks * 16 * 64 + troff;
            const bf16x8 vf = cat8(tr16(vp), tr16(vp + 8 * 64));
#pragma unroll
            for (int dt = 0; dt < 4; ++dt) { const LAS unsigned char* kp = Kl + dt * 4096 + ks * 16 * 64 + troff;
                const bf16x8 kf = cat8(tr16(kp), tr16(kp + 8 * 64));
                acc[dt] = MFMA32(kf, vf, acc[dt]); }
        }
        bf16* st = STATE + ((size_t)(c * 4 + h) * 256 + F.wave * 32 + r32) * 128 + 4 * hi;
#pragma unroll
        for (int dt = 0; dt < 4; ++dt)
#pragma unroll
            for (int gq = 0; gq < 4; ++gq) { u32x2 w; w.x = cvtpk(acc[dt][4 * gq], acc[dt][4 * gq + 1]); w.y = cvtpk(acc[dt][4 * gq + 2], acc[dt][4 * gq + 3]); *(u32x2*)(st + 32 * dt + 8 * gq) = w; }
        __syncthreads();
    }
}

__device__ __forceinline__ void ml_out_phase_mfma(Frame& F, const bf16* PROJ, const float* GATES, const bf16* STATE, const float* NST, const float* MS, const float* hnorm, bf16* HG) {
    LAUNDER_TID(F);
    LAS unsigned char* Vl = F.lds + RING_OFF;
    LAS float* bcum = (LAS float*)(Vl + 32768); LAS float* aval = bcum + 64; LAS float* mt = aval + 64; LAS float* et = mt + 64; LAS float* nst = et + 64  ; LAS float* red = nst + 128  ;
    const int lane = F.lane, r32 = lane & 31, hi = lane >> 5, tb = F.wave >> 2, vq = F.wave & 3;
    for (int unit = F.vcu; unit < NC * 4; unit += F.G) {
        const int c = unit >> 2, h = unit & 3;
        const float mc = MS[c * 4 + h];
        if (F.tid < 64) {
            const float lf = GATES[(size_t)(c * 64 + F.tid) * 8 + 4 + h], ig = GATES[(size_t)(c * 64 + F.tid) * 8 + h];
            float s = lf;
#pragma unroll
            for (int o = 1; o < 64; o <<= 1) { const float t = __shfl_up(s, o); if (lane >= o) s += t; }
            const float a = ig - s; float am = a;
#pragma unroll
            for (int o = 1; o < 64; o <<= 1) { const float t = __shfl_up(am, o); if (lane >= o) am = fmaxf(am, t); }
            const float m_t = s + fmaxf(mc, am);
            bcum[F.tid] = s; aval[F.tid] = a; mt[F.tid] = m_t; et[F.tid] = expf(s + mc - m_t);
        }
        if (F.tid >= 64 && F.tid < 192) nst[F.tid - 64] = NST[(size_t)(c * 4 + h) * 128 + F.tid - 64];
        const bf16* qb = PROJ + (size_t)(c * 64) * 3072 + h * 128;
        const bf16* kb = PROJ + (size_t)(c * 64) * 3072 + 512 + h * 128;
        const bf16* vb = PROJ + (size_t)(c * 64) * 3072 + 1024 + h * 256;
#pragma unroll
        for (int i = 0; i < 4; ++i) { const int p = F.tid + 512 * i, s = p >> 5, cc = p & 31; const v4u vv = *(const v4u*)(vb + (size_t)s * 3072 + cc * 8);
            *(LAS v4u*)(Vl + (cc >> 2) * 4096 + s * 64 + (cc & 3) * 16) = vv; }
        const int t = tb * 32 + r32;
        bf16x8 qf[8];
#pragma unroll
        for (int kk = 0; kk < 8; ++kk) qf[kk] = *(const bf16x8*)(qb + (size_t)t * 3072 + kk * 16 + hi * 8);
        f32x16 sacc[2];
#pragma unroll
        for (int sb = 0; sb < 2; ++sb) {
#pragma unroll
            for (int r = 0; r < 16; ++r) sacc[sb][r] = 0.f;
            if (sb <= tb) {
#pragma unroll
                for (int kk = 0; kk < 8; ++kk) { const bf16x8 kf = *(const bf16x8*)(kb + (size_t)(sb * 32 + r32) * 3072 + kk * 16 + hi * 8); sacc[sb] = MFMA32(kf, qf[kk], sacc[sb]); } }
        }
        __syncthreads();
        const float b_t = bcum[t], m_t = mt[t], e_t = et[t];
        float dsum = 0.f;
#pragma unroll
        for (int sb = 0; sb < 2; ++sb)
#pragma unroll
            for (int gq = 0; gq < 4; ++gq) { const f32x4 a4 = *(const LAS f32x4*)(aval + sb * 32 + 8 * gq + 4 * hi);
#pragma unroll
                for (int i = 0; i < 4; ++i) { const int r = 4 * gq + i, cr = 8 * gq + 4 * hi + i; const bool valid = (sb < tb) || (sb == tb && cr <= r32);
                    const float w = valid ? sacc[sb][r] * expf(b_t + a4[i] - m_t) : 0.f; sacc[sb][r] = w; dsum += w; } }
        float nq = 0.f;
#pragma unroll
        for (int kk = 0; kk < 8; ++kk) { const v4u qw = __builtin_bit_cast(v4u, qf[kk]); const f32x4 n0 = *(const LAS f32x4*)(nst + kk * 16 + hi * 8), n1 = *(const LAS f32x4*)(nst + kk * 16 + hi * 8 + 4);
            nq += (bflo(qw.x) * n0.x + bfhi(qw.x) * n0.y) + (bflo(qw.y) * n0.z + bfhi(qw.y) * n0.w) + (bflo(qw.z) * n1.x + bfhi(qw.z) * n1.y) + (bflo(qw.w) * n1.z + bfhi(qw.w) * n1.w); }
        dsum += __shfl_xor(dsum, 32); nq += __shfl_xor(nq, 32);
        const float dd = fmaxf(fabsf(dsum + e_t * nq), expf(-m_t));
        const float dinv = 1.f / dd;
        f32x16 hacc[2];
        const int troff = (4 * hi + ((lane & 15) >> 2)) * 64 + ((lane >> 4) & 1) * 32 + (lane & 3) * 8;
        float ss = 0.f;
#pragma unroll
        for (int vt = 0; vt < 2; ++vt) {
            f32x16 ia, xa;
#pragma unroll
            for (int r = 0; r < 16; ++r) { ia[r] = 0.f; xa[r] = 0.f; }
#pragma unroll
            for (int sb = 0; sb < 2; ++sb) if (sb <= tb) {
#pragma unroll
                for (int s16 = 0; s16 < 2; ++s16) { const LAS unsigned char* vp = Vl + (vq * 2 + vt) * 4096 + (sb * 32 + s16 * 16) * 64 + troff;
                    const bf16x8 vf = cat8(tr16(vp), tr16(vp + 8 * 64)); ia = MFMA32(vf, pack8(sacc[sb], s16), ia); } }
            const bf16* cb = STATE + ((size_t)(c * 4 + h) * 256 + vq * 64 + vt * 32 + r32) * 128 + hi * 8;
#pragma unroll
            for (int kk = 0; kk < 8; ++kk) { const bf16x8 cf = *(const bf16x8*)(cb + kk * 16); xa = MFMA32(cf, qf[kk], xa); }
#pragma unroll
            for (int r = 0; r < 16; ++r) { const float hv = (ia[r] + e_t * xa[r]) * dinv; hacc[vt][r] = hv; ss += hv * hv; }
        }
        ss += __shfl_xor(ss, 32);
        if (hi == 0) red[(tb * 4 + vq) * 32 + r32] = ss;
        __syncthreads();
        const float tot = (red[(tb * 4 + 0) * 32 + r32] + red[(tb * 4 + 1) * 32 + r32]) + (red[(tb * 4 + 2) * 32 + r32] + red[(tb * 4 + 3) * 32 + r32]);
        const float rn = rsqrtf(tot * (1.f / 256.f) + RMS_EPS);
        const size_t row = (size_t)(c * 64 + t);
#pragma unroll
        for (int vt = 0; vt < 2; ++vt)
#pragma unroll
            for (int gq = 0; gq < 4; ++gq) { const int v0 = h * 256 + vq * 64 + vt * 32 + 8 * gq + 4 * hi;
                const f32x4 gn = *(const f32x4*)(hnorm + v0); const u32x2 ow = *(const u32x2*)(PROJ + row * 3072 + 2048 + v0);
                const float o0 = bflo(ow.x), o1 = bfhi(ow.x), o2 = bflo(ow.y), o3 = bfhi(ow.y);
                const float y0 = hacc[vt][4 * gq] * rn * gn.x / (1.f + expf(-o0)), y1 = hacc[vt][4 * gq + 1] * rn * gn.y / (1.f + expf(-o1));
                const float y2 = hacc[vt][4 * gq + 2] * rn * gn.z / (1.f + expf(-o2)), y3 = hacc[vt][4 * gq + 3] * rn * gn.w / (1.f + expf(-o3));
                u32x2 w; w.x = cvtpk(y0, y1); w.y = cvtpk(y2, y3); *(u32x2*)(HG + row * D + v0) = w; }
        __syncthreads();
    }
}

#ifndef XP_PRO
#define XP_PRO 0
#endif
#ifndef XP_GEMM
#define XP_GEMM 0
#endif
#ifndef XP_ML
#define XP_ML 0
#endif
#ifndef XP_ATTN
#define XP_ATTN 0
#endif
#ifndef XP_BAR
#define XP_BAR 0
#endif
#ifndef ATTN_MFMA
#define ATTN_MFMA 1
#endif
#ifndef MLL_MFMA
#define MLL_MFMA 1
#endif
#ifndef MLO_MFMA
#define MLO_MFMA 1
#endif
#ifndef PG8_SP2
#define PG8_SP2 true
#endif
#ifndef PG8_ALIGN
#define PG8_ALIGN true
#endif
__global__ void __launch_bounds__(NWAVES * 64, 2) yoco_fwd(Args args) {
    extern __shared__ __attribute__((aligned(16))) unsigned char lds[];
    Frame F;
    F.lds = (LAS unsigned char*)lds;
    F.MISC = (volatile LAS unsigned*)(F.lds + MISC_OFF);
    F.tid = threadIdx.x; F.lane = F.tid & 63; F.wave = __builtin_amdgcn_readfirstlane(F.tid >> 6);
    F.G = gridDim.x; { const int bx = blockIdx.x; F.vcu = (F.G % 8 == 0) ? (bx % 8) * (F.G / 8) + bx / 8 : bx; }
    unsigned char* ws = args.ws;
    F.ctl = (gu32*)(ws + WS_CTL);
    for (int u = F.tid; u < (LDS_BYTES - LDSCTL_OFF) / 4; u += NWAVES * 64) ((LAS unsigned*)(F.lds + LDSCTL_OFF))[u] = 0u;
    __syncthreads();
    XcdBarrier bar = xcd_barrier_post((unsigned*)(F.ctl + CW_BAR), F.MISC + 8);
#define GRID_BAR() xcd_barrier(bar)

    float* X = args.out;
    float* SSP = (float*)(ws + WS_SSP); float* GATES = (float*)(ws + WS_GATES); float* NST = (float*)(ws + WS_NST); float* CH = (float*)(ws + WS_CH); float* MS = (float*)(ws + WS_MS);
    bf16* XB = (bf16*)(ws + WS_XB); bf16* PROJ = (bf16*)(ws + WS_PROJ); bf16* KVb = (bf16*)(ws + WS_KV); bf16* HG = (bf16*)(ws + WS_HG); bf16* STATE = (bf16*)(ws + WS_STATE);
    bf16* Hb = PROJ; bf16* Qb = PROJ;

    for (int rep = 0; rep <= XP_PRO; ++rep) p0_prologue(F, args);
    GRID_BAR();
    for (int rep = 0; rep < XP_BAR; ++rep) GRID_BAR();

    for (int l = 0; l < 4; ++l) {
        const float* resid_base = (l == 0) ? args.in[0] : X;
        if (l < 2) {
            {
                pg8::Gemm g{XB, (const bf16*)(ws + WS_WIN) + (size_t)l * 3072 * D, M, 3072, D}; pg8::StaticOrder S; S.init(M, 3072, F.G, (int)blockIdx.x);
                EpiProj E{PROJ, 3072, PROJ, 3072, 0, nullptr, SSP};
                for (int rep = 0; rep <= XP_GEMM; ++rep) pg8::gemm_phase<EpiProj, pg8::StaticOrder, PG8_ALIGN, PG8_SP2>(F.lds + RING_OFF, g, S, E);
                gates_phase(F, XB, SSP, (const float*)(ws + WS_WGT) + l * 8 * 1024, args.in[3] + l * 8, GATES);
            }
            GRID_BAR();
#if MLL_MFMA
            for (int rep = 0; rep <= XP_ML; ++rep) ml_local_phase_mfma(F, PROJ, GATES, STATE, NST, CH);
#else
            ml_local_phase(F, PROJ, GATES, STATE, NST, CH);
#endif
            GRID_BAR();
            ml_scan_phase(F, STATE, NST, CH, MS);
            GRID_BAR();
#if MLO_MFMA
            for (int rep = 0; rep <= XP_ML; ++rep) ml_out_phase_mfma(F, PROJ, GATES, STATE, NST, MS, args.in[4] + l * D, HG);
#else
            ml_out_phase(F, PROJ, GATES, STATE, NST, MS, args.in[4] + l * D, HG);
#endif
            GRID_BAR();
            {
                pg8::Gemm g{HG, (const bf16*)(ws + WS_WOUT) + (size_t)l * D * D, M, D, D}; pg8::StaticOrder S; S.init(M, D, F.G, (int)blockIdx.x);
                EpiResid E{resid_base, X, XB, nullptr, SSP};
                pg8::gemm_phase<EpiResid, pg8::StaticOrder, false, PG8_SP2>(F.lds + RING_OFF, g, S, E);
            }
            GRID_BAR();
        } else {
            const int j = l - 2;
            {
                const int N = (j == 0) ? 1280 : 1024;
                pg8::Gemm g{XB, (const bf16*)(ws + (j == 0 ? WS_WQ2 : WS_WQ3)), M, N, D}; pg8::StaticOrder S; S.init(M, N, F.G, (int)blockIdx.x);
                EpiProj E{Qb, D, KVb, 256, 1024, (const float*)(ws + WS_BQ) + j * 1280, SSP};
                for (int rep = 0; rep <= XP_GEMM; ++rep) pg8::gemm_phase<EpiProj, pg8::StaticOrder, PG8_ALIGN, PG8_SP2>(F.lds + RING_OFF, g, S, E);
            }
            GRID_BAR();
#if ATTN_MFMA
            for (int rep = 0; rep <= XP_ATTN; ++rep) attn_phase_mfma(F, Qb, KVb, args.in[12] + j * 16, HG);
#else
            attn_phase(F, Qb, KVb, args.in[12] + j * 16, HG);
#endif
            GRID_BAR();
            {
                pg8::Gemm g{HG, (const bf16*)(ws + WS_WBO) + (size_t)j * D * D, M, D, D}; pg8::StaticOrder S; S.init(M, D, F.G, (int)blockIdx.x);
                EpiResid E{resid_base, X, XB, args.in[14] + j * D, SSP};
                pg8::gemm_phase<EpiResid, pg8::StaticOrder, false, PG8_SP2>(F.lds + RING_OFF, g, S, E);
            }
            GRID_BAR();
        }
        {
            pg8::Gemm g{XB, (const bf16*)(ws + WS_WGU) + (size_t)l * 2 * DFF * D, M, 2 * DFF, D}; pg8::StaticOrder S; S.init(M, 2 * DFF, F.G, (int)blockIdx.x);
            EpiSwiglu E{Hb, SSP};
            for (int rep = 0; rep <= XP_GEMM; ++rep) pg8::gemm_phase<EpiSwiglu, pg8::StaticOrder, PG8_ALIGN, PG8_SP2>(F.lds + RING_OFF, g, S, E);
        }
        GRID_BAR();
        {
            pg8::Gemm g{Hb, (const bf16*)(ws + WS_WD) + (size_t)l * D * DFF, M, D, DFF}; pg8::StaticOrder S; S.init(M, D, F.G, (int)blockIdx.x);
            EpiResid E{X, X, XB, nullptr, SSP};
            pg8::gemm_phase<EpiResid, pg8::StaticOrder, false, PG8_SP2>(F.lds + RING_OFF, g, S, E);
        }
        GRID_BAR();
    }
    final_norm_phase(F, X, SSP, args.in[18]);
}

extern "C" void kernel_launch(void* const* d_in, const int* in_sizes, int n_in, void* d_out, int out_size, void* d_ws, size_t ws_size, hipStream_t stream) {
    static int grid = 0;
    if (grid == 0) {
        if (n_in != 19 || in_sizes[0] != M * D || out_size != M * D || ws_size < WS_END) { fprintf(stderr, "kernel_launch: unexpected shapes / workspace (n_in %d, ws %zu < %zu)\n", n_in, ws_size, (size_t)WS_END); grid = -1; return; }
        int dev = 0, cus = 0, per_cu = 0;
        if (hipGetDevice(&dev) != hipSuccess || hipDeviceGetAttribute(&cus, hipDeviceAttributeMultiprocessorCount, dev) != hipSuccess) { grid = -1; return; }
        if (hipFuncSetAttribute((const void*)yoco_fwd, hipFuncAttributeMaxDynamicSharedMemorySize, LDS_BYTES) != hipSuccess) { fprintf(stderr, "kernel_launch: hipFuncSetAttribute failed\n"); grid = -1; return; }
        if (hipOccupancyMaxActiveBlocksPerMultiprocessor(&per_cu, (const void*)yoco_fwd, NWAVES * 64, LDS_BYTES) != hipSuccess || per_cu < 1) { fprintf(stderr, "kernel_launch: occupancy query says %d blocks per CU\n", per_cu); (void)hipGetLastError(); grid = -1; return; }
        grid = cus;
        if (grid != 256) fprintf(stderr, "kernel_launch: %d CUs; this kernel is laid out for 256\n", grid);
    }
    if (grid < 0) return;
    if (hipMemsetAsync((char*)d_ws + WS_CTL, 0, CTL_ZERO_BYTES, stream) != hipSuccess) return;
    Args a{};
    for (int i = 0; i < 19; ++i) a.in[i] = (const float*)d_in[i];
    a.out = (float*)d_out; a.ws = (unsigned char*)d_ws;
    hipLaunchKernelGGL(yoco_fwd, dim3(grid), dim3(NWAVES * 64), LDS_BYTES, stream, a);
}
```

```cpp
#include <hip/hip_runtime.h>
#include <cstdio>
#include <cstdint>
#include <cmath>
namespace pg8 {
#define PG8_LAS __attribute__((address_space(3)))
typedef unsigned short bf16_t;
typedef short bf16x8 __attribute__((ext_vector_type(8)));
typedef float f32x4 __attribute__((ext_vector_type(4)));
typedef unsigned u32x4 __attribute__((ext_vector_type(4)));
constexpr int BM = 256, BK = 64, HALF = 128, HTB = HALF * BK * 2  , STAGE_BYTES = 8 * HTB, NXCD = 8, WGM = 8;

__host__ __device__ __forceinline__ int lds_byte(int r, int c) { const int st = (r >> 4) * 2 + (c >> 5), rr = r & 15, cc = c & 31, ob = rr * 64 + cc * 2; return st * 1024 + (ob ^ (((ob >> 9) & 1) << 5)); }
__host__ __device__ __forceinline__ void stage_rc(int b, int& R, int& C) { const int st = b / 1024, sb = b % 1024, swz = sb ^ (((sb >> 9) & 1) << 5); R = (st >> 1) * 16 + swz / 64; C = (st & 1) * 32 + (swz % 64) / 2; }
__host__ __device__ __forceinline__ int perm32(int rho) { const int n = rho >> 4, i = rho & 15; return 8 * (i >> 2) + 4 * n + (i & 3); }

struct Unit { int pm, pn; };
struct Gemm { const bf16_t* A; const bf16_t* Bt; int M, N, K; };

struct StaticOrder {
    int nM, nN, nwg, G, c;
    __host__ __device__ void init(int M, int N, int G_, int c_) { nM = M / BM; nN = N / BM; nwg = nM * nN; G = G_; c = c_; }
    __host__ __device__ bool next(int i, Unit& u) const {
        const long L = (long)i * G + c; if (L >= nwg) return false;
        int wgid = (int)L; { const int q = nwg / NXCD, r = nwg % NXCD, xcd = wgid % NXCD, off = wgid / NXCD; wgid = (xcd < r ? xcd * (q + 1) : r * (q + 1) + (xcd - r) * q) + off; }
        const int nig = WGM * nN, gid = wgid / nig, fm = gid * WGM, gsz = (nM - fm) < WGM ? (nM - fm) : WGM;
        u.pm = fm + ((wgid % nig) % gsz); u.pn = (wgid % nig) / gsz; return true;
    }
    __device__ __forceinline__ void a_ready(const Unit&) const {}
    __device__ __forceinline__ void done(const Unit&) const {}
};

__device__ __forceinline__ unsigned cvt_pk_bf16(float lo, float hi) { unsigned r; asm volatile("v_cvt_pk_bf16_f32 %0, %1, %2" : "=v"(r) : "v"(lo), "v"(hi)); return r; }
typedef float f32x2 __attribute__((ext_vector_type(2)));
template <class Epi, class Sched, bool ALIGN_EPI = false, bool SP2 = false>
__device__ __forceinline__ void gemm_phase(PG8_LAS unsigned char* lds, const Gemm g, const Sched& S, const Epi& E) {
    int tid_ = (int)__builtin_amdgcn_mbcnt_hi(~0u, __builtin_amdgcn_mbcnt_lo(~0u, 0u)); asm volatile("" : "+v"(tid_)); tid_ += 64 * __builtin_amdgcn_readfirstlane((int)threadIdx.x >> 6);
    const int tid = tid_, wid = __builtin_amdgcn_readfirstlane(tid >> 6), lane = tid & 63, wr = wid >> 2, wc = wid & 3, fr = lane & 15, fq = lane >> 4;
    const int K = g.K, nt = K / BK;
    unsigned voffA[2], voffB[2];
#pragma unroll
    for (int i = 0; i < 2; ++i) { int R, C; stage_rc(tid * 16 + i * 8192, R, C); const int Rb = Epi::PERM ? ((R & ~31) + perm32(R & 31)) : R;
        voffA[i] = (unsigned)(R * K + C) * 2u; voffB[i] = (unsigned)(Rb * K + C) * 2u; }
    const size_t kstep = (size_t)(BK * 2);
    const size_t hstep = (size_t)HALF * K * 2;
    const size_t tstep = 2 * hstep;
    const unsigned ldsw = (unsigned)wid * 1024u;
    const int aoff = lds_byte(wr * 64 + fr, fq * 8), boff = lds_byte(wc * 32 + fr, fq * 8);
#define PG8_SA(b, h) (((b) * 2 + (h)) * HTB)
#define PG8_SB(b, h) ((4 + (b) * 2 + (h)) * HTB)
#define PG8_STAGE(bufoff, gbase, voff) do { _Pragma("unroll") for (int _i = 0; _i < 2; ++_i) \
        __builtin_amdgcn_global_load_lds((const unsigned*)((const char*)(gbase) + (voff)[_i]), (PG8_LAS unsigned*)(lds + (bufoff) + ldsw + _i * 8192), 16, 0, 0); } while (0)
#define PG8_LDA(dst, b, h) do { _Pragma("unroll") for (int m = 0; m < 4; ++m) _Pragma("unroll") for (int k = 0; k < 2; ++k) dst[m][k] = *(const PG8_LAS bf16x8*)(lds + PG8_SA(b, h) + aoff + m * 2048 + k * 1024); } while (0)
#define PG8_LDB(dst, b, h) do { _Pragma("unroll") for (int n = 0; n < 2; ++n) _Pragma("unroll") for (int k = 0; k < 2; ++k) dst[n][k] = *(const PG8_LAS bf16x8*)(lds + PG8_SB(b, h) + boff + n * 2048 + k * 1024); } while (0)
#define PG8_MMA(ai, bj, At, Bt) do { __builtin_amdgcn_s_setprio(1); _Pragma("unroll") for (int m = 0; m < 4; ++m) _Pragma("unroll") for (int n = 0; n < 2; ++n) _Pragma("unroll") for (int k = 0; k < 2; ++k) \
        acc[ai][bj][m][n] = __builtin_amdgcn_mfma_f32_16x16x32_bf16(Bt[n][k], At[m][k], acc[ai][bj][m][n], 0, 0, 0); __builtin_amdgcn_s_setprio(0); } while (0)
#define PG8_WAIT_V(n) asm volatile("s_waitcnt vmcnt(" #n ")" ::: "memory")
#define PG8_WAIT_L(n) asm volatile("s_waitcnt lgkmcnt(" #n ")" ::: "memory")
#define PG8_BAR __builtin_amdgcn_s_barrier()
#define PG8_SCHED __builtin_amdgcn_sched_barrier(0)
    Unit cur, nxt; int ui = 0;
    if (!S.next(0, cur)) return;
    f32x4 acc[2][2][4][2];
#pragma unroll
    for (int a = 0; a < 2; ++a)
#pragma unroll
        for (int b = 0; b < 2; ++b)
#pragma unroll
            for (int m = 0; m < 4; ++m)
#pragma unroll
                for (int n = 0; n < 2; ++n) acc[a][b][m][n] = (f32x4){0.f, 0.f, 0.f, 0.f};
    bf16x8 At[4][2], B0[2][2], B1[2][2];
    const char* cA = (const char*)g.A + (size_t)cur.pm * tstep; const char* cB = (const char*)g.Bt + (size_t)cur.pn * tstep;
    S.a_ready(cur);
    if constexpr (SP2) {
        PG8_STAGE(PG8_SB(0, 0), cB, voffB); PG8_STAGE(PG8_SB(0, 1), cB + hstep, voffB); PG8_STAGE(PG8_SA(0, 0), cA, voffA); PG8_STAGE(PG8_SA(0, 1), cA + hstep, voffA);
        if (wr == 1) PG8_BAR;
        PG8_WAIT_V(2); PG8_BAR;
        PG8_STAGE(PG8_SB(1, 0), cB + kstep, voffB); PG8_STAGE(PG8_SA(1, 0), cA + kstep, voffA); PG8_STAGE(PG8_SB(1, 1), cB + hstep + kstep, voffB);
        PG8_WAIT_V(6); PG8_BAR;
    } else {
        PG8_STAGE(PG8_SB(0, 0), cB, voffB); PG8_STAGE(PG8_SA(0, 0), cA, voffA); PG8_STAGE(PG8_SB(0, 1), cB + hstep, voffB); PG8_STAGE(PG8_SA(0, 1), cA + hstep, voffA);
        if (wr == 1) PG8_BAR;
        PG8_WAIT_V(4); PG8_BAR;
        PG8_STAGE(PG8_SB(1, 0), cB + kstep, voffB); PG8_STAGE(PG8_SA(1, 0), cA + kstep, voffA); PG8_STAGE(PG8_SB(1, 1), cB + hstep + kstep, voffB);
        PG8_WAIT_V(6); PG8_BAR;
    }
    for (;;) {
        const bool has_next = S.next(ui + 1, nxt);
        const char* nA = has_next ? (const char*)g.A + (size_t)nxt.pm * tstep : cA; const char* nB = has_next ? (const char*)g.Bt + (size_t)nxt.pn * tstep : cB;
        for (int t = 0; t < nt; t += 2) {
            const bool last = (t == nt - 2);
            const char* a1 = cA + (size_t)(t + 1) * kstep;
            const char* a2 = last ? nA : cA + (size_t)(t + 2) * kstep; const char* b2 = last ? nB : cB + (size_t)(t + 2) * kstep;
            const char* a3 = a2 + kstep; const char* b3 = b2 + kstep;
            if (last && has_next) S.a_ready(nxt);
            if constexpr (SP2) {
            PG8_LDB(B0, 0, 0); PG8_LDB(B1, 0, 1); PG8_SCHED; PG8_LDA(At, 0, 0); PG8_STAGE(PG8_SA(1, 1), a1 + hstep, voffA);
            PG8_WAIT_V(8); PG8_WAIT_L(0); PG8_BAR; PG8_MMA(0, 0, At, B0); PG8_MMA(0, 1, At, B1); PG8_BAR; PG8_SCHED;
            PG8_LDA(At, 0, 1); PG8_STAGE(PG8_SB(0, 0), b2, voffB); PG8_STAGE(PG8_SB(0, 1), b2 + hstep, voffB); PG8_STAGE(PG8_SA(0, 0), a2, voffA);
            PG8_WAIT_V(8); PG8_WAIT_L(0); PG8_BAR; PG8_MMA(1, 0, At, B0); PG8_MMA(1, 1, At, B1); PG8_BAR; PG8_SCHED;
            PG8_LDB(B0, 1, 0); PG8_LDB(B1, 1, 1); PG8_SCHED; PG8_LDA(At, 1, 0); PG8_STAGE(PG8_SA(0, 1), a2 + hstep, voffA);
            PG8_WAIT_V(8); PG8_WAIT_L(0); PG8_BAR; PG8_MMA(0, 0, At, B0); PG8_MMA(0, 1, At, B1); PG8_BAR; PG8_SCHED;
            PG8_LDA(At, 1, 1); PG8_STAGE(PG8_SB(1, 0), b3, voffB); PG8_STAGE(PG8_SB(1, 1), b3 + hstep, voffB); PG8_STAGE(PG8_SA(1, 0), a3, voffA);
            PG8_WAIT_V(8); PG8_WAIT_L(0); PG8_BAR; PG8_MMA(1, 0, At, B0); PG8_MMA(1, 1, At, B1); PG8_BAR; PG8_SCHED;
            } else {
            PG8_LDB(B0, 0, 0); PG8_SCHED; PG8_LDA(At, 0, 0); PG8_STAGE(PG8_SA(1, 1), a1 + hstep, voffA);
            PG8_WAIT_L(8); PG8_BAR; PG8_WAIT_L(0); PG8_MMA(0, 0, At, B0); PG8_BAR; PG8_SCHED;
            PG8_LDB(B1, 0, 1); PG8_STAGE(PG8_SB(0, 0), b2, voffB);
            PG8_BAR; PG8_WAIT_L(0); PG8_MMA(0, 1, At, B1); PG8_BAR;
            PG8_LDA(At, 0, 1); PG8_STAGE(PG8_SA(0, 0), a2, voffA);
            PG8_BAR; PG8_WAIT_L(0); PG8_MMA(1, 0, At, B0); PG8_BAR; PG8_SCHED;
            PG8_STAGE(PG8_SB(0, 1), b2 + hstep, voffB);
            PG8_WAIT_V(6); PG8_BAR; PG8_MMA(1, 1, At, B1); PG8_BAR;
            PG8_LDB(B0, 1, 0); PG8_SCHED; PG8_LDA(At, 1, 0); PG8_STAGE(PG8_SA(0, 1), a2 + hstep, voffA);
            PG8_WAIT_L(8); PG8_BAR; PG8_WAIT_L(0); PG8_MMA(0, 0, At, B0); PG8_BAR; PG8_SCHED;
            PG8_LDB(B1, 1, 1); PG8_STAGE(PG8_SB(1, 0), b3, voffB);
            PG8_BAR; PG8_WAIT_L(0); PG8_MMA(0, 1, At, B1); PG8_BAR;
            PG8_LDA(At, 1, 1); PG8_STAGE(PG8_SA(1, 0), a3, voffA);
            PG8_BAR; PG8_WAIT_L(0); PG8_MMA(1, 0, At, B0); PG8_BAR; PG8_SCHED;
            PG8_STAGE(PG8_SB(1, 1), b3 + hstep, voffB);
            PG8_WAIT_V(6); PG8_BAR; PG8_MMA(1, 1, At, B1); PG8_BAR;
            }
        }
        if constexpr (ALIGN_EPI) { if (wr == 0) PG8_BAR; }
        if constexpr (!Epi::AFTER_DRAIN) { E(acc, cur, wr, wc, fr, fq); S.done(cur); }
        if (!has_next) break;
#pragma unroll
        for (int a = 0; a < 2; ++a)
#pragma unroll
            for (int b = 0; b < 2; ++b)
#pragma unroll
                for (int m = 0; m < 4; ++m)
#pragma unroll
                    for (int n = 0; n < 2; ++n) acc[a][b][m][n] = (f32x4){0.f, 0.f, 0.f, 0.f};
        cur = nxt; cA = nA; cB = nB; ++ui;
        if constexpr (ALIGN_EPI) { if (wr == 1) PG8_BAR; }
    }
    PG8_WAIT_V(0);
    if constexpr (!ALIGN_EPI) { if (wr == 0) PG8_BAR; }
    PG8_BAR;
    if constexpr (Epi::AFTER_DRAIN) { E.fused(acc, cur, wr, wc, fr, fq, lds, wid, lane); S.done(cur); }
#undef PG8_SA
#undef PG8_SB
#undef PG8_STAGE
#undef PG8_LDA
#undef PG8_LDB
#undef PG8_MMA
#undef PG8_WAIT_V
#undef PG8_WAIT_L
#undef PG8_BAR
#undef PG8_SCHED
}
}
#define GAS __attribute__((address_space(1)))
#define LAS __attribute__((address_space(3)))
typedef unsigned short bf16;
typedef unsigned v4u __attribute__((ext_vector_type(4)));
typedef float f32x4 __attribute__((ext_vector_type(4)));
typedef short bf16x8 __attribute__((ext_vector_type(8)));
typedef GAS unsigned gu32;
typedef GAS unsigned long long gu64;
#define RLX_AGENT __ATOMIC_RELAXED, __HIP_MEMORY_SCOPE_AGENT
#define LDS_WAIT() asm volatile("s_waitcnt lgkmcnt(0)" ::: "memory")
#define VM_WAIT() asm volatile("s_waitcnt vmcnt(0)" ::: "memory")
__device__ __forceinline__ unsigned long long rt() { return __builtin_amdgcn_s_memrealtime(); }
__device__ __forceinline__ unsigned f2bf(float f) { unsigned u = __builtin_bit_cast(unsigned, f); return (u + 0x7fffu + ((u >> 16) & 1u)) >> 16; }
__device__ __forceinline__ unsigned pk2(float lo, float hi) { return f2bf(lo) | (f2bf(hi) << 16); }

#define XB_TMO      128
#define XB_XCNT(j)  (256  + 64 * (j))
#define XB_XSUB(j)  (1280 + 64 * (j))
#define XB_XGEN(j)  (2304 + 64 * (j))
#define XB_TOP      3328
#define XB_TOPGEN   3392
#define XCD_BAR_WORDS 3456
#define XB_SPIN_CAP (1u << 18)

__device__ __forceinline__ unsigned xb_ld(unsigned* p)              { return __hip_atomic_load(p, __ATOMIC_RELAXED, __HIP_MEMORY_SCOPE_AGENT); }
__device__ __forceinline__ unsigned xb_add(unsigned* p, unsigned v) { return __hip_atomic_fetch_add(p, v, __ATOMIC_RELAXED, __HIP_MEMORY_SCOPE_AGENT); }
__device__ __forceinline__ unsigned xb_xcc_id() { return (unsigned)__builtin_amdgcn_s_getreg((3 << 11) | 20) & 0xFu; }
#define XB_SPIN(cond, bar) do { unsigned _sp = 0; while (cond) { __builtin_amdgcn_s_sleep(1); \
    if ((++_sp & 255u) == 0u) { if (xb_ld(&(bar)[XB_TMO])) break; if (_sp > XB_SPIN_CAP) { atomicAdd(&(bar)[XB_TMO], 1u); break; } } } } while (0)

struct XcdBarrier {
    unsigned* bar; unsigned x;
    volatile LAS unsigned* st;
};

__device__ __forceinline__ XcdBarrier xcd_barrier_post(unsigned* bar, volatile LAS unsigned* st) {
    XcdBarrier b; b.bar = bar; b.x = xb_xcc_id(); b.st = st;
    if (threadIdx.x == 0) (void)xb_add(&bar[XB_XCNT(b.x)], 1u);
    return b;
}
__device__ __forceinline__ void xcd_barrier_complete(unsigned* bar, unsigned x, unsigned& nloc, unsigned& nx) {
    const unsigned G = gridDim.x * gridDim.y * gridDim.z;
    unsigned sum, cnt, mine, sp = 0u;
    for (;;) {
        sum = 0u; cnt = 0u; mine = 0u;
#pragma unroll
        for (unsigned j = 0; j < 16; ++j) { const unsigned c = xb_ld(&bar[XB_XCNT(j)]); sum += c; cnt += (c > 0u) ? 1u : 0u; mine = (j == x) ? c : mine; }
        if (sum == G) break;
        __builtin_amdgcn_s_sleep(1);
        if ((++sp & 255u) == 0u) { if (xb_ld(&bar[XB_TMO])) break; if (sp > XB_SPIN_CAP) { atomicAdd(&bar[XB_TMO], 1u); break; } }
    }
    nloc = mine > 0u ? mine : 1u; nx = cnt > 0u ? cnt : 1u;
}

__device__ __forceinline__ void xcd_barrier(const XcdBarrier& b) {
    asm volatile("s_waitcnt vmcnt(0)" ::: "memory");
    __syncthreads();
    if (threadIdx.x == 0) {
        unsigned* bar = b.bar;
        __builtin_amdgcn_s_waitcnt(0);
        unsigned nloc = b.st[0], nx = b.st[1];
        if (nloc == 0u) { xcd_barrier_complete(bar, b.x, nloc, nx); b.st[0] = nloc; b.st[1] = nx; }
        const unsigned old = xb_add(&bar[XB_XSUB(b.x)], 1u);
        const unsigned gen = old / nloc;
        if (old + 1u == (gen + 1u) * nloc) {
            __builtin_amdgcn_fence(__ATOMIC_RELEASE, "agent");
            asm volatile("s_waitcnt vmcnt(0)" ::: "memory");
            const unsigned og = xb_add(&bar[XB_TOP], 1u);
            const unsigned tg = og / nx;
            if (og + 1u == (tg + 1u) * nx) xb_add(&bar[XB_TOPGEN], 1u);
            else XB_SPIN(xb_ld(&bar[XB_TOPGEN]) == tg, bar);
            __builtin_amdgcn_fence(__ATOMIC_ACQUIRE, "agent");
            xb_add(&bar[XB_XGEN(b.x)], 1u);
            asm volatile("s_waitcnt vmcnt(0)" ::: "memory");
        } else {
            XB_SPIN(xb_ld(&bar[XB_XGEN(b.x)]) == gen, bar);
            __builtin_amdgcn_fence(__ATOMIC_ACQUIRE, "agent");
            asm volatile("s_waitcnt vmcnt(0)" ::: "memory");
        }
    }
    __syncthreads();
}

constexpr int NWAVES = 8;
constexpr int M = 16384, D = 1024, DFF = 2816, INA = 3080, NC = 256;
constexpr float RMS_EPS = 1e-6f;
constexpr float LOG2E = 1.4426950408889634f;
constexpr float QSCALE_A = 0.08838834764831845f;
constexpr float C2 = 0.125f * LOG2E;

constexpr size_t MiB = 1u << 20;
constexpr size_t WS_CTL = 0, CTL_ZERO_BYTES = 1 * MiB;
constexpr size_t WS_SSP = 1 * MiB;
constexpr size_t WS_GATES = WS_SSP + 256 * 1024;
constexpr size_t WS_NST = 2 * MiB;
constexpr size_t WS_CH = WS_NST + 512 * 1024;
constexpr size_t WS_MS = WS_CH + 16 * 1024;
constexpr size_t WS_WGT = WS_MS + 16 * 1024;
constexpr size_t WS_BQ = WS_WGT + 64 * 1024;
constexpr size_t WS_WIN = 3 * MiB;
constexpr size_t WS_WOUT = 15 * MiB;
constexpr size_t WS_WQ2 = 19 * MiB;
constexpr size_t WS_WQ3 = WS_WQ2 + 1280 * 1024 * 2;
constexpr size_t WS_WBO = 24 * MiB;
constexpr size_t WS_WGU = 28 * MiB;
constexpr size_t WS_WD = 72 * MiB;
constexpr size_t WS_XB = 94 * MiB;
constexpr size_t WS_PROJ = 126 * MiB;
constexpr size_t WS_KV = 222 * MiB;
constexpr size_t WS_HG = 230 * MiB;
constexpr size_t WS_STATE = 262 * MiB;
constexpr size_t WS_END = 326 * MiB;
constexpr int CW_BAR = 4096;

constexpr int RING_OFF = 0, RING_BYTES = 131072;
constexpr int LDSCTL_OFF = RING_BYTES, MISC_OFF = LDSCTL_OFF + 320;
constexpr int LDS_BYTES = 147456;

typedef float f32x2 __attribute__((ext_vector_type(2)));
typedef unsigned u32x2 __attribute__((ext_vector_type(2)));
__device__ __forceinline__ float bf2f(unsigned short b) { return __builtin_bit_cast(float, (unsigned)b << 16); }
__device__ __forceinline__ float bflo(unsigned w) { return __builtin_bit_cast(float, w << 16); }
__device__ __forceinline__ float bfhi(unsigned w) { return __builtin_bit_cast(float, w & 0xffff0000u); }
__device__ __forceinline__ float wave_sum(float v) {
#pragma unroll
    for (int o = 1; o < 64; o <<= 1) v += __shfl_xor(v, o);
    return v;
}
__device__ __forceinline__ float rstd_of(const float* ssp, int row) { const f32x4 p = *(const f32x4*)(ssp + (size_t)row * 4); return rsqrtf(((p.x + p.y) + (p.z + p.w)) * (1.f / D) + RMS_EPS); }

struct EpiProj {
    static constexpr bool PERM = true, AFTER_DRAIN = false;
    bf16* O0; int ld0; bf16* O1; int ld1; int split; const float* bias; const float* ssp;
    __device__ __forceinline__ void operator()(const pg8::f32x4 (&acc)[2][2][4][2], const pg8::Unit& u, int wr, int wc, int fr, int fq) const {
        const int row0 = u.pm * 256 + wr * 64 + fr; int colt = u.pn * 256; bf16* base = O0; int ld = ld0;
        if (split && colt >= split) { base = O1; ld = ld1; colt -= split; }
        const int col0 = colt + wc * 32 + 8 * fq, bcol0 = u.pn * 256 + wc * 32 + 8 * fq;
        f32x4 bv[2][2];
#pragma unroll
        for (int bj = 0; bj < 2; ++bj)
#pragma unroll
            for (int n = 0; n < 2; ++n) bv[bj][n] = bias ? *(const f32x4*)(bias + bcol0 + bj * 128 + 4 * n) : (f32x4){0.f, 0.f, 0.f, 0.f};
#pragma unroll
        for (int ai = 0; ai < 2; ++ai)
#pragma unroll
            for (int m = 0; m < 4; ++m) { const int r = row0 + ai * 128 + m * 16; const float rs = rstd_of(ssp, r); bf16* rowp = base + (size_t)r * ld + col0;
#pragma unroll
                for (int bj = 0; bj < 2; ++bj) { const f32x4 v0 = acc[ai][bj][m][0] * rs + bv[bj][0], v1 = acc[ai][bj][m][1] * rs + bv[bj][1];
                    v4u w; w.x = pg8::cvt_pk_bf16(v0[0], v0[1]); w.y = pg8::cvt_pk_bf16(v0[2], v0[3]); w.z = pg8::cvt_pk_bf16(v1[0], v1[1]); w.w = pg8::cvt_pk_bf16(v1[2], v1[3]);
                    *(v4u*)(rowp + bj * 128) = w; } }
    }
};
__device__ __forceinline__ float silu_mul(float g, float u) { return g * __builtin_amdgcn_rcpf(1.f + __builtin_amdgcn_exp2f(-g * LOG2E)) * u; }
struct EpiSwiglu {
    static constexpr bool PERM = true, AFTER_DRAIN = false;
    bf16* H; const float* ssp;
    __device__ __forceinline__ void operator()(const pg8::f32x4 (&acc)[2][2][4][2], const pg8::Unit& u, int wr, int wc, int fr, int fq) const {
        const int row0 = u.pm * 256 + wr * 64 + fr, col0 = u.pn * 128 + wc * 32 + 8 * fq;
#pragma unroll
        for (int ai = 0; ai < 2; ++ai)
#pragma unroll
            for (int m = 0; m < 4; ++m) { const int r = row0 + ai * 128 + m * 16; const float rs = rstd_of(ssp, r);
                const f32x4 g0 = acc[ai][0][m][0] * rs, g1 = acc[ai][0][m][1] * rs, u0 = acc[ai][1][m][0] * rs, u1 = acc[ai][1][m][1] * rs;
                v4u w; w.x = pg8::cvt_pk_bf16(silu_mul(g0[0], u0[0]), silu_mul(g0[1], u0[1])); w.y = pg8::cvt_pk_bf16(silu_mul(g0[2], u0[2]), silu_mul(g0[3], u0[3]));
                w.z = pg8::cvt_pk_bf16(silu_mul(g1[0], u1[0]), silu_mul(g1[1], u1[1])); w.w = pg8::cvt_pk_bf16(silu_mul(g1[2], u1[2]), silu_mul(g1[3], u1[3]));
                *(v4u*)(H + (size_t)r * DFF + col0) = w; }
    }
};
struct EpiResid {
    static constexpr bool PERM = false, AFTER_DRAIN = true;
    const float* base; float* out; bf16* xb; const float* bias; float* ssp;
    __device__ __forceinline__ void fused(pg8::f32x4 (&acc)[2][2][4][2], const pg8::Unit& u, int wr, int wc, int fr, int fq, PG8_LAS unsigned char* lds, int wid, int lane) const {
        PG8_LAS float* P = (PG8_LAS float*)lds;
        const int col0 = u.pn * 256 + wc * 32 + 4 * fq;
#pragma unroll
        for (int ai = 0; ai < 2; ++ai)
#pragma unroll
            for (int m = 0; m < 4; ++m) { const int rl = ai * 128 + wr * 64 + m * 16 + fr; const size_t off = (size_t)(u.pm * 256 + rl) * D + col0; float ss = 0.f;
#pragma unroll
                for (int bj = 0; bj < 2; ++bj)
#pragma unroll
                    for (int n = 0; n < 2; ++n) { const size_t c = off + bj * 128 + n * 16; f32x4 v = *(const f32x4*)(base + c) + acc[ai][bj][m][n];
                        if (bias) v = v + *(const f32x4*)(bias + col0 + bj * 128 + n * 16);
                        *(f32x4*)(out + c) = v; u32x2 w; w.x = pg8::cvt_pk_bf16(v[0], v[1]); w.y = pg8::cvt_pk_bf16(v[2], v[3]); *(u32x2*)(xb + c) = w;
                        ss += (v[0] * v[0] + v[1] * v[1]) + (v[2] * v[2] + v[3] * v[3]); }
                ss += __shfl_xor(ss, 16); ss += __shfl_xor(ss, 32);
                if (fq == 0) P[rl * 4 + wc] = ss;
                if (m & 1) asm volatile("" ::: "memory"); }
        asm volatile("s_waitcnt lgkmcnt(0)" ::: "memory"); __builtin_amdgcn_s_barrier(); asm volatile("" ::: "memory");
        const int tid = wid * 64 + lane;
        if (tid < 256) { const f32x4 p = *(const PG8_LAS f32x4*)(P + tid * 4); ssp[(size_t)(u.pm * 256 + tid) * 4 + u.pn] = (p.x + p.y) + (p.z + p.w); }
        asm volatile("s_waitcnt lgkmcnt(0)" ::: "memory"); __builtin_amdgcn_s_barrier(); asm volatile("" ::: "memory");
    }
};

struct Frame {
    LAS unsigned char* lds;
    volatile LAS unsigned* MISC;
    gu32* ctl;
    int tid, lane, wave;
    int vcu, G;
};
struct Args { const float* in[19]; float* out; unsigned char* ws; };

#define LAUNDER_TID(F) do { int l_ = (int)__builtin_amdgcn_mbcnt_hi(~0u, __builtin_amdgcn_mbcnt_lo(~0u, 0u)); asm volatile("" : "+v"(l_)); (F).lane = l_; (F).tid = (F).wave * 64 + l_; } while (0)
__device__ __forceinline__ void conv_item(const float* W, int ldw, int K, int nblk, const float* gain, float qscale, int qcols, bf16* WT, int rowmode, int row_off, LAS float* scr, int item, int lane) {
    const int kb = item / nblk, nb = item % nblk, k0 = 64 * kb, n0 = 32 * nb;
    const float ns = (n0 < qcols) ? qscale : 1.f;
    {
        f32x4 wv[8];
#pragma unroll
        for (int i = 0; i < 8; ++i) wv[i] = *(const f32x4*)(W + (size_t)(k0 + 8 * i + (lane >> 3)) * ldw + n0 + 4 * (lane & 7));
#pragma unroll
        for (int i = 0; i < 8; ++i) { const int kk = 8 * i + (lane >> 3); const float gk = gain ? gain[k0 + kk] * ns : ns; LAS float* d = scr + kk * 33 + 4 * (lane & 7);
            d[0] = wv[i].x * gk; d[1] = wv[i].y * gk; d[2] = wv[i].z * gk; d[3] = wv[i].w * gk; }
    }
    LDS_WAIT(); asm volatile("" ::: "memory");
    int rbase;
    if (rowmode == 0) rbase = row_off + n0;
    else { int j = n0, add = 0; if (j >= DFF) { j -= DFF; add = 128; } rbase = 256 * (j / 128) + add + (j % 128); }
    const int c = lane & 7;
#pragma unroll
    for (int j = 0; j < 4; ++j) { const int n = (lane >> 3) + 8 * j; const LAS float* s = scr + (8 * c) * 33 + n;
        v4u o; o.x = pk2(s[0 * 33], s[1 * 33]); o.y = pk2(s[2 * 33], s[3 * 33]); o.z = pk2(s[4 * 33], s[5 * 33]); o.w = pk2(s[6 * 33], s[7 * 33]);
        *(GAS v4u*)(WT + (size_t)(rbase + n) * K + k0 + 8 * c) = o; }
    LDS_WAIT(); asm volatile("" ::: "memory");
}
__device__ __forceinline__ void p0_prologue(Frame& F, const Args& A) {
    LAUNDER_TID(F);
    LAS float* scr = (LAS float*)(F.lds + RING_OFF + F.wave * 16384);
    const int gw = F.vcu * NWAVES + F.wave, NGW = F.G * NWAVES;
    unsigned char* ws = A.ws;
    const float* a_norm = A.in[1]; const float* a_w_in = A.in[2]; const float* a_w_out = A.in[5]; const float* kv_norm = A.in[6]; const float* w_kv = A.in[7]; const float* b_kv = A.in[8];
    const float* b_norm = A.in[9]; const float* b_w_q = A.in[10]; const float* b_b_q = A.in[11]; const float* b_w_out = A.in[13]; const float* ffn_norm = A.in[15];
    const float* w_gate_up = A.in[16]; const float* w_down = A.in[17];
    constexpr int I_IN = 16 * 96, I_SQ = 16 * 32, I_KV = 16 * 8, I_GU = 16 * 176, I_DN = 44 * 32;
    constexpr int NITEMS = 2 * I_IN + 2 * I_SQ + (I_SQ + I_KV + I_SQ) + 2 * I_SQ + 4 * I_GU + 4 * I_DN;
    for (int it = gw; it < NITEMS; it += NGW) {
        int r = it;
        if (r < 2 * I_IN) { const int l = r / I_IN; r -= l * I_IN; conv_item(a_w_in + (size_t)l * D * INA, INA, D, 96, a_norm + l * D, QSCALE_A, 512, (bf16*)(ws + WS_WIN) + (size_t)l * 3072 * D, 0, 0, scr, r, F.lane); continue; } r -= 2 * I_IN;
        if (r < 2 * I_SQ) { const int l = r / I_SQ; r -= l * I_SQ; conv_item(a_w_out + (size_t)l * D * D, D, D, 32, nullptr, 1.f, 0, (bf16*)(ws + WS_WOUT) + (size_t)l * D * D, 0, 0, scr, r, F.lane); continue; } r -= 2 * I_SQ;
        if (r < I_SQ) { conv_item(b_w_q, D, D, 32, b_norm, C2, 1024, (bf16*)(ws + WS_WQ2), 0, 0, scr, r, F.lane); continue; } r -= I_SQ;
        if (r < I_KV) { conv_item(w_kv, 256, D, 8, kv_norm, 1.f, 0, (bf16*)(ws + WS_WQ2), 0, 1024, scr, r, F.lane); continue; } r -= I_KV;
        if (r < I_SQ) { conv_item(b_w_q + (size_t)D * D, D, D, 32, b_norm + D, C2, 1024, (bf16*)(ws + WS_WQ3), 0, 0, scr, r, F.lane); continue; } r -= I_SQ;
        if (r < 2 * I_SQ) { const int l = r / I_SQ; r -= l * I_SQ; conv_item(b_w_out + (size_t)l * D * D, D, D, 32, nullptr, 1.f, 0, (bf16*)(ws + WS_WBO) + (size_t)l * D * D, 0, 0, scr, r, F.lane); continue; } r -= 2 * I_SQ;
        if (r < 4 * I_GU) { const int l = r / I_GU; r -= l * I_GU; conv_item(w_gate_up + (size_t)l * D * 2 * DFF, 2 * DFF, D, 176, ffn_norm + l * D, 1.f, 0, (bf16*)(ws + WS_WGU) + (size_t)l * 2 * DFF * D, 1, 0, scr, r, F.lane); continue; } r -= 4 * I_GU;
        { const int l = r / I_DN; r -= l * I_DN; conv_item(w_down + (size_t)l * DFF * D, D, DFF, 32, nullptr, 1.f, 0, (bf16*)(ws + WS_WD) + (size_t)l * D * DFF, 0, 0, scr, r, F.lane); }
    }
    const float* x = A.in[0]; bf16* XB = (bf16*)(ws + WS_XB); float* SSP = (float*)(ws + WS_SSP);
    for (int m = gw; m < M; m += NGW) {
        const GAS f32x4* xr = (const GAS f32x4*)(x + (size_t)m * D) + F.lane; GAS u32x2* o8 = (GAS u32x2*)(XB + (size_t)m * D) + F.lane; float s = 0.f;
#pragma unroll
        for (int j = 0; j < 4; ++j) { const f32x4 v = xr[64 * j]; s += (v.x * v.x + v.y * v.y) + (v.z * v.z + v.w * v.w); u32x2 w; w.x = pk2(v.x, v.y); w.y = pk2(v.z, v.w); o8[64 * j] = w; }
        s = wave_sum(s);
        if (F.lane == 0) *(f32x4*)(SSP + (size_t)m * 4) = (f32x4){s, 0.f, 0.f, 0.f};
    }
    const int gt = F.vcu * (NWAVES * 64) + F.tid, NGT = F.G * NWAVES * 64;
    float* WGT = (float*)(ws + WS_WGT); float* BQ = (float*)(ws + WS_BQ);
    for (int i = gt; i < 2 * 8 * 1024; i += NGT) { const int l = i >> 13, j = (i >> 10) & 7, k = i & 1023; WGT[i] = a_w_in[(size_t)l * D * INA + (size_t)k * INA + 3072 + j] * a_norm[l * D + k]; }
    for (int i = gt; i < 2 * 1280; i += NGT) { const int l = i / 1280, c = i % 1280; BQ[i] = (c < 1024) ? b_b_q[l * D + c] * C2 : b_kv[c - 1024]; }
}

__device__ __forceinline__ float softcap15(float x) { return 15.f * tanhf(x * (1.f / 15.f)); }
__device__ __forceinline__ float logsigmoidf(float x) { return fminf(x, 0.f) - log1pf(expf(-fabsf(x))); }

__device__ __forceinline__ void gates_phase(Frame& F, const bf16* XB, const float* SSP, const float* WGTl, const float* bgl, float* GATES) {
    LAUNDER_TID(F);
    LAS float* Wl = (LAS float*)(F.lds + RING_OFF);
    for (int i = F.tid; i < 8 * 1024 / 4; i += NWAVES * 64) ((LAS f32x4*)Wl)[i] = ((const f32x4*)WGTl)[i];
    __syncthreads();
    for (int blk = F.vcu; blk < M / 64; blk += F.G) {
#pragma unroll 1
        for (int rr = 0; rr < 8; ++rr) {
            const int row = blk * 64 + F.wave * 8 + rr;
            float acc[8] = {0.f, 0.f, 0.f, 0.f, 0.f, 0.f, 0.f, 0.f};
#pragma unroll
            for (int i = 0; i < 4; ++i) { const int k = 4 * F.lane + 256 * i; const u32x2 xw = *(const u32x2*)(XB + (size_t)row * D + k);
                const float x0 = bflo(xw.x), x1 = bfhi(xw.x), x2 = bflo(xw.y), x3 = bfhi(xw.y);
#pragma unroll
                for (int j = 0; j < 8; ++j) { const f32x4 w = *(const LAS f32x4*)(Wl + j * 1024 + k); acc[j] += (x0 * w.x + x1 * w.y) + (x2 * w.z + x3 * w.w); } }
#pragma unroll
            for (int j = 0; j < 8; ++j) acc[j] = wave_sum(acc[j]);
            if (F.lane < 8) { float a = acc[0];
#pragma unroll
                for (int j = 1; j < 8; ++j) a = (F.lane == j) ? acc[j] : a;
                const float pre = softcap15(a * rstd_of(SSP, row) + bgl[F.lane]);
                GATES[(size_t)row * 8 + F.lane] = (F.lane < 4) ? pre : logsigmoidf(pre); }
        }
    }
    __syncthreads();
}

__device__ __forceinline__ void chunk_gates(Frame& F, const float* GATES, int c, int h, LAS float* bcum, LAS float* aval) {
    if (F.tid < 64) {
        const float lf = GATES[(size_t)(c * 64 + F.tid) * 8 + 4 + h], ig = GATES[(size_t)(c * 64 + F.tid) * 8 + h];
        float s = lf;
#pragma unroll
        for (int o = 1; o < 64; o <<= 1) { const float t = __shfl_up(s, o); if (F.lane >= o) s += t; }
        bcum[F.tid] = s; aval[F.tid] = ig - s;
    }
    __syncthreads();
}

__device__ __forceinline__ void ml_local_phase(Frame& F, const bf16* PROJ, const float* GATES, bf16* STATE, float* NST, float* CH) {
    LAUNDER_TID(F);
    LAS float* bcum = (LAS float*)(F.lds + RING_OFF); LAS float* aval = bcum + 64; LAS float* wsv = aval + 64;
    for (int unit = F.vcu; unit < NC * 4; unit += F.G) {
        const int c = unit >> 2, h = unit & 3;
        chunk_gates(F, GATES, c, h, bcum, aval);
        const float btot = bcum[63]; float amax = -INFINITY;
        for (int s = 0; s < 64; ++s) amax = fmaxf(amax, aval[s]);
        const float mloc = btot + amax;
        if (F.tid < 64) wsv[F.tid] = expf(btot + aval[F.tid] - mloc);
        __syncthreads();
        const bf16* kb = PROJ + (size_t)(c * 64) * 3072 + 512 + h * 128;
        const bf16* vb = PROJ + (size_t)(c * 64) * 3072 + 1024 + h * 256;
        const int v = F.tid >> 1, dh = F.tid & 1;
        float acc[64];
#pragma unroll
        for (int j = 0; j < 64; ++j) acc[j] = 0.f;
#pragma unroll 1
        for (int s = 0; s < 64; ++s) {
            const float wv = wsv[s] * bf2f(vb[(size_t)s * 3072 + v]);
            const v4u* kr = (const v4u*)(kb + (size_t)s * 3072 + dh * 64);
#pragma unroll
            for (int q = 0; q < 8; ++q) { const v4u kk = kr[q];
                acc[q * 8 + 0] += wv * bflo(kk.x); acc[q * 8 + 1] += wv * bfhi(kk.x); acc[q * 8 + 2] += wv * bflo(kk.y); acc[q * 8 + 3] += wv * bfhi(kk.y);
                acc[q * 8 + 4] += wv * bflo(kk.z); acc[q * 8 + 5] += wv * bfhi(kk.z); acc[q * 8 + 6] += wv * bflo(kk.w); acc[q * 8 + 7] += wv * bfhi(kk.w); }
        }
        bf16* st = STATE + ((size_t)(c * 4 + h) * 256 + v) * 128 + dh * 64;
#pragma unroll
        for (int q = 0; q < 8; ++q) { v4u o; o.x = pk2(acc[q * 8 + 0], acc[q * 8 + 1]); o.y = pk2(acc[q * 8 + 2], acc[q * 8 + 3]); o.z = pk2(acc[q * 8 + 4], acc[q * 8 + 5]); o.w = pk2(acc[q * 8 + 6], acc[q * 8 + 7]); *(v4u*)(st + q * 8) = o; }
        if (F.tid < 128) { float a = 0.f; for (int s = 0; s < 64; ++s) a += wsv[s] * bf2f(kb[(size_t)s * 3072 + F.tid]); NST[(size_t)(c * 4 + h) * 128 + F.tid] = a; }
        if (F.tid == 0) { CH[(c * 4 + h) * 2] = btot; CH[(c * 4 + h) * 2 + 1] = mloc; }
        __syncthreads();
    }
}

__device__ __forceinline__ void ml_scan_phase(Frame& F, bf16* STATE, float* NST, const float* CH, float* MS) {
    LAUNDER_TID(F);
    LAS float* f1 = (LAS float*)(F.lds + RING_OFF); LAS float* f2 = f1 + 256;
    const int h = F.vcu >> 6;
    if (F.tid < 64) {
        float bt[4], ml[4];
#pragma unroll
        for (int j = 0; j < 4; ++j) { const int c = 4 * F.lane + j; bt[j] = CH[(c * 4 + h) * 2]; ml[j] = CH[(c * 4 + h) * 2 + 1]; }
        float B = bt[0], Mx = ml[0];
#pragma unroll
        for (int j = 1; j < 4; ++j) { Mx = fmaxf(Mx + bt[j], ml[j]); B += bt[j]; }
#pragma unroll
        for (int o = 1; o < 64; o <<= 1) { const float Bp = __shfl_up(B, o), Mp = __shfl_up(Mx, o); if (F.lane >= o) { Mx = fmaxf(Mp + B, Mx); B = Bp + B; } }
        const float Bq = __shfl_up(B, 1), Mq = __shfl_up(Mx, 1);
        float m = (F.lane == 0) ? 0.f : fmaxf(Bq, Mq);
#pragma unroll
        for (int j = 0; j < 4; ++j) { const int c = 4 * F.lane + j; const float mn = fmaxf(bt[j] + m, ml[j]);
            f1[c] = expf(bt[j] + m - mn); f2[c] = expf(ml[j] - mn); if ((F.vcu & 63) == 0) MS[c * 4 + h] = m; m = mn; }
    }
    __syncthreads();
    if (F.tid < 256) {
        unsigned* base = (unsigned*)(STATE + (size_t)h * 32768) + ((F.vcu & 63) * 256 + F.tid);
        float c0v = 0.f, c1v = 0.f;
#pragma unroll 1
        for (int cb = 0; cb < NC; cb += 16) {
            unsigned u[16];
#pragma unroll
            for (int j = 0; j < 16; ++j) u[j] = base[(size_t)(cb + j) * 65536];
#pragma unroll
            for (int j = 0; j < 16; ++j) { const float a = f1[cb + j], b = f2[cb + j];
                base[(size_t)(cb + j) * 65536] = pg8::cvt_pk_bf16(c0v, c1v);
                c0v = a * c0v + b * bflo(u[j]); c1v = a * c1v + b * bfhi(u[j]); }
        }
    } else if ((F.vcu & 63) == 0 && F.tid < 384) {
        float* base = NST + h * 128 + (F.tid - 256); float nv = 0.f;
#pragma unroll 1
        for (int cb = 0; cb < NC; cb += 8) {
            float u[8];
#pragma unroll
            for (int j = 0; j < 8; ++j) u[j] = base[(size_t)(cb + j) * 512];
#pragma unroll
            for (int j = 0; j < 8; ++j) { base[(size_t)(cb + j) * 512] = nv; nv = f1[cb + j] * nv + f2[cb + j] * u[j]; }
        }
    }
    __syncthreads();
}

__device__ __forceinline__ void ml_out_phase(Frame& F, const bf16* PROJ, const float* GATES, const bf16* STATE, const float* NST, const float* MS, const float* hnorm, bf16* HG) {
    LAUNDER_TID(F);
    LAS float* bcum = (LAS float*)(F.lds + RING_OFF); LAS float* aval = bcum + 64; LAS float* mt = aval + 64; LAS float* et = mt + 64; LAS float* den = et + 64; LAS float* nq = den + 64;
    LAS float* red = nq + 64;
    LAS float* S = red + 64;
    const float scale = 1.f;
    for (int unit = F.vcu; unit < NC * 4; unit += F.G) {
        const int c = unit >> 2, h = unit & 3;
        chunk_gates(F, GATES, c, h, bcum, aval);
        const float mc = MS[c * 4 + h];
        if (F.tid < 64) { float am = -INFINITY; for (int s = 0; s <= F.tid; ++s) am = fmaxf(am, aval[s]); const float m_t = bcum[F.tid] + fmaxf(mc, am); mt[F.tid] = m_t; et[F.tid] = expf(bcum[F.tid] + mc - m_t); }
        __syncthreads();
        const bf16* qb = PROJ + (size_t)(c * 64) * 3072 + h * 128;
        const bf16* kb = PROJ + (size_t)(c * 64) * 3072 + 512 + h * 128;
        const bf16* vb = PROJ + (size_t)(c * 64) * 3072 + 1024 + h * 256;
        {
            const int t = F.tid >> 3;
#pragma unroll 1
            for (int j = 0; j < 8; ++j) { const int s = (F.tid & 7) * 8 + j; float a = 0.f;
                if (s <= t) { const v4u* qr = (const v4u*)(qb + (size_t)t * 3072); const v4u* kr = (const v4u*)(kb + (size_t)s * 3072);
#pragma unroll 4
                    for (int q = 0; q < 16; ++q) { const v4u a4 = qr[q], b4 = kr[q];
                        a += bflo(a4.x) * bflo(b4.x) + bfhi(a4.x) * bfhi(b4.x) + bflo(a4.y) * bflo(b4.y) + bfhi(a4.y) * bfhi(b4.y) + bflo(a4.z) * bflo(b4.z) + bfhi(a4.z) * bfhi(b4.z) + bflo(a4.w) * bflo(b4.w) + bfhi(a4.w) * bfhi(b4.w); }
                    a *= scale * expf(bcum[t] + aval[s] - mt[t]); }
                S[t * 65 + s] = a; }
        }
        if (F.tid < 64) { float a = 0.f; const float* nn = NST + (size_t)(c * 4 + h) * 128; for (int d = 0; d < 128; ++d) a += nn[d] * bf2f(qb[(size_t)F.tid * 3072 + d]); nq[F.tid] = a * scale; }
        __syncthreads();
        if (F.tid < 64) { float a = 0.f; for (int s = 0; s < 64; ++s) a += S[F.tid * 65 + s]; a += et[F.tid] * nq[F.tid]; den[F.tid] = fmaxf(fabsf(a), expf(-mt[F.tid])); }
        __syncthreads();
        const int v = F.tid & 255, th = F.tid >> 8;
        v4u Cc[16];
        { const v4u* st = (const v4u*)(STATE + ((size_t)(c * 4 + h) * 256 + v) * 128);
#pragma unroll
          for (int q = 0; q < 16; ++q) Cc[q] = st[q]; }
        const float gain = hnorm[h * 256 + v];
#pragma unroll 1
        for (int tt = 0; tt < 32; ++tt) {
            const int t = th * 32 + tt;
            float a = 0.f;
            for (int s = 0; s <= t; ++s) a += S[t * 65 + s] * bf2f(vb[(size_t)s * 3072 + v]);
            float b = 0.f; const v4u* qr = (const v4u*)(qb + (size_t)t * 3072);
#pragma unroll
            for (int q = 0; q < 16; ++q) { const v4u a4 = qr[q], b4 = Cc[q];
                b += bflo(a4.x) * bflo(b4.x) + bfhi(a4.x) * bfhi(b4.x) + bflo(a4.y) * bflo(b4.y) + bfhi(a4.y) * bfhi(b4.y) + bflo(a4.z) * bflo(b4.z) + bfhi(a4.z) * bfhi(b4.z) + bflo(a4.w) * bflo(b4.w) + bfhi(a4.w) * bfhi(b4.w); }
            const float hv = (a + et[t] * scale * b) / den[t];
            const float ss = wave_sum(hv * hv);
            __syncthreads();
            if (F.lane == 0) red[F.wave] = ss;
            __syncthreads();
            const float tot = (red[th * 4] + red[th * 4 + 1]) + (red[th * 4 + 2] + red[th * 4 + 3]);
            const float r = rsqrtf(tot * (1.f / 256.f) + RMS_EPS);
            const size_t row = (size_t)(c * 64 + t);
            const float o = bf2f(PROJ[row * 3072 + 2048 + h * 256 + v]);
            HG[row * D + h * 256 + v] = (bf16)f2bf(hv * r * gain / (1.f + expf(-o)));
        }
        __syncthreads();
    }
}

__device__ __forceinline__ void attn_phase(Frame& F, const bf16* Q, const bf16* KV, const float* sinks, bf16* O) {
    LAUNDER_TID(F);
    for (int unit = F.vcu; unit < 128 * 16; unit += F.G) {
        const int nb = unit >> 4, head = unit & 15, kvh = head >> 3;
        const int i = F.tid >> 2, part = F.tid & 3;
        const int qpos = nb * 128 + i;
        float q[16], o[16];
        { const v4u* qr = (const v4u*)(Q + (size_t)qpos * D + head * 64 + part * 16);
#pragma unroll
          for (int w = 0; w < 2; ++w) { const v4u a = qr[w]; q[w * 8 + 0] = bflo(a.x); q[w * 8 + 1] = bfhi(a.x); q[w * 8 + 2] = bflo(a.y); q[w * 8 + 3] = bfhi(a.y); q[w * 8 + 4] = bflo(a.z); q[w * 8 + 5] = bfhi(a.z); q[w * 8 + 6] = bflo(a.w); q[w * 8 + 7] = bfhi(a.w); } }
        float m = sinks[head] * LOG2E, l = 1.f;
#pragma unroll
        for (int d = 0; d < 16; ++d) o[d] = 0.f;
        const int j0 = (nb == 0) ? 128 : 0;
#pragma unroll 1
        for (int j = j0; j < 256; ++j) {
            const int kpos = (nb - 1) * 128 + j;
            const int rel = i + 128 - j;
            const bool valid = (rel >= 0) && (rel < 128);
            const v4u* kr = (const v4u*)(KV + (size_t)kpos * 256 + kvh * 64 + part * 16);
            const v4u* vr = (const v4u*)(KV + (size_t)kpos * 256 + 128 + kvh * 64 + part * 16);
            float kf[16], vf[16];
#pragma unroll
            for (int w = 0; w < 2; ++w) { const v4u a = kr[w]; kf[w * 8 + 0] = bflo(a.x); kf[w * 8 + 1] = bfhi(a.x); kf[w * 8 + 2] = bflo(a.y); kf[w * 8 + 3] = bfhi(a.y); kf[w * 8 + 4] = bflo(a.z); kf[w * 8 + 5] = bfhi(a.z); kf[w * 8 + 6] = bflo(a.w); kf[w * 8 + 7] = bfhi(a.w);
                const v4u b = vr[w]; vf[w * 8 + 0] = bflo(b.x); vf[w * 8 + 1] = bfhi(b.x); vf[w * 8 + 2] = bflo(b.y); vf[w * 8 + 3] = bfhi(b.y); vf[w * 8 + 4] = bflo(b.z); vf[w * 8 + 5] = bfhi(b.z); vf[w * 8 + 6] = bflo(b.w); vf[w * 8 + 7] = bfhi(b.w); }
            float s = 0.f;
#pragma unroll
            for (int d = 0; d < 16; ++d) s += q[d] * kf[d];
            s += __shfl_xor(s, 1); s += __shfl_xor(s, 2);
            if (valid) {
                const float mn = fmaxf(m, s), corr = __builtin_amdgcn_exp2f(m - mn), p = __builtin_amdgcn_exp2f(s - mn);
                l = l * corr + p;
#pragma unroll
                for (int d = 0; d < 16; ++d) o[d] = o[d] * corr + p * vf[d];
                m = mn;
            }
        }
        const float inv = 1.f / l;
        v4u w0, w1;
        w0.x = pk2(o[0] * inv, o[1] * inv); w0.y = pk2(o[2] * inv, o[3] * inv); w0.z = pk2(o[4] * inv, o[5] * inv); w0.w = pk2(o[6] * inv, o[7] * inv);
        w1.x = pk2(o[8] * inv, o[9] * inv); w1.y = pk2(o[10] * inv, o[11] * inv); w1.z = pk2(o[12] * inv, o[13] * inv); w1.w = pk2(o[14] * inv, o[15] * inv);
        v4u* op = (v4u*)(O + (size_t)qpos * D + head * 64 + part * 16); op[0] = w0; op[1] = w1;
    }
}

__device__ __forceinline__ void final_norm_phase(Frame& F, float* X, const float* SSP, const float* g) {
    LAUNDER_TID(F);
    const int gw = F.vcu * NWAVES + F.wave, NGW = F.G * NWAVES;
    for (int m = gw; m < M; m += NGW) {
        const float rs = rstd_of(SSP, m);
        GAS f32x4* xr = (GAS f32x4*)(X + (size_t)m * D) + F.lane; const f32x4* gg = (const f32x4*)g + F.lane;
#pragma unroll
        for (int j = 0; j < 4; ++j) { const f32x4 v = xr[64 * j], w = gg[64 * j]; xr[64 * j] = v * rs * w; }
    }
}


typedef float f32x16 __attribute__((ext_vector_type(16)));
typedef short s16x4 __attribute__((ext_vector_type(4)));
typedef short v4i16_t __attribute__((ext_vector_type(4)));
__device__ __forceinline__ s16x4 tr16(const LAS unsigned char* p) { return __builtin_bit_cast(s16x4, __builtin_amdgcn_ds_read_tr16_b64_v4i16((LAS v4i16_t*)p)); }
__device__ __forceinline__ bf16x8 cat8(s16x4 a, s16x4 b) { return (bf16x8){a[0], a[1], a[2], a[3], b[0], b[1], b[2], b[3]}; }
__device__ __forceinline__ unsigned cvtpk(float lo, float hi) { return pg8::cvt_pk_bf16(lo, hi); }
__device__ __forceinline__ bf16x8 pack8(const f32x16& p, int s) {
    v4u w; w.x = cvtpk(p[8 * s + 0], p[8 * s + 1]); w.y = cvtpk(p[8 * s + 2], p[8 * s + 3]); w.z = cvtpk(p[8 * s + 4], p[8 * s + 5]); w.w = cvtpk(p[8 * s + 6], p[8 * s + 7]);
    return __builtin_bit_cast(bf16x8, w);
}
#define MFMA32(a, b, c) __builtin_amdgcn_mfma_f32_32x32x16_bf16((a), (b), (c), 0, 0, 0)
#define CROW(r, hi) (((r) & 3) + 8 * ((r) >> 2) + 4 * (hi))

__device__ __forceinline__ void attn_phase_mfma(Frame& F, const bf16* Q, const bf16* KV, const float* sinks, bf16* O) {
    LAUNDER_TID(F);
    LAS unsigned char* Kl = F.lds + RING_OFF;
    LAS unsigned char* Vl = Kl + 32768;
    const int lane = F.lane, r32 = lane & 31, hi = lane >> 5;
    for (int unit = F.vcu; unit < 256; unit += F.G) {
        const int nb = unit >> 1, kvh = unit & 1, head = kvh * 8 + F.wave;
#pragma unroll
        for (int i = 0; i < 4; ++i) { const int p = F.tid + 512 * i, key = p >> 3, c = p & 7, kpos = (nb - 1) * 128 + key;
            if (kpos >= 0) { const v4u kk = *(const v4u*)(KV + (size_t)kpos * 256 + kvh * 64 + c * 8); const v4u vv = *(const v4u*)(KV + (size_t)kpos * 256 + 128 + kvh * 64 + c * 8);
                *(LAS v4u*)(Kl + key * 128 + ((c ^ ((key >> 1) & 7)) << 4)) = kk; *(LAS v4u*)(Vl + (c >> 2) * 16384 + key * 64 + (c & 3) * 16) = vv; } }
        __syncthreads();
        const float sk = sinks[head] * LOG2E;
#pragma unroll 1
        for (int qb = 0; qb < 4; ++qb) {
            const int qpos = nb * 128 + qb * 32 + r32;
            bf16x8 qf[4];
#pragma unroll
            for (int kk = 0; kk < 4; ++kk) qf[kk] = *(const bf16x8*)(Q + (size_t)qpos * D + head * 64 + kk * 16 + hi * 8);
            f32x16 sacc[5];
#pragma unroll
            for (int t = 0; t < 5; ++t) {
#pragma unroll
                for (int r = 0; r < 16; ++r) sacc[t][r] = 0.f;
                if (nb > 0 || qb + t >= 4) { const int key = (qb + t) * 32 + r32;
#pragma unroll
                    for (int kk = 0; kk < 4; ++kk) { const int c = 2 * kk + hi; const bf16x8 kf = *(const LAS bf16x8*)(Kl + key * 128 + ((c ^ ((key >> 1) & 7)) << 4)); sacc[t] = MFMA32(kf, qf[kk], sacc[t]); } }
            }
            float mx = sk;
#pragma unroll
            for (int t = 0; t < 5; ++t) { const bool live = (nb > 0 || qb + t >= 4);
#pragma unroll
                for (int r = 0; r < 16; ++r) { const int cr = CROW(r, hi); bool valid = live; if (t == 0) valid = valid && (cr > r32); if (t == 4) valid = valid && (cr <= r32);
                    const float s = valid ? sacc[t][r] : -INFINITY; sacc[t][r] = s; mx = fmaxf(mx, s); } }
            mx = fmaxf(mx, __shfl_xor(mx, 32));
            float l = 0.f;
#pragma unroll
            for (int t = 0; t < 5; ++t)
#pragma unroll
                for (int r = 0; r < 16; ++r) { const float p = __builtin_amdgcn_exp2f(sacc[t][r] - mx); sacc[t][r] = p; l += p; }
            l += __shfl_xor(l, 32); l += __builtin_amdgcn_exp2f(sk - mx);
            f32x16 oacc[2];
#pragma unroll
            for (int r = 0; r < 16; ++r) { oacc[0][r] = 0.f; oacc[1][r] = 0.f; }
#pragma unroll
            for (int t = 0; t < 5; ++t) if (nb > 0 || qb + t >= 4) {
#pragma unroll
                for (int s = 0; s < 2; ++s) { const bf16x8 pf = pack8(sacc[t], s);
#pragma unroll
                    for (int dt = 0; dt < 2; ++dt) { const LAS unsigned char* vp = Vl + dt * 16384 + ((qb + t) * 32 + 16 * s + 4 * hi + ((lane & 15) >> 2)) * 64 + ((lane >> 4) & 1) * 32 + (lane & 3) * 8;
                        const bf16x8 vf = cat8(tr16(vp), tr16(vp + 8 * 64)); oacc[dt] = MFMA32(vf, pf, oacc[dt]); } } }
            const float inv = 1.f / l;
            bf16* orow = O + (size_t)qpos * D + head * 64 + 4 * hi;
#pragma unroll
            for (int dt = 0; dt < 2; ++dt)
#pragma unroll
                for (int gq = 0; gq < 4; ++gq) { u32x2 w; w.x = cvtpk(oacc[dt][4 * gq] * inv, oacc[dt][4 * gq + 1] * inv); w.y = cvtpk(oacc[dt][4 * gq + 2] * inv, oacc[dt][4 * gq + 3] * inv);
                    *(u32x2*)(orow + 32 * dt + 8 * gq) = w; }
        }
        __syncthreads();
    }
}

__device__ __forceinline__ void ml_local_phase_mfma(Frame& F, const bf16* PROJ, const float* GATES, bf16* STATE, float* NST, float* CH) {
    LAUNDER_TID(F);
    LAS unsigned char* Kl = F.lds + RING_OFF;
    LAS unsigned char* Vl = Kl + 16384;
    LAS float* bcum = (LAS float*)(Vl + 32768); LAS float* aval = bcum + 64; LAS float* wsv = aval + 64;
    const int lane = F.lane, r32 = lane & 31, hi = lane >> 5;
    for (int unit = F.vcu; unit < NC * 4; unit += F.G) {
        const int c = unit >> 2, h = unit & 3;
        chunk_gates(F, GATES, c, h, bcum, aval);
        const float btot = bcum[63]; float amax = -INFINITY;
        for (int s = 0; s < 64; ++s) amax = fmaxf(amax, aval[s]);
        const float mloc = btot + amax;
        if (F.tid < 64) wsv[F.tid] = expf(btot + aval[F.tid] - mloc);
        __syncthreads();
        const bf16* kb = PROJ + (size_t)(c * 64) * 3072 + 512 + h * 128;
        const bf16* vb = PROJ + (size_t)(c * 64) * 3072 + 1024 + h * 256;
#pragma unroll
        for (int i = 0; i < 2; ++i) { const int p = F.tid + 512 * i, s = p >> 4, cc = p & 15; const v4u kk = *(const v4u*)(kb + (size_t)s * 3072 + cc * 8); const float w = wsv[s];
            v4u o; o.x = pk2(bflo(kk.x) * w, bfhi(kk.x) * w); o.y = pk2(bflo(kk.y) * w, bfhi(kk.y) * w); o.z = pk2(bflo(kk.z) * w, bfhi(kk.z) * w); o.w = pk2(bflo(kk.w) * w, bfhi(kk.w) * w);
            *(LAS v4u*)(Kl + (cc >> 2) * 4096 + s * 64 + (cc & 3) * 16) = o; }
#pragma unroll
        for (int i = 0; i < 4; ++i) { const int p = F.tid + 512 * i, s = p >> 5, cc = p & 31; const v4u vv = *(const v4u*)(vb + (size_t)s * 3072 + cc * 8);
            *(LAS v4u*)(Vl + (cc >> 2) * 4096 + s * 64 + (cc & 3) * 16) = vv; }
        if (F.tid == 0) { CH[(c * 4 + h) * 2] = btot; CH[(c * 4 + h) * 2 + 1] = mloc; }
        __syncthreads();
        if (F.tid >= 384) { const int d = F.tid - 384; float a = 0.f; const LAS unsigned short* kc = (const LAS unsigned short*)(Kl + (d >> 5) * 4096 + (d & 31) * 2);
#pragma unroll 16
            for (int s = 0; s < 64; ++s) a += bf2f(kc[s * 32]);
            NST[(size_t)(c * 4 + h) * 128 + d] = a; }
        f32x16 acc[4];
#pragma unroll
        for (int dt = 0; dt < 4; ++dt)
#pragma unroll
            for (int r = 0; r < 16; ++r) acc[dt][r] = 0.f;
        const int troff = (4 * hi + ((lane & 15) >> 2)) * 64 + ((lane >> 4) & 1) * 32 + (lane & 3) * 8;
#pragma unroll
        for (int ks = 0; ks < 4; ++ks) {
            const LAS unsigned char* vp = Vl + F.wave * 4096 + ks * 16 * 64 + troff;
            const bf16x8 vf = cat8(tr16(vp), tr16(vp + 8 * 64));
#pragma unroll
            for (int dt = 0; dt < 4; ++dt) { const LAS unsigned char* kp = Kl + dt * 4096 + ks * 16 * 64 + troff;
                const bf16x8 kf = cat8(tr16(kp), tr16(kp + 8 * 64));
                acc[dt] = MFMA32(kf, vf, acc[dt]); }
        }
        bf16* st = STATE + ((size_t)(c * 4 + h) * 256 + F.wave * 32 + r32) * 128 + 4 * hi;
#pragma unroll
        for (int dt = 0; dt < 4; ++dt)
#pragma unroll
            for (int gq = 0; gq < 4; ++gq) { u32x2 w; w.x = cvtpk(acc[dt][4 * gq], acc[dt][4 * gq + 1]); w.y = cvtpk(acc[dt][4 * gq + 2], acc[dt][4 * gq + 3]); *(u32x2*)(st + 32 * dt + 8 * gq) = w; }
        __syncthreads();
    }
}

__device__ __forceinline__ void ml_out_phase_mfma(Frame& F, const bf16* PROJ, const float* GATES, const bf16* STATE, const float* NST, const float* MS, const float* hnorm, bf16* HG) {
    LAUNDER_TID(F);
    LAS unsigned char* Vl = F.lds + RING_OFF;
    LAS float* bcum = (LAS float*)(Vl + 32768); LAS float* aval = bcum + 64; LAS float* mt = aval + 64; LAS float* et = mt + 64; LAS float* nst = et + 64  ; LAS float* red = nst + 128  ;
    const int lane = F.lane, r32 = lane & 31, hi = lane >> 5, tb = F.wave >> 2, vq = F.wave & 3;
    for (int unit = F.vcu; unit < NC * 4; unit += F.G) {
        const int c = unit >> 2, h = unit & 3;
        const float mc = MS[c * 4 + h];
        if (F.tid < 64) {
            const float lf = GATES[(size_t)(c * 64 + F.tid) * 8 + 4 + h], ig = GATES[(size_t)(c * 64 + F.tid) * 8 + h];
            float s = lf;
#pragma unroll
            for (int o = 1; o < 64; o <<= 1) { const float t = __shfl_up(s, o); if (lane >= o) s += t; }
            const float a = ig - s; float am = a;
#pragma unroll
            for (int o = 1; o < 64; o <<= 1) { const float t = __shfl_up(am, o); if (lane >= o) am = fmaxf(am, t); }
            const float m_t = s + fmaxf(mc, am);
            bcum[F.tid] = s; aval[F.tid] = a; mt[F.tid] = m_t; et[F.tid] = expf(s + mc - m_t);
        }
        if (F.tid >= 64 && F.tid < 192) nst[F.tid - 64] = NST[(size_t)(c * 4 + h) * 128 + F.tid - 64];
        const bf16* qb = PROJ + (size_t)(c * 64) * 3072 + h * 128;
        const bf16* kb = PROJ + (size_t)(c * 64) * 3072 + 512 + h * 128;
        const bf16* vb = PROJ + (size_t)(c * 64) * 3072 + 1024 + h * 256;
#pragma unroll
        for (int i = 0; i < 4; ++i) { const int p = F.tid + 512 * i, s = p >> 5, cc = p & 31; const v4u vv = *(const v4u*)(vb + (size_t)s * 3072 + cc * 8);
            *(LAS v4u*)(Vl + (cc >> 2) * 4096 + s * 64 + (cc & 3) * 16) = vv; }
        const int t = tb * 32 + r32;
        bf16x8 qf[8];
#pragma unroll
        for (int kk = 0; kk < 8; ++kk) qf[kk] = *(const bf16x8*)(qb + (size_t)t * 3072 + kk * 16 + hi * 8);
        f32x16 sacc[2];
#pragma unroll
        for (int sb = 0; sb < 2; ++sb) {
#pragma unroll
            for (int r = 0; r < 16; ++r) sacc[sb][r] = 0.f;
            if (sb <= tb) {
#pragma unroll
                for (int kk = 0; kk < 8; ++kk) { const bf16x8 kf = *(const bf16x8*)(kb + (size_t)(sb * 32 + r32) * 3072 + kk * 16 + hi * 8); sacc[sb] = MFMA32(kf, qf[kk], sacc[sb]); } }
        }
        __syncthreads();
        const float b_t = bcum[t], m_t = mt[t], e_t = et[t];
        float dsum = 0.f;
#pragma unroll
        for (int sb = 0; sb < 2; ++sb)
#pragma unroll
            for (int gq = 0; gq < 4; ++gq) { const f32x4 a4 = *(const LAS f32x4*)(aval + sb * 32 + 8 * gq + 4 * hi);
#pragma unroll
                for (int i = 0; i < 4; ++i) { const int r = 4 * gq + i, cr = 8 * gq + 4 * hi + i; const bool valid = (sb < tb) || (sb == tb && cr <= r32);
                    const float w = valid ? sacc[sb][r] * expf(b_t + a4[i] - m_t) : 0.f; sacc[sb][r] = w; dsum += w; } }
        float nq = 0.f;
#pragma unroll
        for (int kk = 0; kk < 8; ++kk) { const v4u qw = __builtin_bit_cast(v4u, qf[kk]); const f32x4 n0 = *(const LAS f32x4*)(nst + kk * 16 + hi * 8), n1 = *(const LAS f32x4*)(nst + kk * 16 + hi * 8 + 4);
            nq += (bflo(qw.x) * n0.x + bfhi(qw.x) * n0.y) + (bflo(qw.y) * n0.z + bfhi(qw.y) * n0.w) + (bflo(qw.z) * n1.x + bfhi(qw.z) * n1.y) + (bflo(qw.w) * n1.z + bfhi(qw.w) * n1.w); }
        dsum += __shfl_xor(dsum, 32); nq += __shfl_xor(nq, 32);
        const float dd = fmaxf(fabsf(dsum + e_t * nq), expf(-m_t));
        const float dinv = 1.f / dd;
        f32x16 hacc[2];
        const int troff = (4 * hi + ((lane & 15) >> 2)) * 64 + ((lane >> 4) & 1) * 32 + (lane & 3) * 8;
        float ss = 0.f;
#pragma unroll
        for (int vt = 0; vt < 2; ++vt) {
            f32x16 ia, xa;
#pragma unroll
            for (int r = 0; r < 16; ++r) { ia[r] = 0.f; xa[r] = 0.f; }
#pragma unroll
            for (int sb = 0; sb < 2; ++sb) if (sb <= tb) {
#pragma unroll
                for (int s16 = 0; s16 < 2; ++s16) { const LAS unsigned char* vp = Vl + (vq * 2 + vt) * 4096 + (sb * 32 + s16 * 16) * 64 + troff;
                    const bf16x8 vf = cat8(tr16(vp), tr16(vp + 8 * 64)); ia = MFMA32(vf, pack8(sacc[sb], s16), ia); } }
            const bf16* cb = STATE + ((size_t)(c * 4 + h) * 256 + vq * 64 + vt * 32 + r32) * 128 + hi * 8;
#pragma unroll
            for (int kk = 0; kk < 8; ++kk) { const bf16x8 cf = *(const bf16x8*)(cb + kk * 16); xa = MFMA32(cf, qf[kk], xa); }
#pragma unroll
            for (int r = 0; r < 16; ++r) { const float hv = (ia[r] + e_t * xa[r]) * dinv; hacc[vt][r] = hv; ss += hv * hv; }
        }
        ss += __shfl_xor(ss, 32);
        if (hi == 0) red[(tb * 4 + vq) * 32 + r32] = ss;
        __syncthreads();
        const float tot = (red[(tb * 4 + 0) * 32 + r32] + red[(tb * 4 + 1) * 32 + r32]) + (red[(tb * 4 + 2) * 32 + r32] + red[(tb * 4 + 3) * 32 + r32]);
        const float rn = rsqrtf(tot * (1.f / 256.f) + RMS_EPS);
        const size_t row = (size_t)(c * 64 + t);
#pragma unroll
        for (int vt = 0; vt < 2; ++vt)
#pragma unroll
            for (int gq = 0; gq < 4; ++gq) { const int v0 = h * 256 + vq * 64 + vt * 32 + 8 * gq + 4 * hi;
                const f32x4 gn = *(const f32x4*)(hnorm + v0); const u32x2 ow = *(const u32x2*)(PROJ + row * 3072 + 2048 + v0);
                const float o0 = bflo(ow.x), o1 = bfhi(ow.x), o2 = bflo(ow.y), o3 = bfhi(ow.y);
                const float y0 = hacc[vt][4 * gq] * rn * gn.x / (1.f + expf(-o0)), y1 = hacc[vt][4 * gq + 1] * rn * gn.y / (1.f + expf(-o1));
                const float y2 = hacc[vt][4 * gq + 2] * rn * gn.z / (1.f + expf(-o2)), y3 = hacc[vt][4 * gq + 3] * rn * gn.w / (1.f + expf(-o3));
                u32x2 w; w.x = cvtpk(y0, y1); w.y = cvtpk(y2, y3); *(u32x2*)(HG + row * D + v0) = w; }
        __syncthreads();
    }
}


constexpr int NSC = 64;
constexpr int GA_OFF = 132096;
__device__ __forceinline__ void sc_gates(const float* GATES, int sc, int h, int lane, LAS float* bcum, LAS float* aval, LAS float* amc, float& btot, float& amax) {
    float lf[4], ig[4];
#pragma unroll
    for (int j = 0; j < 4; ++j) { const size_t row = (size_t)sc * 256 + 4 * lane + j; lf[j] = GATES[row * 8 + 4 + h]; ig[j] = GATES[row * 8 + h]; }
    float b[4]; b[0] = lf[0]; b[1] = b[0] + lf[1]; b[2] = b[1] + lf[2]; b[3] = b[2] + lf[3];
    float inc = b[3];
#pragma unroll
    for (int o = 1; o < 64; o <<= 1) { const float t = __shfl_up(inc, o); if (lane >= o) inc += t; }
    const float excl = inc - b[3];
    float a[4], cm[4];
#pragma unroll
    for (int j = 0; j < 4; ++j) { b[j] += excl; a[j] = ig[j] - b[j]; }
    cm[0] = a[0]; cm[1] = fmaxf(cm[0], a[1]); cm[2] = fmaxf(cm[1], a[2]); cm[3] = fmaxf(cm[2], a[3]);
    float inc2 = cm[3];
#pragma unroll
    for (int o = 1; o < 64; o <<= 1) { const float t = __shfl_up(inc2, o); if (lane >= o) inc2 = fmaxf(inc2, t); }
    float prev = __shfl_up(inc2, 1); if (lane == 0) prev = -INFINITY;
#pragma unroll
    for (int j = 0; j < 4; ++j) cm[j] = fmaxf(cm[j], prev);
    *(LAS f32x4*)(bcum + 4 * lane) = (f32x4){b[0], b[1], b[2], b[3]};
    *(LAS f32x4*)(aval + 4 * lane) = (f32x4){a[0], a[1], a[2], a[3]};
    *(LAS f32x4*)(amc + 4 * lane) = (f32x4){cm[0], cm[1], cm[2], cm[3]};
    btot = __shfl(inc, 63); amax = __shfl(inc2, 63);
}

__device__ __forceinline__ void ml_local256(Frame& F, const bf16* PROJ, const float* GATES, bf16* STATE, float* NST, float* CH) {
    LAUNDER_TID(F);
    LAS unsigned char* Kl = F.lds + RING_OFF;
    LAS unsigned char* Vl = Kl + 16384;
    LAS float* bcum = (LAS float*)(F.lds + GA_OFF); LAS float* aval = bcum + 256; LAS float* amc = aval + 256; LAS float* wsv = amc + 256;
    const int lane = F.lane, r32 = lane & 31, hi = lane >> 5;
    for (int unit = F.vcu; unit < NSC * 4; unit += F.G) {
        const int sc = unit >> 2, h = unit & 3;
        const bf16* kb = PROJ + (size_t)(sc * 256) * 3072 + 512 + h * 128;
        const bf16* vb = PROJ + (size_t)(sc * 256) * 3072 + 1024 + h * 256;
        v4u kreg[2], vreg[4];
#define ML_LOAD(j) do { _Pragma("unroll") for (int i = 0; i < 2; ++i) { const int p = F.tid + 512 * i, s = p >> 4, cc = p & 15; kreg[i] = *(const v4u*)(kb + (size_t)((j) * 64 + s) * 3072 + cc * 8); } \
                        _Pragma("unroll") for (int i = 0; i < 4; ++i) { const int p = F.tid + 512 * i, s = p >> 5, cc = p & 31; vreg[i] = *(const v4u*)(vb + (size_t)((j) * 64 + s) * 3072 + cc * 8); } } while (0)
        ML_LOAD(0);
        if (F.tid < 64) {
            float btot, amax; sc_gates(GATES, sc, h, lane, bcum, aval, amc, btot, amax);
            const float mloc = btot + amax; const f32x4 a4 = *(const LAS f32x4*)(aval + 4 * lane);
            *(LAS f32x4*)(wsv + 4 * lane) = (f32x4){expf(btot + a4.x - mloc), expf(btot + a4.y - mloc), expf(btot + a4.z - mloc), expf(btot + a4.w - mloc)};
            if (lane == 0) { CH[(sc * 4 + h) * 2] = btot; CH[(sc * 4 + h) * 2 + 1] = mloc; }
        }
        f32x16 acc[4];
#pragma unroll
        for (int dt = 0; dt < 4; ++dt)
#pragma unroll
            for (int r = 0; r < 16; ++r) acc[dt][r] = 0.f;
        float nsum = 0.f;
        const int troff = (4 * hi + ((lane & 15) >> 2)) * 64 + ((lane >> 4) & 1) * 32 + (lane & 3) * 8;
        __syncthreads();
#pragma unroll 1
        for (int j = 0; j < 4; ++j) {
#pragma unroll
            for (int i = 0; i < 2; ++i) { const int p = F.tid + 512 * i, s = p >> 4, cc = p & 15; const v4u kk = kreg[i]; const float w = wsv[j * 64 + s];
                v4u o; o.x = pk2(bflo(kk.x) * w, bfhi(kk.x) * w); o.y = pk2(bflo(kk.y) * w, bfhi(kk.y) * w); o.z = pk2(bflo(kk.z) * w, bfhi(kk.z) * w); o.w = pk2(bflo(kk.w) * w, bfhi(kk.w) * w);
                *(LAS v4u*)(Kl + (cc >> 2) * 4096 + s * 64 + (cc & 3) * 16) = o; }
#pragma unroll
            for (int i = 0; i < 4; ++i) { const int p = F.tid + 512 * i, s = p >> 5, cc = p & 31; *(LAS v4u*)(Vl + (cc >> 2) * 4096 + s * 64 + (cc & 3) * 16) = vreg[i]; }
            if (j < 3) ML_LOAD(j + 1);
            __syncthreads();
#pragma unroll
            for (int ks = 0; ks < 4; ++ks) {
                const LAS unsigned char* vp = Vl + F.wave * 4096 + ks * 16 * 64 + troff;
                const bf16x8 vf = cat8(tr16(vp), tr16(vp + 8 * 64));
#pragma unroll
                for (int dt = 0; dt < 4; ++dt) { const LAS unsigned char* kp = Kl + dt * 4096 + ks * 16 * 64 + troff;
                    const bf16x8 kf = cat8(tr16(kp), tr16(kp + 8 * 64)); acc[dt] = MFMA32(kf, vf, acc[dt]); }
            }
            if (F.tid >= 384) { const int d = F.tid - 384; const LAS unsigned short* kc = (const LAS unsigned short*)(Kl + (d >> 5) * 4096 + (d & 31) * 2);
#pragma unroll 16
                for (int s = 0; s < 64; ++s) nsum += bf2f(kc[s * 32]); }
            __syncthreads();
        }
#undef ML_LOAD
        bf16* st = STATE + ((size_t)(sc * 4 + h) * 256 + F.wave * 32 + r32) * 128 + 4 * hi;
#pragma unroll
        for (int dt = 0; dt < 4; ++dt)
#pragma unroll
            for (int gq = 0; gq < 4; ++gq) { u32x2 w; w.x = cvtpk(acc[dt][4 * gq], acc[dt][4 * gq + 1]); w.y = cvtpk(acc[dt][4 * gq + 2], acc[dt][4 * gq + 3]); *(u32x2*)(st + 32 * dt + 8 * gq) = w; }
        if (F.tid >= 384) NST[(size_t)(sc * 4 + h) * 128 + F.tid - 384] = nsum;
    }
}

__device__ __forceinline__ void ml_scan256(Frame& F, bf16* STATE, float* NST, const float* CH, float* MS) {
    LAUNDER_TID(F);
    LAS float* f1 = (LAS float*)(F.lds + RING_OFF); LAS float* f2 = f1 + 64;
    const int h = F.vcu >> 6;
    if (F.tid < 64) {
        const int c = F.lane; const float bt = CH[(c * 4 + h) * 2], ml = CH[(c * 4 + h) * 2 + 1];
        float B = bt, Mx = ml;
#pragma unroll
        for (int o = 1; o < 64; o <<= 1) { const float Bp = __shfl_up(B, o), Mp = __shfl_up(Mx, o); if (F.lane >= o) { Mx = fmaxf(Mp + B, Mx); B = Bp + B; } }
        const float Bq = __shfl_up(B, 1), Mq = __shfl_up(Mx, 1);
        const float m = (F.lane == 0) ? 0.f : fmaxf(Bq, Mq);
        const float mn = fmaxf(bt + m, ml);
        f1[c] = expf(bt + m - mn); f2[c] = expf(ml - mn);
        if ((F.vcu & 63) == 0) MS[c * 4 + h] = m;
    }
    __syncthreads();
    if (F.tid < 256) {
        unsigned* base = (unsigned*)(STATE + (size_t)h * 32768) + ((F.vcu & 63) * 256 + F.tid);
        float c0v = 0.f, c1v = 0.f;
#pragma unroll 1
        for (int cb = 0; cb < NSC; cb += 32) {
            unsigned u[32];
#pragma unroll
            for (int j = 0; j < 32; ++j) u[j] = base[(size_t)(cb + j) * 65536];
#pragma unroll
            for (int j = 0; j < 32; ++j) { const float a = f1[cb + j], b = f2[cb + j];
                base[(size_t)(cb + j) * 65536] = pg8::cvt_pk_bf16(c0v, c1v);
                c0v = a * c0v + b * bflo(u[j]); c1v = a * c1v + b * bfhi(u[j]); }
        }
    } else if ((F.vcu & 63) == 0 && F.tid < 384) {
        float* base = NST + h * 128 + (F.tid - 256); float nv = 0.f;
#pragma unroll 1
        for (int cb = 0; cb < NSC; cb += 16) {
            float u[16];
#pragma unroll
            for (int j = 0; j < 16; ++j) u[j] = base[(size_t)(cb + j) * 512];
#pragma unroll
            for (int j = 0; j < 16; ++j) { base[(size_t)(cb + j) * 512] = nv; nv = f1[cb + j] * nv + f2[cb + j] * u[j]; }
        }
    }
    __syncthreads();
}

__device__ __forceinline__ float fexp(float x) { return __builtin_amdgcn_exp2f(x * LOG2E); }
__device__ __forceinline__ void ml_out256(Frame& F, const bf16* PROJ, const float* GATES, const bf16* STATE, const float* NST, const float* MS, const float* hnorm, bf16* HG) {
    LAUNDER_TID(F);
    LAS unsigned char* Vl = F.lds + RING_OFF;
    LAS float* bcum = (LAS float*)(F.lds + GA_OFF); LAS float* aval = bcum + 256; LAS float* amc = aval + 256; LAS float* nst = amc + 256;
    const int lane = F.lane, r32 = lane & 31, hi = lane >> 5, w = F.wave;
    for (int unit = F.vcu; unit < NSC * 4; unit += F.G) {
        const int sc = unit >> 2, h = unit & 3;
        const float mc = MS[sc * 4 + h];
        const bf16* qb = PROJ + (size_t)(sc * 256) * 3072 + h * 128;
        const bf16* kb = PROJ + (size_t)(sc * 256) * 3072 + 512 + h * 128;
        const bf16* vb = PROJ + (size_t)(sc * 256) * 3072 + 1024 + h * 256;
#pragma unroll
        for (int half = 0; half < 2; ++half) { v4u vr[8];
#pragma unroll
            for (int i = 0; i < 8; ++i) { const int p = F.tid + 512 * (half * 8 + i), s = p >> 5, cc = p & 31; vr[i] = *(const v4u*)(vb + (size_t)s * 3072 + cc * 8); }
#pragma unroll
            for (int i = 0; i < 8; ++i) { const int p = F.tid + 512 * (half * 8 + i), s = p >> 5, cc = p & 31; *(LAS v4u*)(Vl + (cc >> 2) * 16384 + s * 64 + (cc & 3) * 16) = vr[i]; } }
        asm volatile("" ::: "memory");
        if (F.tid < 64) { float btot, amax; sc_gates(GATES, sc, h, lane, bcum, aval, amc, btot, amax); }
        if (F.tid >= 64 && F.tid < 192) nst[F.tid - 64] = NST[(size_t)(sc * 4 + h) * 128 + F.tid - 64];
        asm volatile("" ::: "memory");
        const int t = w * 32 + r32;
        bf16x8 qf[8];
#pragma unroll
        for (int kk = 0; kk < 8; ++kk) qf[kk] = *(const bf16x8*)(qb + (size_t)t * 3072 + kk * 16 + hi * 8);
        __syncthreads();
        const float b_t = bcum[t], m_t = b_t + fmaxf(mc, amc[t]), e_t = fexp(b_t + mc - m_t);
        float nq = 0.f;
#pragma unroll
        for (int kk = 0; kk < 8; ++kk) { const v4u qw = __builtin_bit_cast(v4u, qf[kk]); const f32x4 n0 = *(const LAS f32x4*)(nst + kk * 16 + hi * 8), n1 = *(const LAS f32x4*)(nst + kk * 16 + hi * 8 + 4);
            nq += (bflo(qw.x) * n0.x + bfhi(qw.x) * n0.y) + (bflo(qw.y) * n0.z + bfhi(qw.y) * n0.w) + (bflo(qw.z) * n1.x + bfhi(qw.z) * n1.y) + (bflo(qw.w) * n1.z + bfhi(qw.w) * n1.w); }
        nq += __shfl_xor(nq, 32);
        const int troff = (4 * hi + ((lane & 15) >> 2)) * 64 + ((lane >> 4) & 1) * 32 + (lane & 3) * 8;
        const size_t row = (size_t)(sc * 256 + t);
        float ss = 0.f, dinv = 0.f;
#pragma unroll 1
        for (int vh = 0; vh < 2; ++vh) {
            f32x16 acc[4];
#pragma unroll
            for (int i = 0; i < 4; ++i) { f32x16 xa;
#pragma unroll
                for (int r = 0; r < 16; ++r) xa[r] = 0.f;
                const bf16* cb = STATE + ((size_t)(sc * 4 + h) * 256 + (vh * 4 + i) * 32 + r32) * 128 + hi * 8;
#pragma unroll
                for (int kk = 0; kk < 8; ++kk) { const bf16x8 cf = *(const bf16x8*)(cb + kk * 16); xa = MFMA32(cf, qf[kk], xa); }
#pragma unroll
                for (int r = 0; r < 16; ++r) acc[i][r] = e_t * xa[r];
                asm volatile("" ::: "memory"); }
            float dsum = 0.f;
#pragma unroll 1
            for (int sb = 0; sb <= w; ++sb) {
                f32x16 st;
#pragma unroll
                for (int r = 0; r < 16; ++r) st[r] = 0.f;
#pragma unroll
                for (int kk = 0; kk < 8; ++kk) { const bf16x8 kf = *(const bf16x8*)(kb + (size_t)(sb * 32 + r32) * 3072 + kk * 16 + hi * 8); st = MFMA32(kf, qf[kk], st); }
#pragma unroll
                for (int gq = 0; gq < 4; ++gq) { const f32x4 a4 = *(const LAS f32x4*)(aval + sb * 32 + 8 * gq + 4 * hi);
#pragma unroll
                    for (int i = 0; i < 4; ++i) { const int r = 4 * gq + i, cr = 8 * gq + 4 * hi + i; const bool valid = (sb < w) || (cr <= r32);
                        const float wg = valid ? st[r] * fexp(b_t + a4[i] - m_t) : 0.f; st[r] = wg; dsum += wg; } }
                const bf16x8 pf0 = pack8(st, 0), pf1 = pack8(st, 1);
#pragma unroll
                for (int i = 0; i < 4; ++i) { const LAS unsigned char* vp = Vl + (vh * 4 + i) * 16384 + (sb * 32) * 64 + troff;
                    const bf16x8 vf0 = cat8(tr16(vp), tr16(vp + 8 * 64)), vf1 = cat8(tr16(vp + 16 * 64), tr16(vp + 24 * 64));
                    acc[i] = MFMA32(vf0, pf0, acc[i]); acc[i] = MFMA32(vf1, pf1, acc[i]); }
            }
            if (vh == 0) { dsum += __shfl_xor(dsum, 32); dinv = 1.f / fmaxf(fabsf(dsum + e_t * nq), fexp(-m_t)); }
#pragma unroll
            for (int i = 0; i < 4; ++i)
#pragma unroll
                for (int gq = 0; gq < 4; ++gq) { const float h0 = acc[i][4 * gq] * dinv, h1 = acc[i][4 * gq + 1] * dinv, h2 = acc[i][4 * gq + 2] * dinv, h3 = acc[i][4 * gq + 3] * dinv;
                    ss += (h0 * h0 + h1 * h1) + (h2 * h2 + h3 * h3); u32x2 wv; wv.x = cvtpk(h0, h1); wv.y = cvtpk(h2, h3);
                    *(u32x2*)(HG + row * D + h * 256 + (vh * 4 + i) * 32 + 8 * gq + 4 * hi) = wv; }
        }
        ss += __shfl_xor(ss, 32);
        const float rn = rsqrtf(ss * (1.f / 256.f) + RMS_EPS);
#pragma unroll 1
        for (int vi = 0; vi < 8; ++vi)
#pragma unroll
                for (int gq = 0; gq < 4; ++gq) { const int v0 = h * 256 + vi * 32 + 8 * gq + 4 * hi;
                    const f32x4 gn = *(const f32x4*)(hnorm + v0); const u32x2 ow = *(const u32x2*)(PROJ + row * 3072 + 2048 + v0);
                    const u32x2 hp = *(const u32x2*)(HG + row * D + v0); const unsigned p0 = hp.x, p1 = hp.y;
                    const float y0 = bflo(p0) * rn * gn.x * __builtin_amdgcn_rcpf(1.f + fexp(-bflo(ow.x))), y1 = bfhi(p0) * rn * gn.y * __builtin_amdgcn_rcpf(1.f + fexp(-bfhi(ow.x)));
                    const float y2 = bflo(p1) * rn * gn.z * __builtin_amdgcn_rcpf(1.f + fexp(-bflo(ow.y))), y3 = bfhi(p1) * rn * gn.w * __builtin_amdgcn_rcpf(1.f + fexp(-bfhi(ow.y)));
                    u32x2 wv; wv.x = cvtpk(y0, y1); wv.y = cvtpk(y2, y3); *(u32x2*)(HG + row * D + v0) = wv;
                    if (gq == 3) asm volatile("" ::: "memory"); }
        __syncthreads();
    }
}

#ifndef ML256
#define ML256 1
#endif
#ifndef XP_PRO
#define XP_PRO 0
#endif
#ifndef XP_GEMM
#define XP_GEMM 0
#endif
#ifndef XP_ML
#define XP_ML 0
#endif
#ifndef XP_ATTN
#define XP_ATTN 0
#endif
#ifndef XP_GATES
#define XP_GATES 0
#endif
#ifndef XP_BAR
#define XP_BAR 0
#endif
#ifndef ATTN_MFMA
#define ATTN_MFMA 1
#endif
#ifndef MLL_MFMA
#define MLL_MFMA 1
#endif
#ifndef MLO_MFMA
#define MLO_MFMA 1
#endif
#ifndef PG8_SP2
#define PG8_SP2 true
#endif
#ifndef PG8_ALIGN
#define PG8_ALIGN true
#endif
typedef const char __attribute__((address_space(4)))* karg_ptr;
__device__ __forceinline__ karg_ptr kargs() { karg_ptr kp = (karg_ptr)__builtin_amdgcn_kernarg_segment_ptr(); asm volatile("" : "+s"(kp)); return kp; }
__device__ __forceinline__ const float* arg_in(int i) { return *(const float* const __attribute__((address_space(4)))*)(kargs() + 8 * i); }
__device__ __forceinline__ float* arg_out() { return *(float* const __attribute__((address_space(4)))*)(kargs() + 8 * 19); }
__device__ __forceinline__ unsigned char* arg_ws() { return *(unsigned char* const __attribute__((address_space(4)))*)(kargs() + 8 * 20); }
#define WSP(T, off) ((T*)(arg_ws() + (off)))

__global__ void __launch_bounds__(NWAVES * 64, 2) yoco_fwd(Args args) {
    extern __shared__ __attribute__((aligned(16))) unsigned char lds[];
    Frame F;
    F.lds = (LAS unsigned char*)lds;
    F.MISC = (volatile LAS unsigned*)(F.lds + MISC_OFF);
    F.tid = threadIdx.x; F.lane = F.tid & 63; F.wave = __builtin_amdgcn_readfirstlane(F.tid >> 6);
    F.G = gridDim.x; { const int bx = blockIdx.x; F.vcu = (F.G % 8 == 0) ? (bx % 8) * (F.G / 8) + bx / 8 : bx; }
    F.ctl = (gu32*)(args.ws + WS_CTL);
    for (int u = F.tid; u < (LDS_BYTES - LDSCTL_OFF) / 4; u += NWAVES * 64) ((LAS unsigned*)(F.lds + LDSCTL_OFF))[u] = 0u;
    __syncthreads();
    unsigned bar_x; { XcdBarrier bar = xcd_barrier_post((unsigned*)(F.ctl + CW_BAR), F.MISC + 8); bar_x = __builtin_amdgcn_readfirstlane(bar.x); }
#define GRID_BAR() do { XcdBarrier b_; b_.bar = (unsigned*)(arg_ws() + WS_CTL) + CW_BAR; b_.x = bar_x; b_.st = (volatile LAS unsigned*)(F.lds + MISC_OFF) + 8; asm volatile("" : "+s"(b_.x)); xcd_barrier(b_); } while (0)

    for (int rep = 0; rep <= XP_PRO; ++rep) p0_prologue(F, args);
    GRID_BAR();
    for (int rep = 0; rep < XP_BAR; ++rep) GRID_BAR();

#pragma unroll 1
    for (int l = 0; l < 4; ++l) {
        if (l < 2) {
            {
                pg8::Gemm g{WSP(const bf16, WS_XB), WSP(const bf16, WS_WIN) + (size_t)l * 3072 * D, M, 3072, D}; pg8::StaticOrder S; S.init(M, 3072, F.G, (int)blockIdx.x);
                EpiProj E{WSP(bf16, WS_PROJ), 3072, nullptr, 3072, 0, nullptr, WSP(const float, WS_SSP)};
                for (int rep = 0; rep <= XP_GEMM; ++rep) pg8::gemm_phase<EpiProj, pg8::StaticOrder, PG8_ALIGN, PG8_SP2>(F.lds + RING_OFF, g, S, E);
                for (int rep = 0; rep <= XP_GATES; ++rep) gates_phase(F, WSP(const bf16, WS_XB), WSP(const float, WS_SSP), WSP(const float, WS_WGT) + l * 8 * 1024, arg_in(3) + l * 8, WSP(float, WS_GATES));
            }
            GRID_BAR();
            for (int rep = 0; rep <= XP_ML; ++rep) ml_local256(F, WSP(const bf16, WS_PROJ), WSP(const float, WS_GATES), WSP(bf16, WS_STATE), WSP(float, WS_NST), WSP(float, WS_CH));
            GRID_BAR();
            ml_scan256(F, WSP(bf16, WS_STATE), WSP(float, WS_NST), WSP(const float, WS_CH), WSP(float, WS_MS));
            GRID_BAR();
            for (int rep = 0; rep <= XP_ML; ++rep) ml_out256(F, WSP(const bf16, WS_PROJ), WSP(const float, WS_GATES), WSP(const bf16, WS_STATE), WSP(const float, WS_NST), WSP(const float, WS_MS), arg_in(4) + l * D, WSP(bf16, WS_HG));
            GRID_BAR();
            {
                pg8::Gemm g{WSP(const bf16, WS_HG), WSP(const bf16, WS_WOUT) + (size_t)l * D * D, M, D, D}; pg8::StaticOrder S; S.init(M, D, F.G, (int)blockIdx.x);
                float* X = arg_out();
                EpiResid E{(l == 0) ? arg_in(0) : (const float*)X, X, WSP(bf16, WS_XB), nullptr, WSP(float, WS_SSP)};
                pg8::gemm_phase<EpiResid, pg8::StaticOrder, false, PG8_SP2>(F.lds + RING_OFF, g, S, E);
            }
            GRID_BAR();
        } else {
            const int j = l - 2;
            {
                const int N = (j == 0) ? 1280 : 1024;
                pg8::Gemm g{WSP(const bf16, WS_XB), (const bf16*)(arg_ws() + (j == 0 ? WS_WQ2 : WS_WQ3)), M, N, D}; pg8::StaticOrder S; S.init(M, N, F.G, (int)blockIdx.x);
                EpiProj E{WSP(bf16, WS_PROJ), D, WSP(bf16, WS_KV), 256, 1024, WSP(const float, WS_BQ) + j * 1280, WSP(const float, WS_SSP)};
                for (int rep = 0; rep <= XP_GEMM; ++rep) pg8::gemm_phase<EpiProj, pg8::StaticOrder, PG8_ALIGN, PG8_SP2>(F.lds + RING_OFF, g, S, E);
            }
            GRID_BAR();
            for (int rep = 0; rep <= XP_ATTN; ++rep) attn_phase_mfma(F, WSP(const bf16, WS_PROJ), WSP(const bf16, WS_KV), arg_in(12) + j * 16, WSP(bf16, WS_HG));
            GRID_BAR();
            {
                pg8::Gemm g{WSP(const bf16, WS_HG), WSP(const bf16, WS_WBO) + (size_t)j * D * D, M, D, D}; pg8::StaticOrder S; S.init(M, D, F.G, (int)blockIdx.x);
                float* X = arg_out();
                EpiResid E{X, X, WSP(bf16, WS_XB), arg_in(14) + j * D, WSP(float, WS_SSP)};
                pg8::gemm_phase<EpiResid, pg8::StaticOrder, false, PG8_SP2>(F.lds + RING_OFF, g, S, E);
            }
            GRID_BAR();
        }
        {
            pg8::Gemm g{WSP(const bf16, WS_XB), WSP(const bf16, WS_WGU) + (size_t)l * 2 * DFF * D, M, 2 * DFF, D}; pg8::StaticOrder S; S.init(M, 2 * DFF, F.G, (int)blockIdx.x);
            EpiSwiglu E{WSP(bf16, WS_PROJ), WSP(const float, WS_SSP)};
            for (int rep = 0; rep <= XP_GEMM; ++rep) pg8::gemm_phase<EpiSwiglu, pg8::StaticOrder, PG8_ALIGN, PG8_SP2>(F.lds + RING_OFF, g, S, E);
        }
        GRID_BAR();
        {
            pg8::Gemm g{WSP(const bf16, WS_PROJ), WSP(const bf16, WS_WD) + (size_t)l * D * DFF, M, D, DFF}; pg8::StaticOrder S; S.init(M, D, F.G, (int)blockIdx.x);
            float* X = arg_out();
            EpiResid E{X, X, WSP(bf16, WS_XB), nullptr, WSP(float, WS_SSP)};
            pg8::gemm_phase<EpiResid, pg8::StaticOrder, false, PG8_SP2>(F.lds + RING_OFF, g, S, E);
        }
        GRID_BAR();
    }
    final_norm_phase(F, arg_out(), WSP(const float, WS_SSP), arg_in(18));
}

extern "C" void kernel_launch(void* const* d_in, const int* in_sizes, int n_in, void* d_out, int out_size, void* d_ws, size_t ws_size, hipStream_t stream) {
    static int grid = 0;
    if (grid == 0) {
        if (n_in != 19 || in_sizes[0] != M * D || out_size != M * D || ws_size < WS_END) { fprintf(stderr, "kernel_launch: unexpected shapes / workspace (n_in %d, ws %zu < %zu)\n", n_in, ws_size, (size_t)WS_END); grid = -1; return; }
        int dev = 0, cus = 0, per_cu = 0;
        if (hipGetDevice(&dev) != hipSuccess || hipDeviceGetAttribute(&cus, hipDeviceAttributeMultiprocessorCount, dev) != hipSuccess) { grid = -1; return; }
        if (hipFuncSetAttribute((const void*)yoco_fwd, hipFuncAttributeMaxDynamicSharedMemorySize, LDS_BYTES) != hipSuccess) { fprintf(stderr, "kernel_launch: hipFuncSetAttribute failed\n"); grid = -1; return; }
        if (hipOccupancyMaxActiveBlocksPerMultiprocessor(&per_cu, (const void*)yoco_fwd, NWAVES * 64, LDS_BYTES) != hipSuccess || per_cu < 1) { fprintf(stderr, "kernel_launch: occupancy query says %d blocks per CU\n", per_cu); (void)hipGetLastError(); grid = -1; return; }
        grid = cus;
        if (grid != 256) fprintf(stderr, "kernel_launch: %d CUs; this kernel is laid out for 256\n", grid);
    }
    if (grid < 0) return;
    if (hipMemsetAsync((char*)d_ws + WS_CTL, 0, CTL_ZERO_BYTES, stream) != hipSuccess) return;
    Args a{};
    for (int i = 0; i < 19; ++i) a.in[i] = (const float*)d_in[i];
    a.out = (float*)d_out; a.ws = (unsigned char*)d_ws;
    hipLaunchKernelGGL(yoco_fwd, dim3(grid), dim3(NWAVES * 64), LDS_BYTES, stream, a);
}
```

```cpp
#include <hip/hip_runtime.h>
#include <cstdio>
#include <cstdint>
#include <cmath>
namespace pg8 {
#define PG8_LAS __attribute__((address_space(3)))
typedef unsigned short bf16_t;
typedef short bf16x8 __attribute__((ext_vector_type(8)));
typedef float f32x4 __attribute__((ext_vector_type(4)));
typedef unsigned u32x4 __attribute__((ext_vector_type(4)));
constexpr int BM = 256, BK = 64, HALF = 128, HTB = HALF * BK * 2  , STAGE_BYTES = 8 * HTB, NXCD = 8, WGM = 8;

__host__ __device__ __forceinline__ int lds_byte(int r, int c) { const int st = (r >> 4) * 2 + (c >> 5), rr = r & 15, cc = c & 31, ob = rr * 64 + cc * 2; return st * 1024 + (ob ^ (((ob >> 9) & 1) << 5)); }
__host__ __device__ __forceinline__ void stage_rc(int b, int& R, int& C) { const int st = b / 1024, sb = b % 1024, swz = sb ^ (((sb >> 9) & 1) << 5); R = (st >> 1) * 16 + swz / 64; C = (st & 1) * 32 + (swz % 64) / 2; }
__host__ __device__ __forceinline__ int perm32(int rho) { const int n = rho >> 4, i = rho & 15; return 8 * (i >> 2) + 4 * n + (i & 3); }

struct Unit { int pm, pn; };
struct Gemm { const bf16_t* A; const bf16_t* Bt; int M, N, K; };

struct StaticOrder {
    int nM, nN, nwg, G, c;
    __host__ __device__ void init(int M, int N, int G_, int c_) { nM = M / BM; nN = N / BM; nwg = nM * nN; G = G_; c = c_; }
    __host__ __device__ bool next(int i, Unit& u) const {
        const long L = (long)i * G + c; if (L >= nwg) return false;
        int wgid = (int)L; { const int q = nwg / NXCD, r = nwg % NXCD, xcd = wgid % NXCD, off = wgid / NXCD; wgid = (xcd < r ? xcd * (q + 1) : r * (q + 1) + (xcd - r) * q) + off; }
        const int nig = WGM * nN, gid = wgid / nig, fm = gid * WGM, gsz = (nM - fm) < WGM ? (nM - fm) : WGM;
        u.pm = fm + ((wgid % nig) % gsz); u.pn = (wgid % nig) / gsz; return true;
    }
    __device__ __forceinline__ void a_ready(const Unit&) const {}
    __device__ __forceinline__ void done(const Unit&) const {}
};

__device__ __forceinline__ unsigned cvt_pk_bf16(float lo, float hi) { unsigned r; asm volatile("v_cvt_pk_bf16_f32 %0, %1, %2" : "=v"(r) : "v"(lo), "v"(hi)); return r; }
typedef float f32x2 __attribute__((ext_vector_type(2)));
template <class Epi, class Sched, bool ALIGN_EPI = false, bool SP2 = false>
__device__ __forceinline__ void gemm_phase(PG8_LAS unsigned char* lds, const Gemm g, const Sched& S, const Epi& E) {
    int tid_ = (int)__builtin_amdgcn_mbcnt_hi(~0u, __builtin_amdgcn_mbcnt_lo(~0u, 0u)); asm volatile("" : "+v"(tid_)); tid_ += 64 * __builtin_amdgcn_readfirstlane((int)threadIdx.x >> 6);
    const int tid = tid_, wid = __builtin_amdgcn_readfirstlane(tid >> 6), lane = tid & 63, wr = wid >> 2, wc = wid & 3, fr = lane & 15, fq = lane >> 4;
    const int K = g.K, nt = K / BK;
    unsigned voffA[2], voffB[2];
#pragma unroll
    for (int i = 0; i < 2; ++i) { int R, C; stage_rc(tid * 16 + i * 8192, R, C); const int Rb = Epi::PERM ? ((R & ~31) + perm32(R & 31)) : R;
        voffA[i] = (unsigned)(R * K + C) * 2u; voffB[i] = (unsigned)(Rb * K + C) * 2u; }
    const size_t kstep = (size_t)(BK * 2);
    const size_t hstep = (size_t)HALF * K * 2;
    const size_t tstep = 2 * hstep;
    const unsigned ldsw = (unsigned)wid * 1024u;
    const int aoff = lds_byte(wr * 64 + fr, fq * 8), boff = lds_byte(wc * 32 + fr, fq * 8);
#define PG8_SA(b, h) (((b) * 2 + (h)) * HTB)
#define PG8_SB(b, h) ((4 + (b) * 2 + (h)) * HTB)
#define PG8_STAGE(bufoff, gbase, voff) do { _Pragma("unroll") for (int _i = 0; _i < 2; ++_i) \
        __builtin_amdgcn_global_load_lds((const unsigned*)((const char*)(gbase) + (voff)[_i]), (PG8_LAS unsigned*)(lds + (bufoff) + ldsw + _i * 8192), 16, 0, 0); } while (0)
#define PG8_LDA(dst, b, h) do { _Pragma("unroll") for (int m = 0; m < 4; ++m) _Pragma("unroll") for (int k = 0; k < 2; ++k) dst[m][k] = *(const PG8_LAS bf16x8*)(lds + PG8_SA(b, h) + aoff + m * 2048 + k * 1024); } while (0)
#define PG8_LDB(dst, b, h) do { _Pragma("unroll") for (int n = 0; n < 2; ++n) _Pragma("unroll") for (int k = 0; k < 2; ++k) dst[n][k] = *(const PG8_LAS bf16x8*)(lds + PG8_SB(b, h) + boff + n * 2048 + k * 1024); } while (0)
#define PG8_MMA(ai, bj, At, Bt) do { __builtin_amdgcn_s_setprio(1); _Pragma("unroll") for (int m = 0; m < 4; ++m) _Pragma("unroll") for (int n = 0; n < 2; ++n) _Pragma("unroll") for (int k = 0; k < 2; ++k) \
        acc[ai][bj][m][n] = __builtin_amdgcn_mfma_f32_16x16x32_bf16(Bt[n][k], At[m][k], acc[ai][bj][m][n], 0, 0, 0); __builtin_amdgcn_s_setprio(0); } while (0)
#define PG8_WAIT_V(n) asm volatile("s_waitcnt vmcnt(" #n ")" ::: "memory")
#define PG8_WAIT_L(n) asm volatile("s_waitcnt lgkmcnt(" #n ")" ::: "memory")
#define PG8_BAR __builtin_amdgcn_s_barrier()
#define PG8_SCHED __builtin_amdgcn_sched_barrier(0)
    Unit cur, nxt; int ui = 0;
    if (!S.next(0, cur)) return;
    f32x4 acc[2][2][4][2];
#pragma unroll
    for (int a = 0; a < 2; ++a)
#pragma unroll
        for (int b = 0; b < 2; ++b)
#pragma unroll
            for (int m = 0; m < 4; ++m)
#pragma unroll
                for (int n = 0; n < 2; ++n) acc[a][b][m][n] = (f32x4){0.f, 0.f, 0.f, 0.f};
    bf16x8 At[4][2], B0[2][2], B1[2][2];
    const char* cA = (const char*)g.A + (size_t)cur.pm * tstep; const char* cB = (const char*)g.Bt + (size_t)cur.pn * tstep;
    S.a_ready(cur);
    if constexpr (SP2) {
        PG8_STAGE(PG8_SB(0, 0), cB, voffB); PG8_STAGE(PG8_SB(0, 1), cB + hstep, voffB); PG8_STAGE(PG8_SA(0, 0), cA, voffA); PG8_STAGE(PG8_SA(0, 1), cA + hstep, voffA);
        if (wr == 1) PG8_BAR;
        PG8_WAIT_V(2); PG8_BAR;
        PG8_STAGE(PG8_SB(1, 0), cB + kstep, voffB); PG8_STAGE(PG8_SA(1, 0), cA + kstep, voffA); PG8_STAGE(PG8_SB(1, 1), cB + hstep + kstep, voffB);
        PG8_WAIT_V(6); PG8_BAR;
    } else {
        PG8_STAGE(PG8_SB(0, 0), cB, voffB); PG8_STAGE(PG8_SA(0, 0), cA, voffA); PG8_STAGE(PG8_SB(0, 1), cB + hstep, voffB); PG8_STAGE(PG8_SA(0, 1), cA + hstep, voffA);
        if (wr == 1) PG8_BAR;
        PG8_WAIT_V(4); PG8_BAR;
        PG8_STAGE(PG8_SB(1, 0), cB + kstep, voffB); PG8_STAGE(PG8_SA(1, 0), cA + kstep, voffA); PG8_STAGE(PG8_SB(1, 1), cB + hstep + kstep, voffB);
        PG8_WAIT_V(6); PG8_BAR;
    }
    for (;;) {
        const bool has_next = S.next(ui + 1, nxt);
        const char* nA = has_next ? (const char*)g.A + (size_t)nxt.pm * tstep : cA; const char* nB = has_next ? (const char*)g.Bt + (size_t)nxt.pn * tstep : cB;
        for (int t = 0; t < nt; t += 2) {
            const bool last = (t == nt - 2);
            const char* a1 = cA + (size_t)(t + 1) * kstep;
            const char* a2 = last ? nA : cA + (size_t)(t + 2) * kstep; const char* b2 = last ? nB : cB + (size_t)(t + 2) * kstep;
            const char* a3 = a2 + kstep; const char* b3 = b2 + kstep;
            if (last && has_next) S.a_ready(nxt);
            if constexpr (SP2) {
            PG8_LDB(B0, 0, 0); PG8_LDB(B1, 0, 1); PG8_SCHED; PG8_LDA(At, 0, 0); PG8_STAGE(PG8_SA(1, 1), a1 + hstep, voffA);
            PG8_WAIT_V(8); PG8_WAIT_L(0); PG8_BAR; PG8_MMA(0, 0, At, B0); PG8_MMA(0, 1, At, B1); PG8_BAR; PG8_SCHED;
            PG8_LDA(At, 0, 1); PG8_STAGE(PG8_SB(0, 0), b2, voffB); PG8_STAGE(PG8_SB(0, 1), b2 + hstep, voffB); PG8_STAGE(PG8_SA(0, 0), a2, voffA);
            PG8_WAIT_V(8); PG8_WAIT_L(0); PG8_BAR; PG8_MMA(1, 0, At, B0); PG8_MMA(1, 1, At, B1); PG8_BAR; PG8_SCHED;
            PG8_LDB(B0, 1, 0); PG8_LDB(B1, 1, 1); PG8_SCHED; PG8_LDA(At, 1, 0); PG8_STAGE(PG8_SA(0, 1), a2 + hstep, voffA);
            PG8_WAIT_V(8); PG8_WAIT_L(0); PG8_BAR; PG8_MMA(0, 0, At, B0); PG8_MMA(0, 1, At, B1); PG8_BAR; PG8_SCHED;
            PG8_LDA(At, 1, 1); PG8_STAGE(PG8_SB(1, 0), b3, voffB); PG8_STAGE(PG8_SB(1, 1), b3 + hstep, voffB); PG8_STAGE(PG8_SA(1, 0), a3, voffA);
            PG8_WAIT_V(8); PG8_WAIT_L(0); PG8_BAR; PG8_MMA(1, 0, At, B0); PG8_MMA(1, 1, At, B1); PG8_BAR; PG8_SCHED;
            } else {
            PG8_LDB(B0, 0, 0); PG8_SCHED; PG8_LDA(At, 0, 0); PG8_STAGE(PG8_SA(1, 1), a1 + hstep, voffA);
            PG8_WAIT_L(8); PG8_BAR; PG8_WAIT_L(0); PG8_MMA(0, 0, At, B0); PG8_BAR; PG8_SCHED;
            PG8_LDB(B1, 0, 1); PG8_STAGE(PG8_SB(0, 0), b2, voffB);
            PG8_BAR; PG8_WAIT_L(0); PG8_MMA(0, 1, At, B1); PG8_BAR;
            PG8_LDA(At, 0, 1); PG8_STAGE(PG8_SA(0, 0), a2, voffA);
            PG8_BAR; PG8_WAIT_L(0); PG8_MMA(1, 0, At, B0); PG8_BAR; PG8_SCHED;
            PG8_STAGE(PG8_SB(0, 1), b2 + hstep, voffB);
            PG8_WAIT_V(6); PG8_BAR; PG8_MMA(1, 1, At, B1); PG8_BAR;
            PG8_LDB(B0, 1, 0); PG8_SCHED; PG8_LDA(At, 1, 0); PG8_STAGE(PG8_SA(0, 1), a2 + hstep, voffA);
            PG8_WAIT_L(8); PG8_BAR; PG8_WAIT_L(0); PG8_MMA(0, 0, At, B0); PG8_BAR; PG8_SCHED;
            PG8_LDB(B1, 1, 1); PG8_STAGE(PG8_SB(1, 0), b3, voffB);
            PG8_BAR; PG8_WAIT_L(0); PG8_MMA(0, 1, At, B1); PG8_BAR;
            PG8_LDA(At, 1, 1); PG8_STAGE(PG8_SA(1, 0), a3, voffA);
            PG8_BAR; PG8_WAIT_L(0); PG8_MMA(1, 0, At, B0); PG8_BAR; PG8_SCHED;
            PG8_STAGE(PG8_SB(1, 1), b3 + hstep, voffB);
            PG8_WAIT_V(6); PG8_BAR; PG8_MMA(1, 1, At, B1); PG8_BAR;
            }
        }
        if constexpr (ALIGN_EPI) { if (wr == 0) PG8_BAR; }
        if constexpr (!Epi::AFTER_DRAIN) { E(acc, cur, wr, wc, fr, fq); S.done(cur); }
        if (!has_next) break;
#pragma unroll
        for (int a = 0; a < 2; ++a)
#pragma unroll
            for (int b = 0; b < 2; ++b)
#pragma unroll
                for (int m = 0; m < 4; ++m)
#pragma unroll
                    for (int n = 0; n < 2; ++n) acc[a][b][m][n] = (f32x4){0.f, 0.f, 0.f, 0.f};
        cur = nxt; cA = nA; cB = nB; ++ui;
        if constexpr (ALIGN_EPI) { if (wr == 1) PG8_BAR; }
    }
    PG8_WAIT_V(0);
    if constexpr (!ALIGN_EPI) { if (wr == 0) PG8_BAR; }
    PG8_BAR;
    if constexpr (Epi::AFTER_DRAIN) { E.fused(acc, cur, wr, wc, fr, fq, lds, wid, lane); S.done(cur); }
#undef PG8_SA
#undef PG8_SB
#undef PG8_STAGE
#undef PG8_LDA
#undef PG8_LDB
#undef PG8_MMA
#undef PG8_WAIT_V
#undef PG8_WAIT_L
#undef PG8_BAR
#undef PG8_SCHED
}
}
#define GAS __attribute__((address_space(1)))
#define LAS __attribute__((address_space(3)))
typedef unsigned short bf16;
typedef unsigned v4u __attribute__((ext_vector_type(4)));
typedef float f32x4 __attribute__((ext_vector_type(4)));
typedef short bf16x8 __attribute__((ext_vector_type(8)));
typedef GAS unsigned gu32;
typedef GAS unsigned long long gu64;
#define RLX_AGENT __ATOMIC_RELAXED, __HIP_MEMORY_SCOPE_AGENT
#define LDS_WAIT() asm volatile("s_waitcnt lgkmcnt(0)" ::: "memory")
#define VM_WAIT() asm volatile("s_waitcnt vmcnt(0)" ::: "memory")
__device__ __forceinline__ unsigned long long rt() { return __builtin_amdgcn_s_memrealtime(); }
__device__ __forceinline__ unsigned f2bf(float f) { unsigned u = __builtin_bit_cast(unsigned, f); return (u + 0x7fffu + ((u >> 16) & 1u)) >> 16; }
__device__ __forceinline__ unsigned pk2(float lo, float hi) { return f2bf(lo) | (f2bf(hi) << 16); }

#define XB_TMO      128
#define XB_XCNT(j)  (256  + 64 * (j))
#define XB_XSUB(j)  (1280 + 64 * (j))
#define XB_XGEN(j)  (2304 + 64 * (j))
#define XB_TOP      3328
#define XB_TOPGEN   3392
#define XCD_BAR_WORDS 3456
#define XB_SPIN_CAP (1u << 18)

__device__ __forceinline__ unsigned xb_ld(unsigned* p)              { return __hip_atomic_load(p, __ATOMIC_RELAXED, __HIP_MEMORY_SCOPE_AGENT); }
__device__ __forceinline__ unsigned xb_add(unsigned* p, unsigned v) { return __hip_atomic_fetch_add(p, v, __ATOMIC_RELAXED, __HIP_MEMORY_SCOPE_AGENT); }
__device__ __forceinline__ unsigned xb_xcc_id() { return (unsigned)__builtin_amdgcn_s_getreg((3 << 11) | 20) & 0xFu; }
#define XB_SPIN(cond, bar) do { unsigned _sp = 0; while (cond) { __builtin_amdgcn_s_sleep(1); \
    if ((++_sp & 255u) == 0u) { if (xb_ld(&(bar)[XB_TMO])) break; if (_sp > XB_SPIN_CAP) { atomicAdd(&(bar)[XB_TMO], 1u); break; } } } } while (0)

struct XcdBarrier {
    unsigned* bar; unsigned x;
    volatile LAS unsigned* st;
};

__device__ __forceinline__ XcdBarrier xcd_barrier_post(unsigned* bar, volatile LAS unsigned* st) {
    XcdBarrier b; b.bar = bar; b.x = xb_xcc_id(); b.st = st;
    if (threadIdx.x == 0) (void)xb_add(&bar[XB_XCNT(b.x)], 1u);
    return b;
}
__device__ __forceinline__ void xcd_barrier_complete(unsigned* bar, unsigned x, unsigned& nloc, unsigned& nx) {
    const unsigned G = gridDim.x * gridDim.y * gridDim.z;
    unsigned sum, cnt, mine, sp = 0u;
    for (;;) {
        sum = 0u; cnt = 0u; mine = 0u;
#pragma unroll
        for (unsigned j = 0; j < 16; ++j) { const unsigned c = xb_ld(&bar[XB_XCNT(j)]); sum += c; cnt += (c > 0u) ? 1u : 0u; mine = (j == x) ? c : mine; }
        if (sum == G) break;
        __builtin_amdgcn_s_sleep(1);
        if ((++sp & 255u) == 0u) { if (xb_ld(&bar[XB_TMO])) break; if (sp > XB_SPIN_CAP) { atomicAdd(&bar[XB_TMO], 1u); break; } }
    }
    nloc = mine > 0u ? mine : 1u; nx = cnt > 0u ? cnt : 1u;
}

__device__ __forceinline__ void xcd_barrier(const XcdBarrier& b) {
    asm volatile("s_waitcnt vmcnt(0)" ::: "memory");
    __syncthreads();
    if (threadIdx.x == 0) {
        unsigned* bar = b.bar;
        __builtin_amdgcn_s_waitcnt(0);
        unsigned nloc = b.st[0], nx = b.st[1];
        if (nloc == 0u) { xcd_barrier_complete(bar, b.x, nloc, nx); b.st[0] = nloc; b.st[1] = nx; }
        const unsigned old = xb_add(&bar[XB_XSUB(b.x)], 1u);
        const unsigned gen = old / nloc;
        if (old + 1u == (gen + 1u) * nloc) {
            __builtin_amdgcn_fence(__ATOMIC_RELEASE, "agent");
            asm volatile("s_waitcnt vmcnt(0)" ::: "memory");
            const unsigned og = xb_add(&bar[XB_TOP], 1u);
            const unsigned tg = og / nx;
            if (og + 1u == (tg + 1u) * nx) xb_add(&bar[XB_TOPGEN], 1u);
            else XB_SPIN(xb_ld(&bar[XB_TOPGEN]) == tg, bar);
            __builtin_amdgcn_fence(__ATOMIC_ACQUIRE, "agent");
            xb_add(&bar[XB_XGEN(b.x)], 1u);
            asm volatile("s_waitcnt vmcnt(0)" ::: "memory");
        } else {
            XB_SPIN(xb_ld(&bar[XB_XGEN(b.x)]) == gen, bar);
            __builtin_amdgcn_fence(__ATOMIC_ACQUIRE, "agent");
            asm volatile("s_waitcnt vmcnt(0)" ::: "memory");
        }
    }
    __syncthreads();
}

constexpr int NWAVES = 8;
constexpr int M = 16384, D = 1024, DFF = 2816, INA = 3080, NC = 256;
constexpr float RMS_EPS = 1e-6f;
constexpr float LOG2E = 1.4426950408889634f;
constexpr float QSCALE_A = 0.08838834764831845f;
constexpr float C2 = 0.125f * LOG2E;

constexpr size_t MiB = 1u << 20;
constexpr size_t WS_CTL = 0, CTL_ZERO_BYTES = 1 * MiB;
constexpr size_t WS_SSP = 1 * MiB;
constexpr size_t WS_GATES = WS_SSP + 256 * 1024;
constexpr size_t WS_NST = 2 * MiB;
constexpr size_t WS_CH = WS_NST + 512 * 1024;
constexpr size_t WS_MS = WS_CH + 16 * 1024;
constexpr size_t WS_WGT = WS_MS + 16 * 1024;
constexpr size_t WS_BQ = WS_WGT + 64 * 1024;
constexpr size_t WS_WIN = 3 * MiB;
constexpr size_t WS_WOUT = 15 * MiB;
constexpr size_t WS_WQ2 = 19 * MiB;
constexpr size_t WS_WQ3 = WS_WQ2 + 1280 * 1024 * 2;
constexpr size_t WS_WBO = 24 * MiB;
constexpr size_t WS_WGU = 28 * MiB;
constexpr size_t WS_WD = 72 * MiB;
constexpr size_t WS_XB = 94 * MiB;
constexpr size_t WS_PROJ = 126 * MiB;
constexpr size_t WS_KV = 222 * MiB;
constexpr size_t WS_HG = 230 * MiB;
constexpr size_t WS_STATE = 262 * MiB;
constexpr size_t WS_END = 326 * MiB;
constexpr int CW_BAR = 4096;

constexpr int RING_OFF = 0, RING_BYTES = 131072;
constexpr int LDSCTL_OFF = RING_BYTES, MISC_OFF = LDSCTL_OFF + 320;
constexpr int LDS_BYTES = 147456;

typedef float f32x2 __attribute__((ext_vector_type(2)));
typedef unsigned u32x2 __attribute__((ext_vector_type(2)));
__device__ __forceinline__ float bf2f(unsigned short b) { return __builtin_bit_cast(float, (unsigned)b << 16); }
__device__ __forceinline__ float bflo(unsigned w) { return __builtin_bit_cast(float, w << 16); }
__device__ __forceinline__ float bfhi(unsigned w) { return __builtin_bit_cast(float, w & 0xffff0000u); }
__device__ __forceinline__ float wave_sum(float v) {
#pragma unroll
    for (int o = 1; o < 64; o <<= 1) v += __shfl_xor(v, o);
    return v;
}
__device__ __forceinline__ float rstd_of(const float* ssp, int row) { const f32x4 p = *(const f32x4*)(ssp + (size_t)row * 4); return rsqrtf(((p.x + p.y) + (p.z + p.w)) * (1.f / D) + RMS_EPS); }

struct EpiProj {
    static constexpr bool PERM = true, AFTER_DRAIN = false;
    bf16* O0; int ld0; bf16* O1; int ld1; int split; const float* bias; const float* ssp;
    __device__ __forceinline__ void operator()(const pg8::f32x4 (&acc)[2][2][4][2], const pg8::Unit& u, int wr, int wc, int fr, int fq) const {
        const int row0 = u.pm * 256 + wr * 64 + fr; int colt = u.pn * 256; bf16* base = O0; int ld = ld0;
        if (split && colt >= split) { base = O1; ld = ld1; colt -= split; }
        const int col0 = colt + wc * 32 + 8 * fq, bcol0 = u.pn * 256 + wc * 32 + 8 * fq;
        f32x4 bv[2][2];
#pragma unroll
        for (int bj = 0; bj < 2; ++bj)
#pragma unroll
            for (int n = 0; n < 2; ++n) bv[bj][n] = bias ? *(const f32x4*)(bias + bcol0 + bj * 128 + 4 * n) : (f32x4){0.f, 0.f, 0.f, 0.f};
#pragma unroll
        for (int ai = 0; ai < 2; ++ai)
#pragma unroll
            for (int m = 0; m < 4; ++m) { const int r = row0 + ai * 128 + m * 16; const float rs = rstd_of(ssp, r); bf16* rowp = base + (size_t)r * ld + col0;
#pragma unroll
                for (int bj = 0; bj < 2; ++bj) { const f32x4 v0 = acc[ai][bj][m][0] * rs + bv[bj][0], v1 = acc[ai][bj][m][1] * rs + bv[bj][1];
                    v4u w; w.x = pg8::cvt_pk_bf16(v0[0], v0[1]); w.y = pg8::cvt_pk_bf16(v0[2], v0[3]); w.z = pg8::cvt_pk_bf16(v1[0], v1[1]); w.w = pg8::cvt_pk_bf16(v1[2], v1[3]);
                    *(v4u*)(rowp + bj * 128) = w; } }
    }
};
__device__ __forceinline__ float silu_mul(float g, float u) { return g * __builtin_amdgcn_rcpf(1.f + __builtin_amdgcn_exp2f(-g * LOG2E)) * u; }
struct EpiSwiglu {
    static constexpr bool PERM = true, AFTER_DRAIN = false;
    bf16* H; const float* ssp;
    __device__ __forceinline__ void operator()(const pg8::f32x4 (&acc)[2][2][4][2], const pg8::Unit& u, int wr, int wc, int fr, int fq) const {
        const int row0 = u.pm * 256 + wr * 64 + fr, col0 = u.pn * 128 + wc * 32 + 8 * fq;
#pragma unroll
        for (int ai = 0; ai < 2; ++ai)
#pragma unroll
            for (int m = 0; m < 4; ++m) { const int r = row0 + ai * 128 + m * 16; const float rs = rstd_of(ssp, r);
                const f32x4 g0 = acc[ai][0][m][0] * rs, g1 = acc[ai][0][m][1] * rs, u0 = acc[ai][1][m][0] * rs, u1 = acc[ai][1][m][1] * rs;
                v4u w; w.x = pg8::cvt_pk_bf16(silu_mul(g0[0], u0[0]), silu_mul(g0[1], u0[1])); w.y = pg8::cvt_pk_bf16(silu_mul(g0[2], u0[2]), silu_mul(g0[3], u0[3]));
                w.z = pg8::cvt_pk_bf16(silu_mul(g1[0], u1[0]), silu_mul(g1[1], u1[1])); w.w = pg8::cvt_pk_bf16(silu_mul(g1[2], u1[2]), silu_mul(g1[3], u1[3]));
                *(v4u*)(H + (size_t)r * DFF + col0) = w; }
    }
};
struct EpiResid {
    static constexpr bool PERM = true, AFTER_DRAIN = true;
    const float* basef; const bf16* baseb; bf16* xb; const float* bias; float* ssp;
    __device__ __forceinline__ void fused(pg8::f32x4 (&acc)[2][2][4][2], const pg8::Unit& u, int wr, int wc, int fr, int fq, PG8_LAS unsigned char* lds, int wid, int lane) const {
        PG8_LAS float* P = (PG8_LAS float*)lds;
        const int col0 = u.pn * 256 + wc * 32 + 8 * fq;
        f32x4 bv[2][2];
#pragma unroll
        for (int bj = 0; bj < 2; ++bj)
#pragma unroll
            for (int n = 0; n < 2; ++n) bv[bj][n] = bias ? *(const f32x4*)(bias + col0 + bj * 128 + 4 * n) : (f32x4){0.f, 0.f, 0.f, 0.f};
#pragma unroll
        for (int ai = 0; ai < 2; ++ai)
#pragma unroll
            for (int m = 0; m < 4; ++m) { const int rl = ai * 128 + wr * 64 + m * 16 + fr; const size_t off = (size_t)(u.pm * 256 + rl) * D + col0; float ss = 0.f;
#pragma unroll
                for (int bj = 0; bj < 2; ++bj) { const size_t c = off + bj * 128; f32x4 b0, b1;
                    if (basef) { b0 = *(const f32x4*)(basef + c); b1 = *(const f32x4*)(basef + c + 4); }
                    else { const v4u bw = *(const v4u*)(baseb + c); b0 = (f32x4){bflo(bw.x), bfhi(bw.x), bflo(bw.y), bfhi(bw.y)}; b1 = (f32x4){bflo(bw.z), bfhi(bw.z), bflo(bw.w), bfhi(bw.w)}; }
                    const f32x4 v0 = b0 + acc[ai][bj][m][0] + bv[bj][0], v1 = b1 + acc[ai][bj][m][1] + bv[bj][1];
                    v4u w; w.x = pg8::cvt_pk_bf16(v0[0], v0[1]); w.y = pg8::cvt_pk_bf16(v0[2], v0[3]); w.z = pg8::cvt_pk_bf16(v1[0], v1[1]); w.w = pg8::cvt_pk_bf16(v1[2], v1[3]);
                    *(v4u*)(xb + c) = w;
                    const float r0 = bflo(w.x), r1 = bfhi(w.x), r2 = bflo(w.y), r3 = bfhi(w.y), r4 = bflo(w.z), r5 = bfhi(w.z), r6 = bflo(w.w), r7 = bfhi(w.w);
                    ss += ((r0 * r0 + r1 * r1) + (r2 * r2 + r3 * r3)) + ((r4 * r4 + r5 * r5) + (r6 * r6 + r7 * r7)); }
                ss += __shfl_xor(ss, 16); ss += __shfl_xor(ss, 32);
                if (fq == 0) P[rl * 4 + wc] = ss;
                if (m & 1) asm volatile("" ::: "memory"); }
        asm volatile("s_waitcnt lgkmcnt(0)" ::: "memory"); __builtin_amdgcn_s_barrier(); asm volatile("" ::: "memory");
        const int tid = wid * 64 + lane;
        if (tid < 256) { const f32x4 p = *(const PG8_LAS f32x4*)(P + tid * 4); ssp[(size_t)(u.pm * 256 + tid) * 4 + u.pn] = (p.x + p.y) + (p.z + p.w); }
        asm volatile("s_waitcnt lgkmcnt(0)" ::: "memory"); __builtin_amdgcn_s_barrier(); asm volatile("" ::: "memory");
    }
};

struct Frame {
    LAS unsigned char* lds;
    volatile LAS unsigned* MISC;
    gu32* ctl;
    int tid, lane, wave;
    int vcu, G;
};
struct Args { const float* in[19]; float* out; unsigned char* ws; };

#define LAUNDER_TID(F) do { int l_ = (int)__builtin_amdgcn_mbcnt_hi(~0u, __builtin_amdgcn_mbcnt_lo(~0u, 0u)); asm volatile("" : "+v"(l_)); (F).lane = l_; (F).tid = (F).wave * 64 + l_; } while (0)
__device__ __forceinline__ void conv_item(const float* W, int ldw, int K, int nblk, const float* gain, float qscale, int qcols, bf16* WT, int rowmode, int row_off, LAS float* scr, int item, int lane) {
    const int kb = item / nblk, nb = item % nblk, k0 = 64 * kb, n0 = 32 * nb;
    const float ns = (n0 < qcols) ? qscale : 1.f;
    {
        f32x4 wv[8];
#pragma unroll
        for (int i = 0; i < 8; ++i) wv[i] = *(const f32x4*)(W + (size_t)(k0 + 8 * i + (lane >> 3)) * ldw + n0 + 4 * (lane & 7));
#pragma unroll
        for (int i = 0; i < 8; ++i) { const int kk = 8 * i + (lane >> 3); const float gk = gain ? gain[k0 + kk] * ns : ns; LAS float* d = scr + kk * 33 + 4 * (lane & 7);
            d[0] = wv[i].x * gk; d[1] = wv[i].y * gk; d[2] = wv[i].z * gk; d[3] = wv[i].w * gk; }
    }
    LDS_WAIT(); asm volatile("" ::: "memory");
    int rbase;
    if (rowmode == 0) rbase = row_off + n0;
    else { int j = n0, add = 0; if (j >= DFF) { j -= DFF; add = 128; } rbase = 256 * (j / 128) + add + (j % 128); }
    const int c = lane & 7;
#pragma unroll
    for (int j = 0; j < 4; ++j) { const int n = (lane >> 3) + 8 * j; const LAS float* s = scr + (8 * c) * 33 + n;
        v4u o; o.x = pk2(s[0 * 33], s[1 * 33]); o.y = pk2(s[2 * 33], s[3 * 33]); o.z = pk2(s[4 * 33], s[5 * 33]); o.w = pk2(s[6 * 33], s[7 * 33]);
        *(GAS v4u*)(WT + (size_t)(rbase + n) * K + k0 + 8 * c) = o; }
    LDS_WAIT(); asm volatile("" ::: "memory");
}
__device__ __forceinline__ void p0_prologue(Frame& F, const Args& A) {
    LAUNDER_TID(F);
    LAS float* scr = (LAS float*)(F.lds + RING_OFF + F.wave * 16384);
    const int gw = F.vcu * NWAVES + F.wave, NGW = F.G * NWAVES;
    unsigned char* ws = A.ws;
    const float* a_norm = A.in[1]; const float* a_w_in = A.in[2]; const float* a_w_out = A.in[5]; const float* kv_norm = A.in[6]; const float* w_kv = A.in[7]; const float* b_kv = A.in[8];
    const float* b_norm = A.in[9]; const float* b_w_q = A.in[10]; const float* b_b_q = A.in[11]; const float* b_w_out = A.in[13]; const float* ffn_norm = A.in[15];
    const float* w_gate_up = A.in[16]; const float* w_down = A.in[17];
    constexpr int I_IN = 16 * 96, I_SQ = 16 * 32, I_KV = 16 * 8, I_GU = 16 * 176, I_DN = 44 * 32;
    constexpr int NITEMS = 2 * I_IN + 2 * I_SQ + (I_SQ + I_KV + I_SQ) + 2 * I_SQ + 4 * I_GU + 4 * I_DN;
    for (int it = gw; it < NITEMS; it += NGW) {
        int r = it;
        if (r < 2 * I_IN) { const int l = r / I_IN; r -= l * I_IN; conv_item(a_w_in + (size_t)l * D * INA, INA, D, 96, a_norm + l * D, QSCALE_A, 512, (bf16*)(ws + WS_WIN) + (size_t)l * 3072 * D, 0, 0, scr, r, F.lane); continue; } r -= 2 * I_IN;
        if (r < 2 * I_SQ) { const int l = r / I_SQ; r -= l * I_SQ; conv_item(a_w_out + (size_t)l * D * D, D, D, 32, nullptr, 1.f, 0, (bf16*)(ws + WS_WOUT) + (size_t)l * D * D, 0, 0, scr, r, F.lane); continue; } r -= 2 * I_SQ;
        if (r < I_SQ) { conv_item(b_w_q, D, D, 32, b_norm, C2, 1024, (bf16*)(ws + WS_WQ2), 0, 0, scr, r, F.lane); continue; } r -= I_SQ;
        if (r < I_KV) { conv_item(w_kv, 256, D, 8, kv_norm, 1.f, 0, (bf16*)(ws + WS_WQ2), 0, 1024, scr, r, F.lane); continue; } r -= I_KV;
        if (r < I_SQ) { conv_item(b_w_q + (size_t)D * D, D, D, 32, b_norm + D, C2, 1024, (bf16*)(ws + WS_WQ3), 0, 0, scr, r, F.lane); continue; } r -= I_SQ;
        if (r < 2 * I_SQ) { const int l = r / I_SQ; r -= l * I_SQ; conv_item(b_w_out + (size_t)l * D * D, D, D, 32, nullptr, 1.f, 0, (bf16*)(ws + WS_WBO) + (size_t)l * D * D, 0, 0, scr, r, F.lane); continue; } r -= 2 * I_SQ;
        if (r < 4 * I_GU) { const int l = r / I_GU; r -= l * I_GU; conv_item(w_gate_up + (size_t)l * D * 2 * DFF, 2 * DFF, D, 176, ffn_norm + l * D, 1.f, 0, (bf16*)(ws + WS_WGU) + (size_t)l * 2 * DFF * D, 1, 0, scr, r, F.lane); continue; } r -= 4 * I_GU;
        { const int l = r / I_DN; r -= l * I_DN; conv_item(w_down + (size_t)l * DFF * D, D, DFF, 32, nullptr, 1.f, 0, (bf16*)(ws + WS_WD) + (size_t)l * D * DFF, 0, 0, scr, r, F.lane); }
    }
    const float* x = A.in[0]; bf16* XB = (bf16*)(ws + WS_XB); float* SSP = (float*)(ws + WS_SSP);
    for (int m = gw; m < M; m += NGW) {
        const GAS f32x4* xr = (const GAS f32x4*)(x + (size_t)m * D) + F.lane; GAS u32x2* o8 = (GAS u32x2*)(XB + (size_t)m * D) + F.lane; float s = 0.f;
#pragma unroll
        for (int j = 0; j < 4; ++j) { const f32x4 v = xr[64 * j]; s += (v.x * v.x + v.y * v.y) + (v.z * v.z + v.w * v.w); u32x2 w; w.x = pk2(v.x, v.y); w.y = pk2(v.z, v.w); o8[64 * j] = w; }
        s = wave_sum(s);
        if (F.lane == 0) *(f32x4*)(SSP + (size_t)m * 4) = (f32x4){s, 0.f, 0.f, 0.f};
    }
    const int gt = F.vcu * (NWAVES * 64) + F.tid, NGT = F.G * NWAVES * 64;
    float* WGT = (float*)(ws + WS_WGT); float* BQ = (float*)(ws + WS_BQ);
    for (int i = gt; i < 2 * 8 * 1024; i += NGT) { const int l = i >> 13, j = (i >> 10) & 7, k = i & 1023; WGT[i] = a_w_in[(size_t)l * D * INA + (size_t)k * INA + 3072 + j] * a_norm[l * D + k]; }
    for (int i = gt; i < 2 * 1280; i += NGT) { const int l = i / 1280, c = i % 1280; BQ[i] = (c < 1024) ? b_b_q[l * D + c] * C2 : b_kv[c - 1024]; }
}

__device__ __forceinline__ float softcap15(float x) { return 15.f * tanhf(x * (1.f / 15.f)); }
__device__ __forceinline__ float logsigmoidf(float x) { return fminf(x, 0.f) - log1pf(expf(-fabsf(x))); }

__device__ __forceinline__ void gates_phase(Frame& F, const bf16* XB, const float* SSP, const float* WGTl, const float* bgl, float* GATES) {
    LAUNDER_TID(F);
    LAS float* Wl = (LAS float*)(F.lds + RING_OFF);
    for (int i = F.tid; i < 8 * 1024 / 4; i += NWAVES * 64) ((LAS f32x4*)Wl)[i] = ((const f32x4*)WGTl)[i];
    __syncthreads();
    for (int blk = F.vcu; blk < M / 64; blk += F.G) {
#pragma unroll 1
        for (int rr = 0; rr < 8; ++rr) {
            const int row = blk * 64 + F.wave * 8 + rr;
            float acc[8] = {0.f, 0.f, 0.f, 0.f, 0.f, 0.f, 0.f, 0.f};
#pragma unroll
            for (int i = 0; i < 4; ++i) { const int k = 4 * F.lane + 256 * i; const u32x2 xw = *(const u32x2*)(XB + (size_t)row * D + k);
                const float x0 = bflo(xw.x), x1 = bfhi(xw.x), x2 = bflo(xw.y), x3 = bfhi(xw.y);
#pragma unroll
                for (int j = 0; j < 8; ++j) { const f32x4 w = *(const LAS f32x4*)(Wl + j * 1024 + k); acc[j] += (x0 * w.x + x1 * w.y) + (x2 * w.z + x3 * w.w); } }
#pragma unroll
            for (int j = 0; j < 8; ++j) acc[j] = wave_sum(acc[j]);
            if (F.lane < 8) { float a = acc[0];
#pragma unroll
                for (int j = 1; j < 8; ++j) a = (F.lane == j) ? acc[j] : a;
                const float pre = softcap15(a * rstd_of(SSP, row) + bgl[F.lane]);
                GATES[(size_t)row * 8 + F.lane] = (F.lane < 4) ? pre : logsigmoidf(pre); }
        }
    }
    __syncthreads();
}

__device__ __forceinline__ void chunk_gates(Frame& F, const float* GATES, int c, int h, LAS float* bcum, LAS float* aval) {
    if (F.tid < 64) {
        const float lf = GATES[(size_t)(c * 64 + F.tid) * 8 + 4 + h], ig = GATES[(size_t)(c * 64 + F.tid) * 8 + h];
        float s = lf;
#pragma unroll
        for (int o = 1; o < 64; o <<= 1) { const float t = __shfl_up(s, o); if (F.lane >= o) s += t; }
        bcum[F.tid] = s; aval[F.tid] = ig - s;
    }
    __syncthreads();
}

__device__ __forceinline__ void ml_local_phase(Frame& F, const bf16* PROJ, const float* GATES, bf16* STATE, float* NST, float* CH) {
    LAUNDER_TID(F);
    LAS float* bcum = (LAS float*)(F.lds + RING_OFF); LAS float* aval = bcum + 64; LAS float* wsv = aval + 64;
    for (int unit = F.vcu; unit < NC * 4; unit += F.G) {
        const int c = unit >> 2, h = unit & 3;
        chunk_gates(F, GATES, c, h, bcum, aval);
        const float btot = bcum[63]; float amax = -INFINITY;
        for (int s = 0; s < 64; ++s) amax = fmaxf(amax, aval[s]);
        const float mloc = btot + amax;
        if (F.tid < 64) wsv[F.tid] = expf(btot + aval[F.tid] - mloc);
        __syncthreads();
        const bf16* kb = PROJ + (size_t)(c * 64) * 3072 + 512 + h * 128;
        const bf16* vb = PROJ + (size_t)(c * 64) * 3072 + 1024 + h * 256;
        const int v = F.tid >> 1, dh = F.tid & 1;
        float acc[64];
#pragma unroll
        for (int j = 0; j < 64; ++j) acc[j] = 0.f;
#pragma unroll 1
        for (int s = 0; s < 64; ++s) {
            const float wv = wsv[s] * bf2f(vb[(size_t)s * 3072 + v]);
            const v4u* kr = (const v4u*)(kb + (size_t)s * 3072 + dh * 64);
#pragma unroll
            for (int q = 0; q < 8; ++q) { const v4u kk = kr[q];
                acc[q * 8 + 0] += wv * bflo(kk.x); acc[q * 8 + 1] += wv * bfhi(kk.x); acc[q * 8 + 2] += wv * bflo(kk.y); acc[q * 8 + 3] += wv * bfhi(kk.y);
                acc[q * 8 + 4] += wv * bflo(kk.z); acc[q * 8 + 5] += wv * bfhi(kk.z); acc[q * 8 + 6] += wv * bflo(kk.w); acc[q * 8 + 7] += wv * bfhi(kk.w); }
        }
        bf16* st = STATE + ((size_t)(c * 4 + h) * 256 + v) * 128 + dh * 64;
#pragma unroll
        for (int q = 0; q < 8; ++q) { v4u o; o.x = pk2(acc[q * 8 + 0], acc[q * 8 + 1]); o.y = pk2(acc[q * 8 + 2], acc[q * 8 + 3]); o.z = pk2(acc[q * 8 + 4], acc[q * 8 + 5]); o.w = pk2(acc[q * 8 + 6], acc[q * 8 + 7]); *(v4u*)(st + q * 8) = o; }
        if (F.tid < 128) { float a = 0.f; for (int s = 0; s < 64; ++s) a += wsv[s] * bf2f(kb[(size_t)s * 3072 + F.tid]); NST[(size_t)(c * 4 + h) * 128 + F.tid] = a; }
        if (F.tid == 0) { CH[(c * 4 + h) * 2] = btot; CH[(c * 4 + h) * 2 + 1] = mloc; }
        __syncthreads();
    }
}

__device__ __forceinline__ void ml_scan_phase(Frame& F, bf16* STATE, float* NST, const float* CH, float* MS) {
    LAUNDER_TID(F);
    LAS float* f1 = (LAS float*)(F.lds + RING_OFF); LAS float* f2 = f1 + 256;
    const int h = F.vcu >> 6;
    if (F.tid < 64) {
        float bt[4], ml[4];
#pragma unroll
        for (int j = 0; j < 4; ++j) { const int c = 4 * F.lane + j; bt[j] = CH[(c * 4 + h) * 2]; ml[j] = CH[(c * 4 + h) * 2 + 1]; }
        float B = bt[0], Mx = ml[0];
#pragma unroll
        for (int j = 1; j < 4; ++j) { Mx = fmaxf(Mx + bt[j], ml[j]); B += bt[j]; }
#pragma unroll
        for (int o = 1; o < 64; o <<= 1) { const float Bp = __shfl_up(B, o), Mp = __shfl_up(Mx, o); if (F.lane >= o) { Mx = fmaxf(Mp + B, Mx); B = Bp + B; } }
        const float Bq = __shfl_up(B, 1), Mq = __shfl_up(Mx, 1);
        float m = (F.lane == 0) ? 0.f : fmaxf(Bq, Mq);
#pragma unroll
        for (int j = 0; j < 4; ++j) { const int c = 4 * F.lane + j; const float mn = fmaxf(bt[j] + m, ml[j]);
            f1[c] = expf(bt[j] + m - mn); f2[c] = expf(ml[j] - mn); if ((F.vcu & 63) == 0) MS[c * 4 + h] = m; m = mn; }
    }
    __syncthreads();
    if (F.tid < 256) {
        unsigned* base = (unsigned*)(STATE + (size_t)h * 32768) + ((F.vcu & 63) * 256 + F.tid);
        float c0v = 0.f, c1v = 0.f;
#pragma unroll 1
        for (int cb = 0; cb < NC; cb += 16) {
            unsigned u[16];
#pragma unroll
            for (int j = 0; j < 16; ++j) u[j] = base[(size_t)(cb + j) * 65536];
#pragma unroll
            for (int j = 0; j < 16; ++j) { const float a = f1[cb + j], b = f2[cb + j];
                base[(size_t)(cb + j) * 65536] = pg8::cvt_pk_bf16(c0v, c1v);
                c0v = a * c0v + b * bflo(u[j]); c1v = a * c1v + b * bfhi(u[j]); }
        }
    } else if ((F.vcu & 63) == 0 && F.tid < 384) {
        float* base = NST + h * 128 + (F.tid - 256); float nv = 0.f;
#pragma unroll 1
        for (int cb = 0; cb < NC; cb += 8) {
            float u[8];
#pragma unroll
            for (int j = 0; j < 8; ++j) u[j] = base[(size_t)(cb + j) * 512];
#pragma unroll
            for (int j = 0; j < 8; ++j) { base[(size_t)(cb + j) * 512] = nv; nv = f1[cb + j] * nv + f2[cb + j] * u[j]; }
        }
    }
    __syncthreads();
}

__device__ __forceinline__ void ml_out_phase(Frame& F, const bf16* PROJ, const float* GATES, const bf16* STATE, const float* NST, const float* MS, const float* hnorm, bf16* HG) {
    LAUNDER_TID(F);
    LAS float* bcum = (LAS float*)(F.lds + RING_OFF); LAS float* aval = bcum + 64; LAS float* mt = aval + 64; LAS float* et = mt + 64; LAS float* den = et + 64; LAS float* nq = den + 64;
    LAS float* red = nq + 64;
    LAS float* S = red + 64;
    const float scale = 1.f;
    for (int unit = F.vcu; unit < NC * 4; unit += F.G) {
        const int c = unit >> 2, h = unit & 3;
        chunk_gates(F, GATES, c, h, bcum, aval);
        const float mc = MS[c * 4 + h];
        if (F.tid < 64) { float am = -INFINITY; for (int s = 0; s <= F.tid; ++s) am = fmaxf(am, aval[s]); const float m_t = bcum[F.tid] + fmaxf(mc, am); mt[F.tid] = m_t; et[F.tid] = expf(bcum[F.tid] + mc - m_t); }
        __syncthreads();
        const bf16* qb = PROJ + (size_t)(c * 64) * 3072 + h * 128;
        const bf16* kb = PROJ + (size_t)(c * 64) * 3072 + 512 + h * 128;
        const bf16* vb = PROJ + (size_t)(c * 64) * 3072 + 1024 + h * 256;
        {
            const int t = F.tid >> 3;
#pragma unroll 1
            for (int j = 0; j < 8; ++j) { const int s = (F.tid & 7) * 8 + j; float a = 0.f;
                if (s <= t) { const v4u* qr = (const v4u*)(qb + (size_t)t * 3072); const v4u* kr = (const v4u*)(kb + (size_t)s * 3072);
#pragma unroll 4
                    for (int q = 0; q < 16; ++q) { const v4u a4 = qr[q], b4 = kr[q];
                        a += bflo(a4.x) * bflo(b4.x) + bfhi(a4.x) * bfhi(b4.x) + bflo(a4.y) * bflo(b4.y) + bfhi(a4.y) * bfhi(b4.y) + bflo(a4.z) * bflo(b4.z) + bfhi(a4.z) * bfhi(b4.z) + bflo(a4.w) * bflo(b4.w) + bfhi(a4.w) * bfhi(b4.w); }
                    a *= scale * expf(bcum[t] + aval[s] - mt[t]); }
                S[t * 65 + s] = a; }
        }
        if (F.tid < 64) { float a = 0.f; const float* nn = NST + (size_t)(c * 4 + h) * 128; for (int d = 0; d < 128; ++d) a += nn[d] * bf2f(qb[(size_t)F.tid * 3072 + d]); nq[F.tid] = a * scale; }
        __syncthreads();
        if (F.tid < 64) { float a = 0.f; for (int s = 0; s < 64; ++s) a += S[F.tid * 65 + s]; a += et[F.tid] * nq[F.tid]; den[F.tid] = fmaxf(fabsf(a), expf(-mt[F.tid])); }
        __syncthreads();
        const int v = F.tid & 255, th = F.tid >> 8;
        v4u Cc[16];
        { const v4u* st = (const v4u*)(STATE + ((size_t)(c * 4 + h) * 256 + v) * 128);
#pragma unroll
          for (int q = 0; q < 16; ++q) Cc[q] = st[q]; }
        const float gain = hnorm[h * 256 + v];
#pragma unroll 1
        for (int tt = 0; tt < 32; ++tt) {
            const int t = th * 32 + tt;
            float a = 0.f;
            for (int s = 0; s <= t; ++s) a += S[t * 65 + s] * bf2f(vb[(size_t)s * 3072 + v]);
            float b = 0.f; const v4u* qr = (const v4u*)(qb + (size_t)t * 3072);
#pragma unroll
            for (int q = 0; q < 16; ++q) { const v4u a4 = qr[q], b4 = Cc[q];
                b += bflo(a4.x) * bflo(b4.x) + bfhi(a4.x) * bfhi(b4.x) + bflo(a4.y) * bflo(b4.y) + bfhi(a4.y) * bfhi(b4.y) + bflo(a4.z) * bflo(b4.z) + bfhi(a4.z) * bfhi(b4.z) + bflo(a4.w) * bflo(b4.w) + bfhi(a4.w) * bfhi(b4.w); }
            const float hv = (a + et[t] * scale * b) / den[t];
            const float ss = wave_sum(hv * hv);
            __syncthreads();
            if (F.lane == 0) red[F.wave] = ss;
            __syncthreads();
            const float tot = (red[th * 4] + red[th * 4 + 1]) + (red[th * 4 + 2] + red[th * 4 + 3]);
            const float r = rsqrtf(tot * (1.f / 256.f) + RMS_EPS);
            const size_t row = (size_t)(c * 64 + t);
            const float o = bf2f(PROJ[row * 3072 + 2048 + h * 256 + v]);
            HG[row * D + h * 256 + v] = (bf16)f2bf(hv * r * gain / (1.f + expf(-o)));
        }
        __syncthreads();
    }
}

__device__ __forceinline__ void attn_phase(Frame& F, const bf16* Q, const bf16* KV, const float* sinks, bf16* O) {
    LAUNDER_TID(F);
    for (int unit = F.vcu; unit < 128 * 16; unit += F.G) {
        const int nb = unit >> 4, head = unit & 15, kvh = head >> 3;
        const int i = F.tid >> 2, part = F.tid & 3;
        const int qpos = nb * 128 + i;
        float q[16], o[16];
        { const v4u* qr = (const v4u*)(Q + (size_t)qpos * D + head * 64 + part * 16);
#pragma unroll
          for (int w = 0; w < 2; ++w) { const v4u a = qr[w]; q[w * 8 + 0] = bflo(a.x); q[w * 8 + 1] = bfhi(a.x); q[w * 8 + 2] = bflo(a.y); q[w * 8 + 3] = bfhi(a.y); q[w * 8 + 4] = bflo(a.z); q[w * 8 + 5] = bfhi(a.z); q[w * 8 + 6] = bflo(a.w); q[w * 8 + 7] = bfhi(a.w); } }
        float m = sinks[head] * LOG2E, l = 1.f;
#pragma unroll
        for (int d = 0; d < 16; ++d) o[d] = 0.f;
        const int j0 = (nb == 0) ? 128 : 0;
#pragma unroll 1
        for (int j = j0; j < 256; ++j) {
            const int kpos = (nb - 1) * 128 + j;
            const int rel = i + 128 - j;
            const bool valid = (rel >= 0) && (rel < 128);
            const v4u* kr = (const v4u*)(KV + (size_t)kpos * 256 + kvh * 64 + part * 16);
            const v4u* vr = (const v4u*)(KV + (size_t)kpos * 256 + 128 + kvh * 64 + part * 16);
            float kf[16], vf[16];
#pragma unroll
            for (int w = 0; w < 2; ++w) { const v4u a = kr[w]; kf[w * 8 + 0] = bflo(a.x); kf[w * 8 + 1] = bfhi(a.x); kf[w * 8 + 2] = bflo(a.y); kf[w * 8 + 3] = bfhi(a.y); kf[w * 8 + 4] = bflo(a.z); kf[w * 8 + 5] = bfhi(a.z); kf[w * 8 + 6] = bflo(a.w); kf[w * 8 + 7] = bfhi(a.w);
                const v4u b = vr[w]; vf[w * 8 + 0] = bflo(b.x); vf[w * 8 + 1] = bfhi(b.x); vf[w * 8 + 2] = bflo(b.y); vf[w * 8 + 3] = bfhi(b.y); vf[w * 8 + 4] = bflo(b.z); vf[w * 8 + 5] = bfhi(b.z); vf[w * 8 + 6] = bflo(b.w); vf[w * 8 + 7] = bfhi(b.w); }
            float s = 0.f;
#pragma unroll
            for (int d = 0; d < 16; ++d) s += q[d] * kf[d];
            s += __shfl_xor(s, 1); s += __shfl_xor(s, 2);
            if (valid) {
                const float mn = fmaxf(m, s), corr = __builtin_amdgcn_exp2f(m - mn), p = __builtin_amdgcn_exp2f(s - mn);
                l = l * corr + p;
#pragma unroll
                for (int d = 0; d < 16; ++d) o[d] = o[d] * corr + p * vf[d];
                m = mn;
            }
        }
        const float inv = 1.f / l;
        v4u w0, w1;
        w0.x = pk2(o[0] * inv, o[1] * inv); w0.y = pk2(o[2] * inv, o[3] * inv); w0.z = pk2(o[4] * inv, o[5] * inv); w0.w = pk2(o[6] * inv, o[7] * inv);
        w1.x = pk2(o[8] * inv, o[9] * inv); w1.y = pk2(o[10] * inv, o[11] * inv); w1.z = pk2(o[12] * inv, o[13] * inv); w1.w = pk2(o[14] * inv, o[15] * inv);
        v4u* op = (v4u*)(O + (size_t)qpos * D + head * 64 + part * 16); op[0] = w0; op[1] = w1;
    }
}

__device__ __forceinline__ void final_norm_phase(Frame& F, float* out, const bf16* XB, const float* SSP, const float* g) {
    LAUNDER_TID(F);
    const int gw = F.vcu * NWAVES + F.wave, NGW = F.G * NWAVES;
    for (int m = gw; m < M; m += NGW) {
        const float rs = rstd_of(SSP, m);
        GAS f32x4* xr = (GAS f32x4*)(out + (size_t)m * D) + F.lane; const f32x4* gg = (const f32x4*)g + F.lane; const u32x2* xb = (const u32x2*)(XB + (size_t)m * D) + F.lane;
#pragma unroll
        for (int j = 0; j < 4; ++j) { const u32x2 v = xb[64 * j]; const f32x4 w = gg[64 * j]; xr[64 * j] = (f32x4){bflo(v.x) * rs * w.x, bfhi(v.x) * rs * w.y, bflo(v.y) * rs * w.z, bfhi(v.y) * rs * w.w}; }
    }
}

typedef float f32x16 __attribute__((ext_vector_type(16)));
typedef short s16x4 __attribute__((ext_vector_type(4)));
typedef short v4i16_t __attribute__((ext_vector_type(4)));
__device__ __forceinline__ s16x4 tr16(const LAS unsigned char* p) { return __builtin_bit_cast(s16x4, __builtin_amdgcn_ds_read_tr16_b64_v4i16((LAS v4i16_t*)p)); }
__device__ __forceinline__ bf16x8 cat8(s16x4 a, s16x4 b) { return (bf16x8){a[0], a[1], a[2], a[3], b[0], b[1], b[2], b[3]}; }
__device__ __forceinline__ unsigned cvtpk(float lo, float hi) { return pg8::cvt_pk_bf16(lo, hi); }
__device__ __forceinline__ bf16x8 pack8(const f32x16& p, int s) {
    v4u w; w.x = cvtpk(p[8 * s + 0], p[8 * s + 1]); w.y = cvtpk(p[8 * s + 2], p[8 * s + 3]); w.z = cvtpk(p[8 * s + 4], p[8 * s + 5]); w.w = cvtpk(p[8 * s + 6], p[8 * s + 7]);
    return __builtin_bit_cast(bf16x8, w);
}
#define MFMA32(a, b, c) __builtin_amdgcn_mfma_f32_32x32x16_bf16((a), (b), (c), 0, 0, 0)
#define CROW(r, hi) (((r) & 3) + 8 * ((r) >> 2) + 4 * (hi))

__device__ __forceinline__ void attn_phase_mfma(Frame& F, const bf16* Q, const bf16* KV, const float* sinks, bf16* O) {
    LAUNDER_TID(F);
    LAS unsigned char* Kl = F.lds + RING_OFF;
    LAS unsigned char* Vl = Kl + 32768;
    const int lane = F.lane, r32 = lane & 31, hi = lane >> 5;
    for (int unit = F.vcu; unit < 256; unit += F.G) {
        const int nb = unit >> 1, kvh = unit & 1, head = kvh * 8 + F.wave;
#pragma unroll
        for (int i = 0; i < 4; ++i) { const int p = F.tid + 512 * i, key = p >> 3, c = p & 7, kpos = (nb - 1) * 128 + key;
            if (kpos >= 0) { const v4u kk = *(const v4u*)(KV + (size_t)kpos * 256 + kvh * 64 + c * 8); const v4u vv = *(const v4u*)(KV + (size_t)kpos * 256 + 128 + kvh * 64 + c * 8);
                *(LAS v4u*)(Kl + key * 128 + ((c ^ ((key >> 1) & 7)) << 4)) = kk; *(LAS v4u*)(Vl + (c >> 2) * 16384 + key * 64 + (c & 3) * 16) = vv; } }
        __syncthreads();
        const float sk = sinks[head] * LOG2E;
#pragma unroll 1
        for (int qb = 0; qb < 4; ++qb) {
            const int qpos = nb * 128 + qb * 32 + r32;
            bf16x8 qf[4];
#pragma unroll
            for (int kk = 0; kk < 4; ++kk) qf[kk] = *(const bf16x8*)(Q + (size_t)qpos * D + head * 64 + kk * 16 + hi * 8);
            f32x16 sacc[5];
#pragma unroll
            for (int t = 0; t < 5; ++t) {
#pragma unroll
                for (int r = 0; r < 16; ++r) sacc[t][r] = 0.f;
                if (nb > 0 || qb + t >= 4) { const int key = (qb + t) * 32 + r32;
#pragma unroll
                    for (int kk = 0; kk < 4; ++kk) { const int c = 2 * kk + hi; const bf16x8 kf = *(const LAS bf16x8*)(Kl + key * 128 + ((c ^ ((key >> 1) & 7)) << 4)); sacc[t] = MFMA32(kf, qf[kk], sacc[t]); } }
            }
            float mx = sk;
#pragma unroll
            for (int t = 0; t < 5; ++t) { const bool live = (nb > 0 || qb + t >= 4);
#pragma unroll
                for (int r = 0; r < 16; ++r) { const int cr = CROW(r, hi); bool valid = live; if (t == 0) valid = valid && (cr > r32); if (t == 4) valid = valid && (cr <= r32);
                    const float s = valid ? sacc[t][r] : -INFINITY; sacc[t][r] = s; mx = fmaxf(mx, s); } }
            mx = fmaxf(mx, __shfl_xor(mx, 32));
            float l = 0.f;
#pragma unroll
            for (int t = 0; t < 5; ++t)
#pragma unroll
                for (int r = 0; r < 16; ++r) { const float p = __builtin_amdgcn_exp2f(sacc[t][r] - mx); sacc[t][r] = p; l += p; }
            l += __shfl_xor(l, 32); l += __builtin_amdgcn_exp2f(sk - mx);
            f32x16 oacc[2];
#pragma unroll
            for (int r = 0; r < 16; ++r) { oacc[0][r] = 0.f; oacc[1][r] = 0.f; }
#pragma unroll
            for (int t = 0; t < 5; ++t) if (nb > 0 || qb + t >= 4) {
#pragma unroll
                for (int s = 0; s < 2; ++s) { const bf16x8 pf = pack8(sacc[t], s);
#pragma unroll
                    for (int dt = 0; dt < 2; ++dt) { const LAS unsigned char* vp = Vl + dt * 16384 + ((qb + t) * 32 + 16 * s + 4 * hi + ((lane & 15) >> 2)) * 64 + ((lane >> 4) & 1) * 32 + (lane & 3) * 8;
                        const bf16x8 vf = cat8(tr16(vp), tr16(vp + 8 * 64)); oacc[dt] = MFMA32(vf, pf, oacc[dt]); } } }
            const float inv = 1.f / l;
            bf16* orow = O + (size_t)qpos * D + head * 64 + 4 * hi;
#pragma unroll
            for (int dt = 0; dt < 2; ++dt)
#pragma unroll
                for (int gq = 0; gq < 4; ++gq) { u32x2 w; w.x = cvtpk(oacc[dt][4 * gq] * inv, oacc[dt][4 * gq + 1] * inv); w.y = cvtpk(oacc[dt][4 * gq + 2] * inv, oacc[dt][4 * gq + 3] * inv);
                    *(u32x2*)(orow + 32 * dt + 8 * gq) = w; }
        }
        __syncthreads();
    }
}

__device__ __forceinline__ void ml_local_phase_mfma(Frame& F, const bf16* PROJ, const float* GATES, bf16* STATE, float* NST, float* CH) {
    LAUNDER_TID(F);
    LAS unsigned char* Kl = F.lds + RING_OFF;
    LAS unsigned char* Vl = Kl + 16384;
    LAS float* bcum = (LAS float*)(Vl + 32768); LAS float* aval = bcum + 64; LAS float* wsv = aval + 64;
    const int lane = F.lane, r32 = lane & 31, hi = lane >> 5;
    for (int unit = F.vcu; unit < NC * 4; unit += F.G) {
        const int c = unit >> 2, h = unit & 3;
        chunk_gates(F, GATES, c, h, bcum, aval);
        const float btot = bcum[63]; float amax = -INFINITY;
        for (int s = 0; s < 64; ++s) amax = fmaxf(amax, aval[s]);
        const float mloc = btot + amax;
        if (F.tid < 64) wsv[F.tid] = expf(btot + aval[F.tid] - mloc);
        __syncthreads();
        const bf16* kb = PROJ + (size_t)(c * 64) * 3072 + 512 + h * 128;
        const bf16* vb = PROJ + (size_t)(c * 64) * 3072 + 1024 + h * 256;
#pragma unroll
        for (int i = 0; i < 2; ++i) { const int p = F.tid + 512 * i, s = p >> 4, cc = p & 15; const v4u kk = *(const v4u*)(kb + (size_t)s * 3072 + cc * 8); const float w = wsv[s];
            v4u o; o.x = pk2(bflo(kk.x) * w, bfhi(kk.x) * w); o.y = pk2(bflo(kk.y) * w, bfhi(kk.y) * w); o.z = pk2(bflo(kk.z) * w, bfhi(kk.z) * w); o.w = pk2(bflo(kk.w) * w, bfhi(kk.w) * w);
            *(LAS v4u*)(Kl + (cc >> 2) * 4096 + s * 64 + (cc & 3) * 16) = o; }
#pragma unroll
        for (int i = 0; i < 4; ++i) { const int p = F.tid + 512 * i, s = p >> 5, cc = p & 31; const v4u vv = *(const v4u*)(vb + (size_t)s * 3072 + cc * 8);
            *(LAS v4u*)(Vl + (cc >> 2) * 4096 + s * 64 + (cc & 3) * 16) = vv; }
        if (F.tid == 0) { CH[(c * 4 + h) * 2] = btot; CH[(c * 4 + h) * 2 + 1] = mloc; }
        __syncthreads();
        if (F.tid >= 384) { const int d = F.tid - 384; float a = 0.f; const LAS unsigned short* kc = (const LAS unsigned short*)(Kl + (d >> 5) * 4096 + (d & 31) * 2);
#pragma unroll 16
            for (int s = 0; s < 64; ++s) a += bf2f(kc[s * 32]);
            NST[(size_t)(c * 4 + h) * 128 + d] = a; }
        f32x16 acc[4];
#pragma unroll
        for (int dt = 0; dt < 4; ++dt)
#pragma unroll
            for (int r = 0; r < 16; ++r) acc[dt][r] = 0.f;
        const int troff = (4 * hi + ((lane & 15) >> 2)) * 64 + ((lane >> 4) & 1) * 32 + (lane & 3) * 8;
#pragma unroll
        for (int ks = 0; ks < 4; ++ks) {
            const LAS unsigned char* vp = Vl + F.wave * 4096 + ks * 16 * 64 + troff;
            const bf16x8 vf = cat8(tr16(vp), tr16(vp + 8 * 64));
#pragma unroll
            for (int dt = 0; dt < 4; ++dt) { const LAS unsigned char* kp = Kl + dt * 4096 + ks * 16 * 64 + troff;
                const bf16x8 kf = cat8(tr16(kp), tr16(kp + 8 * 64));
                acc[dt] = MFMA32(kf, vf, acc[dt]); }
        }
        bf16* st = STATE + ((size_t)(c * 4 + h) * 256 + F.wave * 32 + r32) * 128 + 4 * hi;
#pragma unroll
        for (int dt = 0; dt < 4; ++dt)
#pragma unroll
            for (int gq = 0; gq < 4; ++gq) { u32x2 w; w.x = cvtpk(acc[dt][4 * gq], acc[dt][4 * gq + 1]); w.y = cvtpk(acc[dt][4 * gq + 2], acc[dt][4 * gq + 3]); *(u32x2*)(st + 32 * dt + 8 * gq) = w; }
        __syncthreads();
    }
}

__device__ __forceinline__ void ml_out_phase_mfma(Frame& F, const bf16* PROJ, const float* GATES, const bf16* STATE, const float* NST, const float* MS, const float* hnorm, bf16* HG) {
    LAUNDER_TID(F);
    LAS unsigned char* Vl = F.lds + RING_OFF;
    LAS float* bcum = (LAS float*)(Vl + 32768); LAS float* aval = bcum + 64; LAS float* mt = aval + 64; LAS float* et = mt + 64; LAS float* nst = et + 64  ; LAS float* red = nst + 128  ;
    const int lane = F.lane, r32 = lane & 31, hi = lane >> 5, tb = F.wave >> 2, vq = F.wave & 3;
    for (int unit = F.vcu; unit < NC * 4; unit += F.G) {
        const int c = unit >> 2, h = unit & 3;
        const float mc = MS[c * 4 + h];
        if (F.tid < 64) {
            const float lf = GATES[(size_t)(c * 64 + F.tid) * 8 + 4 + h], ig = GATES[(size_t)(c * 64 + F.tid) * 8 + h];
            float s = lf;
#pragma unroll
            for (int o = 1; o < 64; o <<= 1) { const float t = __shfl_up(s, o); if (lane >= o) s += t; }
            const float a = ig - s; float am = a;
#pragma unroll
            for (int o = 1; o < 64; o <<= 1) { const float t = __shfl_up(am, o); if (lane >= o) am = fmaxf(am, t); }
            const float m_t = s + fmaxf(mc, am);
            bcum[F.tid] = s; aval[F.tid] = a; mt[F.tid] = m_t; et[F.tid] = expf(s + mc - m_t);
        }
        if (F.tid >= 64 && F.tid < 192) nst[F.tid - 64] = NST[(size_t)(c * 4 + h) * 128 + F.tid - 64];
        const bf16* qb = PROJ + (size_t)(c * 64) * 3072 + h * 128;
        const bf16* kb = PROJ + (size_t)(c * 64) * 3072 + 512 + h * 128;
        const bf16* vb = PROJ + (size_t)(c * 64) * 3072 + 1024 + h * 256;
#pragma unroll
        for (int i = 0; i < 4; ++i) { const int p = F.tid + 512 * i, s = p >> 5, cc = p & 31; const v4u vv = *(const v4u*)(vb + (size_t)s * 3072 + cc * 8);
            *(LAS v4u*)(Vl + (cc >> 2) * 4096 + s * 64 + (cc & 3) * 16) = vv; }
        const int t = tb * 32 + r32;
        bf16x8 qf[8];
#pragma unroll
        for (int kk = 0; kk < 8; ++kk) qf[kk] = *(const bf16x8*)(qb + (size_t)t * 3072 + kk * 16 + hi * 8);
        f32x16 sacc[2];
#pragma unroll
        for (int sb = 0; sb < 2; ++sb) {
#pragma unroll
            for (int r = 0; r < 16; ++r) sacc[sb][r] = 0.f;
            if (sb <= tb) {
#pragma unroll
                for (int kk = 0; kk < 8; ++kk) { const bf16x8 kf = *(const bf16x8*)(kb + (size_t)(sb * 32 + r32) * 3072 + kk * 16 + hi * 8); sacc[sb] = MFMA32(kf, qf[kk], sacc[sb]); } }
        }
        __syncthreads();
        const float b_t = bcum[t], m_t = mt[t], e_t = et[t];
        float dsum = 0.f;
#pragma unroll
        for (int sb = 0; sb < 2; ++sb)
#pragma unroll
            for (int gq = 0; gq < 4; ++gq) { const f32x4 a4 = *(const LAS f32x4*)(aval + sb * 32 + 8 * gq + 4 * hi);
#pragma unroll
                for (int i = 0; i < 4; ++i) { const int r = 4 * gq + i, cr = 8 * gq + 4 * hi + i; const bool valid = (sb < tb) || (sb == tb && cr <= r32);
                    const float w = valid ? sacc[sb][r] * expf(b_t + a4[i] - m_t) : 0.f; sacc[sb][r] = w; dsum += w; } }
        float nq = 0.f;
#pragma unroll
        for (int kk = 0; kk < 8; ++kk) { const v4u qw = __builtin_bit_cast(v4u, qf[kk]); const f32x4 n0 = *(const LAS f32x4*)(nst + kk * 16 + hi * 8), n1 = *(const LAS f32x4*)(nst + kk * 16 + hi * 8 + 4);
            nq += (bflo(qw.x) * n0.x + bfhi(qw.x) * n0.y) + (bflo(qw.y) * n0.z + bfhi(qw.y) * n0.w) + (bflo(qw.z) * n1.x + bfhi(qw.z) * n1.y) + (bflo(qw.w) * n1.z + bfhi(qw.w) * n1.w); }
        dsum += __shfl_xor(dsum, 32); nq += __shfl_xor(nq, 32);
        const float dd = fmaxf(fabsf(dsum + e_t * nq), expf(-m_t));
        const float dinv = 1.f / dd;
        f32x16 hacc[2];
        const int troff = (4 * hi + ((lane & 15) >> 2)) * 64 + ((lane >> 4) & 1) * 32 + (lane & 3) * 8;
        float ss = 0.f;
#pragma unroll
        for (int vt = 0; vt < 2; ++vt) {
            f32x16 ia, xa;
#pragma unroll
            for (int r = 0; r < 16; ++r) { ia[r] = 0.f; xa[r] = 0.f; }
#pragma unroll
            for (int sb = 0; sb < 2; ++sb) if (sb <= tb) {
#pragma unroll
                for (int s16 = 0; s16 < 2; ++s16) { const LAS unsigned char* vp = Vl + (vq * 2 + vt) * 4096 + (sb * 32 + s16 * 16) * 64 + troff;
                    const bf16x8 vf = cat8(tr16(vp), tr16(vp + 8 * 64)); ia = MFMA32(vf, pack8(sacc[sb], s16), ia); } }
            const bf16* cb = STATE + ((size_t)(c * 4 + h) * 256 + vq * 64 + vt * 32 + r32) * 128 + hi * 8;
#pragma unroll
            for (int kk = 0; kk < 8; ++kk) { const bf16x8 cf = *(const bf16x8*)(cb + kk * 16); xa = MFMA32(cf, qf[kk], xa); }
#pragma unroll
            for (int r = 0; r < 16; ++r) { const float hv = (ia[r] + e_t * xa[r]) * dinv; hacc[vt][r] = hv; ss += hv * hv; }
        }
        ss += __shfl_xor(ss, 32);
        if (hi == 0) red[(tb * 4 + vq) * 32 + r32] = ss;
        __syncthreads();
        const float tot = (red[(tb * 4 + 0) * 32 + r32] + red[(tb * 4 + 1) * 32 + r32]) + (red[(tb * 4 + 2) * 32 + r32] + red[(tb * 4 + 3) * 32 + r32]);
        const float rn = rsqrtf(tot * (1.f / 256.f) + RMS_EPS);
        const size_t row = (size_t)(c * 64 + t);
#pragma unroll
        for (int vt = 0; vt < 2; ++vt)
#pragma unroll
            for (int gq = 0; gq < 4; ++gq) { const int v0 = h * 256 + vq * 64 + vt * 32 + 8 * gq + 4 * hi;
                const f32x4 gn = *(const f32x4*)(hnorm + v0); const u32x2 ow = *(const u32x2*)(PROJ + row * 3072 + 2048 + v0);
                const float o0 = bflo(ow.x), o1 = bfhi(ow.x), o2 = bflo(ow.y), o3 = bfhi(ow.y);
                const float y0 = hacc[vt][4 * gq] * rn * gn.x / (1.f + expf(-o0)), y1 = hacc[vt][4 * gq + 1] * rn * gn.y / (1.f + expf(-o1));
                const float y2 = hacc[vt][4 * gq + 2] * rn * gn.z / (1.f + expf(-o2)), y3 = hacc[vt][4 * gq + 3] * rn * gn.w / (1.f + expf(-o3));
                u32x2 w; w.x = cvtpk(y0, y1); w.y = cvtpk(y2, y3); *(u32x2*)(HG + row * D + v0) = w; }
        __syncthreads();
    }
}


constexpr int NSC = 64;
constexpr int GA_OFF = 132096;
__device__ __forceinline__ void sc_gates(const float* GATES, int sc, int h, int lane, LAS float* bcum, LAS float* aval, LAS float* amc, float& btot, float& amax) {
    float lf[4], ig[4];
#pragma unroll
    for (int j = 0; j < 4; ++j) { const size_t row = (size_t)sc * 256 + 4 * lane + j; lf[j] = GATES[row * 8 + 4 + h]; ig[j] = GATES[row * 8 + h]; }
    float b[4]; b[0] = lf[0]; b[1] = b[0] + lf[1]; b[2] = b[1] + lf[2]; b[3] = b[2] + lf[3];
    float inc = b[3];
#pragma unroll
    for (int o = 1; o < 64; o <<= 1) { const float t = __shfl_up(inc, o); if (lane >= o) inc += t; }
    const float excl = inc - b[3];
    float a[4], cm[4];
#pragma unroll
    for (int j = 0; j < 4; ++j) { b[j] += excl; a[j] = ig[j] - b[j]; }
    cm[0] = a[0]; cm[1] = fmaxf(cm[0], a[1]); cm[2] = fmaxf(cm[1], a[2]); cm[3] = fmaxf(cm[2], a[3]);
    float inc2 = cm[3];
#pragma unroll
    for (int o = 1; o < 64; o <<= 1) { const float t = __shfl_up(inc2, o); if (lane >= o) inc2 = fmaxf(inc2, t); }
    float prev = __shfl_up(inc2, 1); if (lane == 0) prev = -INFINITY;
#pragma unroll
    for (int j = 0; j < 4; ++j) cm[j] = fmaxf(cm[j], prev);
    *(LAS f32x4*)(bcum + 4 * lane) = (f32x4){b[0], b[1], b[2], b[3]};
    *(LAS f32x4*)(aval + 4 * lane) = (f32x4){a[0], a[1], a[2], a[3]};
    *(LAS f32x4*)(amc + 4 * lane) = (f32x4){cm[0], cm[1], cm[2], cm[3]};
    btot = __shfl(inc, 63); amax = __shfl(inc2, 63);
}

__device__ __forceinline__ void ml_local256(Frame& F, const bf16* PROJ, const float* GATES, bf16* STATE, float* NST, float* CH) {
    LAUNDER_TID(F);
    LAS unsigned char* Kl = F.lds + RING_OFF;
    LAS unsigned char* Vl = Kl + 16384;
    LAS float* bcum = (LAS float*)(F.lds + GA_OFF); LAS float* aval = bcum + 256; LAS float* amc = aval + 256; LAS float* wsv = amc + 256;
    const int lane = F.lane, r32 = lane & 31, hi = lane >> 5;
    for (int unit = F.vcu; unit < NSC * 4; unit += F.G) {
        const int sc = unit >> 2, h = unit & 3;
        const bf16* kb = PROJ + (size_t)(sc * 256) * 3072 + 512 + h * 128;
        const bf16* vb = PROJ + (size_t)(sc * 256) * 3072 + 1024 + h * 256;
        v4u kreg[2], vreg[4];
#define ML_LOAD(j) do { _Pragma("unroll") for (int i = 0; i < 2; ++i) { const int p = F.tid + 512 * i, s = p >> 4, cc = p & 15; kreg[i] = *(const v4u*)(kb + (size_t)((j) * 64 + s) * 3072 + cc * 8); } \
                        _Pragma("unroll") for (int i = 0; i < 4; ++i) { const int p = F.tid + 512 * i, s = p >> 5, cc = p & 31; vreg[i] = *(const v4u*)(vb + (size_t)((j) * 64 + s) * 3072 + cc * 8); } } while (0)
        ML_LOAD(0);
        if (F.tid < 64) {
            float btot, amax; sc_gates(GATES, sc, h, lane, bcum, aval, amc, btot, amax);
            const float mloc = btot + amax; const f32x4 a4 = *(const LAS f32x4*)(aval + 4 * lane);
            *(LAS f32x4*)(wsv + 4 * lane) = (f32x4){expf(btot + a4.x - mloc), expf(btot + a4.y - mloc), expf(btot + a4.z - mloc), expf(btot + a4.w - mloc)};
            if (lane == 0) { CH[(sc * 4 + h) * 2] = btot; CH[(sc * 4 + h) * 2 + 1] = mloc; }
        }
        f32x16 acc[4];
#pragma unroll
        for (int dt = 0; dt < 4; ++dt)
#pragma unroll
            for (int r = 0; r < 16; ++r) acc[dt][r] = 0.f;
        float nsum = 0.f;
        const int troff = (4 * hi + ((lane & 15) >> 2)) * 64 + ((lane >> 4) & 1) * 32 + (lane & 3) * 8;
        __syncthreads();
#pragma unroll 1
        for (int j = 0; j < 4; ++j) {
#pragma unroll
            for (int i = 0; i < 2; ++i) { const int p = F.tid + 512 * i, s = p >> 4, cc = p & 15; const v4u kk = kreg[i]; const float w = wsv[j * 64 + s];
                v4u o; o.x = pk2(bflo(kk.x) * w, bfhi(kk.x) * w); o.y = pk2(bflo(kk.y) * w, bfhi(kk.y) * w); o.z = pk2(bflo(kk.z) * w, bfhi(kk.z) * w); o.w = pk2(bflo(kk.w) * w, bfhi(kk.w) * w);
                *(LAS v4u*)(Kl + (cc >> 2) * 4096 + s * 64 + (cc & 3) * 16) = o; }
#pragma unroll
            for (int i = 0; i < 4; ++i) { const int p = F.tid + 512 * i, s = p >> 5, cc = p & 31; *(LAS v4u*)(Vl + (cc >> 2) * 4096 + s * 64 + (cc & 3) * 16) = vreg[i]; }
            if (j < 3) ML_LOAD(j + 1);
            __syncthreads();
#pragma unroll
            for (int ks = 0; ks < 4; ++ks) {
                const LAS unsigned char* vp = Vl + F.wave * 4096 + ks * 16 * 64 + troff;
                const bf16x8 vf = cat8(tr16(vp), tr16(vp + 8 * 64));
#pragma unroll
                for (int dt = 0; dt < 4; ++dt) { const LAS unsigned char* kp = Kl + dt * 4096 + ks * 16 * 64 + troff;
                    const bf16x8 kf = cat8(tr16(kp), tr16(kp + 8 * 64)); acc[dt] = MFMA32(kf, vf, acc[dt]); }
            }
            if (F.tid >= 384) { const int d = F.tid - 384; const LAS unsigned short* kc = (const LAS unsigned short*)(Kl + (d >> 5) * 4096 + (d & 31) * 2);
#pragma unroll 16
                for (int s = 0; s < 64; ++s) nsum += bf2f(kc[s * 32]); }
            __syncthreads();
        }
#undef ML_LOAD
        bf16* st = STATE + ((size_t)(sc * 4 + h) * 256 + F.wave * 32 + r32) * 128 + 4 * hi;
#pragma unroll
        for (int dt = 0; dt < 4; ++dt)
#pragma unroll
            for (int gq = 0; gq < 4; ++gq) { u32x2 w; w.x = cvtpk(acc[dt][4 * gq], acc[dt][4 * gq + 1]); w.y = cvtpk(acc[dt][4 * gq + 2], acc[dt][4 * gq + 3]); *(u32x2*)(st + 32 * dt + 8 * gq) = w; }
        if (F.tid >= 384) NST[(size_t)(sc * 4 + h) * 128 + F.tid - 384] = nsum;
    }
}

__device__ __forceinline__ void ml_scan256(Frame& F, bf16* STATE, float* NST, const float* CH, float* MS, bf16* DST, float* NDST) {
    LAUNDER_TID(F);
    LAS float* f1 = (LAS float*)(F.lds + RING_OFF); LAS float* f2 = f1 + 64;
    const int h = F.vcu >> 6;
    if (F.tid < 64) {
        const int c = F.lane; const float bt = CH[(c * 4 + h) * 2], ml = CH[(c * 4 + h) * 2 + 1];
        float B = bt, Mx = ml;
#pragma unroll
        for (int o = 1; o < 64; o <<= 1) { const float Bp = __shfl_up(B, o), Mp = __shfl_up(Mx, o); if (F.lane >= o) { Mx = fmaxf(Mp + B, Mx); B = Bp + B; } }
        const float Bq = __shfl_up(B, 1), Mq = __shfl_up(Mx, 1);
        const float m = (F.lane == 0) ? 0.f : fmaxf(Bq, Mq);
        const float mn = fmaxf(bt + m, ml);
        f1[c] = expf(bt + m - mn); f2[c] = expf(ml - mn);
        if ((F.vcu & 63) == 0) MS[c * 4 + h] = m;
    }
    __syncthreads();
    if (F.tid < 256) {
        unsigned* base = (unsigned*)(STATE + (size_t)h * 32768) + ((F.vcu & 63) * 256 + F.tid);
        unsigned* dbase = (unsigned*)(DST + (size_t)h * 32768) + ((F.vcu & 63) * 256 + F.tid);
        float c0v = 0.f, c1v = 0.f;
#pragma unroll 1
        for (int cb = 0; cb < NSC; cb += 32) {
            unsigned u[32];
#pragma unroll
            for (int j = 0; j < 32; ++j) u[j] = base[(size_t)(cb + j) * 65536];
#pragma unroll
            for (int j = 0; j < 32; ++j) { const float a = f1[cb + j], b = f2[cb + j];
                dbase[(size_t)(cb + j) * 65536] = pg8::cvt_pk_bf16(c0v, c1v);
                c0v = a * c0v + b * bflo(u[j]); c1v = a * c1v + b * bfhi(u[j]); }
        }
    } else if ((F.vcu & 63) == 0 && F.tid < 384) {
        float* base = NST + h * 128 + (F.tid - 256); float* dbase = NDST + h * 128 + (F.tid - 256); float nv = 0.f;
#pragma unroll 1
        for (int cb = 0; cb < NSC; cb += 16) {
            float u[16];
#pragma unroll
            for (int j = 0; j < 16; ++j) u[j] = base[(size_t)(cb + j) * 512];
#pragma unroll
            for (int j = 0; j < 16; ++j) { dbase[(size_t)(cb + j) * 512] = nv; nv = f1[cb + j] * nv + f2[cb + j] * u[j]; }
        }
    }
    __syncthreads();
}

__device__ __forceinline__ float fexp(float x) { return __builtin_amdgcn_exp2f(x * LOG2E); }
__device__ __forceinline__ void ml_out256(Frame& F, const bf16* PROJ, const float* GATES, const bf16* STATE, const float* NST, const float* MS, const float* hnorm, bf16* HG) {
    LAUNDER_TID(F);
    LAS unsigned char* Vl = F.lds + RING_OFF;
    LAS float* bcum = (LAS float*)(F.lds + GA_OFF); LAS float* aval = bcum + 256; LAS float* amc = aval + 256; LAS float* nst = amc + 256;
    const int lane = F.lane, r32 = lane & 31, hi = lane >> 5, w = F.wave;
    for (int unit = F.vcu; unit < NSC * 4; unit += F.G) {
        const int sc = unit >> 2, h = unit & 3;
        const float mc = MS[sc * 4 + h];
        const bf16* qb = PROJ + (size_t)(sc * 256) * 3072 + h * 128;
        const bf16* kb = PROJ + (size_t)(sc * 256) * 3072 + 512 + h * 128;
        const bf16* vb = PROJ + (size_t)(sc * 256) * 3072 + 1024 + h * 256;
#pragma unroll
        for (int half = 0; half < 2; ++half) { v4u vr[8];
#pragma unroll
            for (int i = 0; i < 8; ++i) { const int p = F.tid + 512 * (half * 8 + i), s = p >> 5, cc = p & 31; vr[i] = *(const v4u*)(vb + (size_t)s * 3072 + cc * 8); }
#pragma unroll
            for (int i = 0; i < 8; ++i) { const int p = F.tid + 512 * (half * 8 + i), s = p >> 5, cc = p & 31; *(LAS v4u*)(Vl + (cc >> 2) * 16384 + s * 64 + (cc & 3) * 16) = vr[i]; } }
        asm volatile("" ::: "memory");
        if (F.tid < 64) { float btot, amax; sc_gates(GATES, sc, h, lane, bcum, aval, amc, btot, amax); }
        if (F.tid >= 64 && F.tid < 192) nst[F.tid - 64] = NST[(size_t)(sc * 4 + h) * 128 + F.tid - 64];
        asm volatile("" ::: "memory");
        const int t = w * 32 + r32;
        bf16x8 qf[8];
#pragma unroll
        for (int kk = 0; kk < 8; ++kk) qf[kk] = *(const bf16x8*)(qb + (size_t)t * 3072 + kk * 16 + hi * 8);
        __syncthreads();
        const float b_t = bcum[t], m_t = b_t + fmaxf(mc, amc[t]), e_t = fexp(b_t + mc - m_t);
        float nq = 0.f;
#pragma unroll
        for (int kk = 0; kk < 8; ++kk) { const v4u qw = __builtin_bit_cast(v4u, qf[kk]); const f32x4 n0 = *(const LAS f32x4*)(nst + kk * 16 + hi * 8), n1 = *(const LAS f32x4*)(nst + kk * 16 + hi * 8 + 4);
            nq += (bflo(qw.x) * n0.x + bfhi(qw.x) * n0.y) + (bflo(qw.y) * n0.z + bfhi(qw.y) * n0.w) + (bflo(qw.z) * n1.x + bfhi(qw.z) * n1.y) + (bflo(qw.w) * n1.z + bfhi(qw.w) * n1.w); }
        nq += __shfl_xor(nq, 32);
        const int troff = (4 * hi + ((lane & 15) >> 2)) * 64 + ((lane >> 4) & 1) * 32 + (lane & 3) * 8;
        const size_t row = (size_t)(sc * 256 + t);
        float ss = 0.f, dinv = 0.f;
#pragma unroll 1
        for (int vh = 0; vh < 2; ++vh) {
            f32x16 acc[4];
#pragma unroll
            for (int i = 0; i < 4; ++i) { f32x16 xa;
#pragma unroll
                for (int r = 0; r < 16; ++r) xa[r] = 0.f;
                const bf16* cb = STATE + ((size_t)(sc * 4 + h) * 256 + (vh * 4 + i) * 32 + r32) * 128 + hi * 8;
#pragma unroll
                for (int kk = 0; kk < 8; ++kk) { const bf16x8 cf = *(const bf16x8*)(cb + kk * 16); xa = MFMA32(cf, qf[kk], xa); }
#pragma unroll
                for (int r = 0; r < 16; ++r) acc[i][r] = e_t * xa[r];
                asm volatile("" ::: "memory"); }
            float dsum = 0.f;
#pragma unroll 1
            for (int sb = 0; sb <= w; ++sb) {
                f32x16 st;
#pragma unroll
                for (int r = 0; r < 16; ++r) st[r] = 0.f;
#pragma unroll
                for (int kk = 0; kk < 8; ++kk) { const bf16x8 kf = *(const bf16x8*)(kb + (size_t)(sb * 32 + r32) * 3072 + kk * 16 + hi * 8); st = MFMA32(kf, qf[kk], st); }
#pragma unroll
                for (int gq = 0; gq < 4; ++gq) { const f32x4 a4 = *(const LAS f32x4*)(aval + sb * 32 + 8 * gq + 4 * hi);
#pragma unroll
                    for (int i = 0; i < 4; ++i) { const int r = 4 * gq + i, cr = 8 * gq + 4 * hi + i; const bool valid = (sb < w) || (cr <= r32);
                        const float wg = valid ? st[r] * fexp(b_t + a4[i] - m_t) : 0.f; st[r] = wg; dsum += wg; } }
                const bf16x8 pf0 = pack8(st, 0), pf1 = pack8(st, 1);
#pragma unroll
                for (int i = 0; i < 4; ++i) { const LAS unsigned char* vp = Vl + (vh * 4 + i) * 16384 + (sb * 32) * 64 + troff;
                    const bf16x8 vf0 = cat8(tr16(vp), tr16(vp + 8 * 64)), vf1 = cat8(tr16(vp + 16 * 64), tr16(vp + 24 * 64));
                    acc[i] = MFMA32(vf0, pf0, acc[i]); acc[i] = MFMA32(vf1, pf1, acc[i]); }
            }
            if (vh == 0) { dsum += __shfl_xor(dsum, 32); dinv = 1.f / fmaxf(fabsf(dsum + e_t * nq), fexp(-m_t)); }
#pragma unroll
            for (int i = 0; i < 4; ++i)
#pragma unroll
                for (int gq = 0; gq < 4; ++gq) { const float h0 = acc[i][4 * gq] * dinv, h1 = acc[i][4 * gq + 1] * dinv, h2 = acc[i][4 * gq + 2] * dinv, h3 = acc[i][4 * gq + 3] * dinv;
                    ss += (h0 * h0 + h1 * h1) + (h2 * h2 + h3 * h3); u32x2 wv; wv.x = cvtpk(h0, h1); wv.y = cvtpk(h2, h3);
                    *(u32x2*)(HG + row * D + h * 256 + (vh * 4 + i) * 32 + 8 * gq + 4 * hi) = wv; }
        }
        ss += __shfl_xor(ss, 32);
        const float rn = rsqrtf(ss * (1.f / 256.f) + RMS_EPS);
#pragma unroll 1
        for (int vi = 0; vi < 8; ++vi)
#pragma unroll
                for (int gq = 0; gq < 4; ++gq) { const int v0 = h * 256 + vi * 32 + 8 * gq + 4 * hi;
                    const f32x4 gn = *(const f32x4*)(hnorm + v0); const u32x2 ow = *(const u32x2*)(PROJ + row * 3072 + 2048 + v0);
                    const u32x2 hp = *(const u32x2*)(HG + row * D + v0); const unsigned p0 = hp.x, p1 = hp.y;
                    const float y0 = bflo(p0) * rn * gn.x * __builtin_amdgcn_rcpf(1.f + fexp(-bflo(ow.x))), y1 = bfhi(p0) * rn * gn.y * __builtin_amdgcn_rcpf(1.f + fexp(-bfhi(ow.x)));
                    const float y2 = bflo(p1) * rn * gn.z * __builtin_amdgcn_rcpf(1.f + fexp(-bflo(ow.y))), y3 = bfhi(p1) * rn * gn.w * __builtin_amdgcn_rcpf(1.f + fexp(-bfhi(ow.y)));
                    u32x2 wv; wv.x = cvtpk(y0, y1); wv.y = cvtpk(y2, y3); *(u32x2*)(HG + row * D + v0) = wv;
                    if (gq == 3) asm volatile("" ::: "memory"); }
        __syncthreads();
    }
}

#ifndef ML256
#define ML256 1
#endif
#ifndef XP_PRO
#define XP_PRO 0
#endif
#ifndef XP_GEMM
#define XP_GEMM 0
#endif
#ifndef XP_ML
#define XP_ML 0
#endif
#ifndef XP_ATTN
#define XP_ATTN 0
#endif
#ifndef XP_GATES
#define XP_GATES 0
#endif
#ifndef XP_RES
#define XP_RES 0
#endif
#ifndef XP_SCAN
#define XP_SCAN 0
#endif
#ifndef XP_BAR
#define XP_BAR 0
#endif
#ifndef ATTN_MFMA
#define ATTN_MFMA 1
#endif
#ifndef MLL_MFMA
#define MLL_MFMA 1
#endif
#ifndef MLO_MFMA
#define MLO_MFMA 1
#endif
#ifndef PG8_SP2
#define PG8_SP2 true
#endif
#ifndef PG8_ALIGN
#define PG8_ALIGN true
#endif
typedef const char __attribute__((address_space(4)))* karg_ptr;
__device__ __forceinline__ karg_ptr kargs() { karg_ptr kp = (karg_ptr)__builtin_amdgcn_kernarg_segment_ptr(); asm volatile("" : "+s"(kp)); return kp; }
__device__ __forceinline__ const float* arg_in(int i) { return *(const float* const __attribute__((address_space(4)))*)(kargs() + 8 * i); }
__device__ __forceinline__ float* arg_out() { return *(float* const __attribute__((address_space(4)))*)(kargs() + 8 * 19); }
__device__ __forceinline__ unsigned char* arg_ws() { return *(unsigned char* const __attribute__((address_space(4)))*)(kargs() + 8 * 20); }
#define WSP(T, off) ((T*)(arg_ws() + (off)))

__global__ void __launch_bounds__(NWAVES * 64, 2) yoco_fwd(Args args) {
    extern __shared__ __attribute__((aligned(16))) unsigned char lds[];
    Frame F;
    F.lds = (LAS unsigned char*)lds;
    F.MISC = (volatile LAS unsigned*)(F.lds + MISC_OFF);
    F.tid = threadIdx.x; F.lane = F.tid & 63; F.wave = __builtin_amdgcn_readfirstlane(F.tid >> 6);
    F.G = gridDim.x; { const int bx = blockIdx.x; F.vcu = (F.G % 8 == 0) ? (bx % 8) * (F.G / 8) + bx / 8 : bx; }
    F.ctl = (gu32*)(args.ws + WS_CTL);
    for (int u = F.tid; u < (LDS_BYTES - LDSCTL_OFF) / 4; u += NWAVES * 64) ((LAS unsigned*)(F.lds + LDSCTL_OFF))[u] = 0u;
    __syncthreads();
    unsigned bar_x; { XcdBarrier bar = xcd_barrier_post((unsigned*)(F.ctl + CW_BAR), F.MISC + 8); bar_x = __builtin_amdgcn_readfirstlane(bar.x); }
#define GRID_BAR() do { XcdBarrier b_; b_.bar = (unsigned*)(arg_ws() + WS_CTL) + CW_BAR; b_.x = bar_x; b_.st = (volatile LAS unsigned*)(F.lds + MISC_OFF) + 8; asm volatile("" : "+s"(b_.x)); xcd_barrier(b_); } while (0)

    for (int rep = 0; rep <= XP_PRO; ++rep) p0_prologue(F, args);
    GRID_BAR();
    for (int rep = 0; rep < XP_BAR; ++rep) GRID_BAR();

#pragma unroll 1
    for (int l = 0; l < 4; ++l) {
        if (l < 2) {
            {
                pg8::Gemm g{WSP(const bf16, WS_XB), WSP(const bf16, WS_WIN) + (size_t)l * 3072 * D, M, 3072, D}; pg8::StaticOrder S; S.init(M, 3072, F.G, (int)blockIdx.x);
                EpiProj E{WSP(bf16, WS_PROJ), 3072, nullptr, 3072, 0, nullptr, WSP(const float, WS_SSP)};
                for (int rep = 0; rep <= XP_GEMM; ++rep) pg8::gemm_phase<EpiProj, pg8::StaticOrder, PG8_ALIGN, PG8_SP2>(F.lds + RING_OFF, g, S, E);
                for (int rep = 0; rep <= XP_GATES; ++rep) gates_phase(F, WSP(const bf16, WS_XB), WSP(const float, WS_SSP), WSP(const float, WS_WGT) + l * 8 * 1024, arg_in(3) + l * 8, WSP(float, WS_GATES));
            }
            GRID_BAR();
            for (int rep = 0; rep <= XP_ML; ++rep) ml_local256(F, WSP(const bf16, WS_PROJ), WSP(const float, WS_GATES), WSP(bf16, WS_STATE), WSP(float, WS_NST), WSP(float, WS_CH));
            GRID_BAR();
            for (int rep = 0; rep < XP_SCAN; ++rep) ml_scan256(F, WSP(bf16, WS_STATE), WSP(float, WS_NST), WSP(const float, WS_CH), WSP(float, WS_MS), WSP(bf16, WS_HG), (float*)(arg_ws() + WS_HG + 20 * MiB));
            ml_scan256(F, WSP(bf16, WS_STATE), WSP(float, WS_NST), WSP(const float, WS_CH), WSP(float, WS_MS), WSP(bf16, WS_STATE), WSP(float, WS_NST));
            GRID_BAR();
            for (int rep = 0; rep <= XP_ML; ++rep) ml_out256(F, WSP(const bf16, WS_PROJ), WSP(const float, WS_GATES), WSP(const bf16, WS_STATE), WSP(const float, WS_NST), WSP(const float, WS_MS), arg_in(4) + l * D, WSP(bf16, WS_HG));
            GRID_BAR();
            {
                pg8::Gemm g{WSP(const bf16, WS_HG), WSP(const bf16, WS_WOUT) + (size_t)l * D * D, M, D, D}; pg8::StaticOrder S; S.init(M, D, F.G, (int)blockIdx.x);
                for (int rep = 0; rep < XP_RES; ++rep) { EpiResid E0{(l == 0) ? arg_in(0) : nullptr, WSP(const bf16, WS_XB), WSP(bf16, WS_PROJ), nullptr, WSP(float, WS_GATES)}; pg8::gemm_phase<EpiResid, pg8::StaticOrder, false, PG8_SP2>(F.lds + RING_OFF, g, S, E0); }
                EpiResid E{(l == 0) ? arg_in(0) : nullptr, WSP(const bf16, WS_XB), WSP(bf16, WS_XB), nullptr, WSP(float, WS_SSP)};
                pg8::gemm_phase<EpiResid, pg8::StaticOrder, false, PG8_SP2>(F.lds + RING_OFF, g, S, E);
            }
            GRID_BAR();
        } else {
            const int j = l - 2;
            {
                const int N = (j == 0) ? 1280 : 1024;
                pg8::Gemm g{WSP(const bf16, WS_XB), (const bf16*)(arg_ws() + (j == 0 ? WS_WQ2 : WS_WQ3)), M, N, D}; pg8::StaticOrder S; S.init(M, N, F.G, (int)blockIdx.x);
                EpiProj E{WSP(bf16, WS_PROJ), D, WSP(bf16, WS_KV), 256, 1024, WSP(const float, WS_BQ) + j * 1280, WSP(const float, WS_SSP)};
                for (int rep = 0; rep <= XP_GEMM; ++rep) pg8::gemm_phase<EpiProj, pg8::StaticOrder, PG8_ALIGN, PG8_SP2>(F.lds + RING_OFF, g, S, E);
            }
            GRID_BAR();
            for (int rep = 0; rep <= XP_ATTN; ++rep) attn_phase_mfma(F, WSP(const bf16, WS_PROJ), WSP(const bf16, WS_KV), arg_in(12) + j * 16, WSP(bf16, WS_HG));
            GRID_BAR();
            {
                pg8::Gemm g{WSP(const bf16, WS_HG), WSP(const bf16, WS_WBO) + (size_t)j * D * D, M, D, D}; pg8::StaticOrder S; S.init(M, D, F.G, (int)blockIdx.x);
                for (int rep = 0; rep < XP_RES; ++rep) { EpiResid E0{nullptr, WSP(const bf16, WS_XB), WSP(bf16, WS_PROJ), arg_in(14) + j * D, WSP(float, WS_GATES)}; pg8::gemm_phase<EpiResid, pg8::StaticOrder, false, PG8_SP2>(F.lds + RING_OFF, g, S, E0); }
                EpiResid E{nullptr, WSP(const bf16, WS_XB), WSP(bf16, WS_XB), arg_in(14) + j * D, WSP(float, WS_SSP)};
                pg8::gemm_phase<EpiResid, pg8::StaticOrder, false, PG8_SP2>(F.lds + RING_OFF, g, S, E);
            }
            GRID_BAR();
        }
        {
            pg8::Gemm g{WSP(const bf16, WS_XB), WSP(const bf16, WS_WGU) + (size_t)l * 2 * DFF * D, M, 2 * DFF, D}; pg8::StaticOrder S; S.init(M, 2 * DFF, F.G, (int)blockIdx.x);
            EpiSwiglu E{WSP(bf16, WS_PROJ), WSP(const float, WS_SSP)};
            for (int rep = 0; rep <= XP_GEMM; ++rep) pg8::gemm_phase<EpiSwiglu, pg8::StaticOrder, PG8_ALIGN, PG8_SP2>(F.lds + RING_OFF, g, S, E);
        }
        GRID_BAR();
        {
            pg8::Gemm g{WSP(const bf16, WS_PROJ), WSP(const bf16, WS_WD) + (size_t)l * D * DFF, M, D, DFF}; pg8::StaticOrder S; S.init(M, D, F.G, (int)blockIdx.x);
            for (int rep = 0; rep < XP_RES; ++rep) { EpiResid E0{nullptr, WSP(const bf16, WS_XB), WSP(bf16, WS_HG), nullptr, WSP(float, WS_GATES)}; pg8::gemm_phase<EpiResid, pg8::StaticOrder, false, PG8_SP2>(F.lds + RING_OFF, g, S, E0); }
            EpiResid E{nullptr, WSP(const bf16, WS_XB), WSP(bf16, WS_XB), nullptr, WSP(float, WS_SSP)};
            pg8::gemm_phase<EpiResid, pg8::StaticOrder, false, PG8_SP2>(F.lds + RING_OFF, g, S, E);
        }
        GRID_BAR();
    }
    final_norm_phase(F, arg_out(), WSP(const bf16, WS_XB), WSP(const float, WS_SSP), arg_in(18));
}

extern "C" void kernel_launch(void* const* d_in, const int* in_sizes, int n_in, void* d_out, int out_size, void* d_ws, size_t ws_size, hipStream_t stream) {
    static int grid = 0;
    if (grid == 0) {
        if (n_in != 19 || in_sizes[0] != M * D || out_size != M * D || ws_size < WS_END) { fprintf(stderr, "kernel_launch: unexpected shapes / workspace (n_in %d, ws %zu < %zu)\n", n_in, ws_size, (size_t)WS_END); grid = -1; return; }
        int dev = 0, cus = 0, per_cu = 0;
        if (hipGetDevice(&dev) != hipSuccess || hipDeviceGetAttribute(&cus, hipDeviceAttributeMultiprocessorCount, dev) != hipSuccess) { grid = -1; return; }
        if (hipFuncSetAttribute((const void*)yoco_fwd, hipFuncAttributeMaxDynamicSharedMemorySize, LDS_BYTES) != hipSuccess) { fprintf(stderr, "kernel_launch: hipFuncSetAttribute failed\n"); grid = -1; return; }
        if (hipOccupancyMaxActiveBlocksPerMultiprocessor(&per_cu, (const void*)yoco_fwd, NWAVES * 64, LDS_BYTES) != hipSuccess || per_cu < 1) { fprintf(stderr, "kernel_launch: occupancy query says %d blocks per CU\n", per_cu); (void)hipGetLastError(); grid = -1; return; }
        grid = cus;
        if (grid != 256) fprintf(stderr, "kernel_launch: %d CUs; this kernel is laid out for 256\n", grid);
    }
    if (grid < 0) return;
    if (hipMemsetAsync((char*)d_ws + WS_CTL, 0, CTL_ZERO_BYTES, stream) != hipSuccess) return;
    Args a{};
    for (int i = 0; i < 19; ++i) a.in[i] = (const float*)d_in[i];
    a.out = (float*)d_out; a.ws = (unsigned char*)d_ws;
    hipLaunchKernelGGL(yoco_fwd, dim3(grid), dim3(NWAVES * 64), LDS_BYTES, stream, a);
}
```

```cpp
#include <hip/hip_runtime.h>
#include <cstdio>
#include <cstdint>
#include <cmath>
namespace pg8 {
#define PG8_LAS __attribute__((address_space(3)))
typedef unsigned short bf16_t;
typedef short bf16x8 __attribute__((ext_vector_type(8)));
typedef float f32x4 __attribute__((ext_vector_type(4)));
typedef unsigned u32x4 __attribute__((ext_vector_type(4)));
constexpr int BM = 256, BK = 64, HALF = 128, HTB = HALF * BK * 2  , STAGE_BYTES = 8 * HTB, NXCD = 8, WGM = 8;

__host__ __device__ __forceinline__ int lds_byte(int r, int c) { const int st = (r >> 4) * 2 + (c >> 5), rr = r & 15, cc = c & 31, ob = rr * 64 + cc * 2; return st * 1024 + (ob ^ (((ob >> 9) & 1) << 5)); }
__host__ __device__ __forceinline__ void stage_rc(int b, int& R, int& C) { const int st = b / 1024, sb = b % 1024, swz = sb ^ (((sb >> 9) & 1) << 5); R = (st >> 1) * 16 + swz / 64; C = (st & 1) * 32 + (swz % 64) / 2; }
__host__ __device__ __forceinline__ int perm32(int rho) { const int n = rho >> 4, i = rho & 15; return 8 * (i >> 2) + 4 * n + (i & 3); }

struct Unit { int pm, pn; };
struct Gemm { const bf16_t* A; const bf16_t* Bt; int M, N, K; };

struct StaticOrder {
    int nM, nN, nwg, G, c;
    __host__ __device__ void init(int M, int N, int G_, int c_) { nM = M / BM; nN = N / BM; nwg = nM * nN; G = G_; c = c_; }
    __host__ __device__ bool next(int i, Unit& u) const {
        const long L = (long)i * G + c; if (L >= nwg) return false;
        int wgid = (int)L; { const int q = nwg / NXCD, r = nwg % NXCD, xcd = wgid % NXCD, off = wgid / NXCD; wgid = (xcd < r ? xcd * (q + 1) : r * (q + 1) + (xcd - r) * q) + off; }
        const int nig = WGM * nN, gid = wgid / nig, fm = gid * WGM, gsz = (nM - fm) < WGM ? (nM - fm) : WGM;
        u.pm = fm + ((wgid % nig) % gsz); u.pn = (wgid % nig) / gsz; return true;
    }
    __device__ __forceinline__ void a_ready(const Unit&) const {}
    __device__ __forceinline__ void done(const Unit&) const {}
};

__device__ __forceinline__ unsigned cvt_pk_bf16(float lo, float hi) { unsigned r; asm volatile("v_cvt_pk_bf16_f32 %0, %1, %2" : "=v"(r) : "v"(lo), "v"(hi)); return r; }
typedef float f32x2 __attribute__((ext_vector_type(2)));
template <class Epi, class Sched, bool ALIGN_EPI = false, bool SP2 = false>
__device__ __forceinline__ void gemm_phase(PG8_LAS unsigned char* lds, const Gemm g, const Sched& S, const Epi& E) {
    int tid_ = (int)__builtin_amdgcn_mbcnt_hi(~0u, __builtin_amdgcn_mbcnt_lo(~0u, 0u)); asm volatile("" : "+v"(tid_)); tid_ += 64 * __builtin_amdgcn_readfirstlane((int)threadIdx.x >> 6);
    const int tid = tid_, wid = __builtin_amdgcn_readfirstlane(tid >> 6), lane = tid & 63, wr = wid >> 2, wc = wid & 3, fr = lane & 15, fq = lane >> 4;
    const int K = g.K, nt = K / BK;
    unsigned voffA[2], voffB[2];
#pragma unroll
    for (int i = 0; i < 2; ++i) { int R, C; stage_rc(tid * 16 + i * 8192, R, C); const int Rb = Epi::PERM ? ((R & ~31) + perm32(R & 31)) : R;
        voffA[i] = (unsigned)(R * K + C) * 2u; voffB[i] = (unsigned)(Rb * K + C) * 2u; }
    const size_t kstep = (size_t)(BK * 2);
    const size_t hstep = (size_t)HALF * K * 2;
    const size_t tstep = 2 * hstep;
    const unsigned ldsw = (unsigned)wid * 1024u;
    const int aoff = lds_byte(wr * 64 + fr, fq * 8), boff = lds_byte(wc * 32 + fr, fq * 8);
#define PG8_SA(b, h) (((b) * 2 + (h)) * HTB)
#define PG8_SB(b, h) ((4 + (b) * 2 + (h)) * HTB)
#define PG8_STAGE(bufoff, gbase, voff) do { _Pragma("unroll") for (int _i = 0; _i < 2; ++_i) \
        __builtin_amdgcn_global_load_lds((const unsigned*)((const char*)(gbase) + (voff)[_i]), (PG8_LAS unsigned*)(lds + (bufoff) + ldsw + _i * 8192), 16, 0, 0); } while (0)
#define PG8_LDA(dst, b, h) do { _Pragma("unroll") for (int m = 0; m < 4; ++m) _Pragma("unroll") for (int k = 0; k < 2; ++k) dst[m][k] = *(const PG8_LAS bf16x8*)(lds + PG8_SA(b, h) + aoff + m * 2048 + k * 1024); } while (0)
#define PG8_LDB(dst, b, h) do { _Pragma("unroll") for (int n = 0; n < 2; ++n) _Pragma("unroll") for (int k = 0; k < 2; ++k) dst[n][k] = *(const PG8_LAS bf16x8*)(lds + PG8_SB(b, h) + boff + n * 2048 + k * 1024); } while (0)
#define PG8_MMA(ai, bj, At, Bt) do { __builtin_amdgcn_s_setprio(1); _Pragma("unroll") for (int m = 0; m < 4; ++m) _Pragma("unroll") for (int n = 0; n < 2; ++n) _Pragma("unroll") for (int k = 0; k < 2; ++k) \
        acc[ai][bj][m][n] = __builtin_amdgcn_mfma_f32_16x16x32_bf16(Bt[n][k], At[m][k], acc[ai][bj][m][n], 0, 0, 0); __builtin_amdgcn_s_setprio(0); } while (0)
#define PG8_WAIT_V(n) asm volatile("s_waitcnt vmcnt(" #n ")" ::: "memory")
#define PG8_WAIT_L(n) asm volatile("s_waitcnt lgkmcnt(" #n ")" ::: "memory")
#define PG8_BAR __builtin_amdgcn_s_barrier()
#define PG8_SCHED __builtin_amdgcn_sched_barrier(0)
    Unit cur, nxt; int ui = 0;
    if (!S.next(0, cur)) return;
    f32x4 acc[2][2][4][2];
#pragma unroll
    for (int a = 0; a < 2; ++a)
#pragma unroll
        for (int b = 0; b < 2; ++b)
#pragma unroll
            for (int m = 0; m < 4; ++m)
#pragma unroll
                for (int n = 0; n < 2; ++n) acc[a][b][m][n] = (f32x4){0.f, 0.f, 0.f, 0.f};
    bf16x8 At[4][2], B0[2][2], B1[2][2];
    const char* cA = (const char*)g.A + (size_t)cur.pm * tstep; const char* cB = (const char*)g.Bt + (size_t)cur.pn * tstep;
    S.a_ready(cur);
    if constexpr (SP2) {
        PG8_STAGE(PG8_SB(0, 0), cB, voffB); PG8_STAGE(PG8_SB(0, 1), cB + hstep, voffB); PG8_STAGE(PG8_SA(0, 0), cA, voffA); PG8_STAGE(PG8_SA(0, 1), cA + hstep, voffA);
        if (wr == 1) PG8_BAR;
        PG8_WAIT_V(2); PG8_BAR;
        PG8_STAGE(PG8_SB(1, 0), cB + kstep, voffB); PG8_STAGE(PG8_SA(1, 0), cA + kstep, voffA); PG8_STAGE(PG8_SB(1, 1), cB + hstep + kstep, voffB);
        PG8_WAIT_V(6); PG8_BAR;
    } else {
        PG8_STAGE(PG8_SB(0, 0), cB, voffB); PG8_STAGE(PG8_SA(0, 0), cA, voffA); PG8_STAGE(PG8_SB(0, 1), cB + hstep, voffB); PG8_STAGE(PG8_SA(0, 1), cA + hstep, voffA);
        if (wr == 1) PG8_BAR;
        PG8_WAIT_V(4); PG8_BAR;
        PG8_STAGE(PG8_SB(1, 0), cB + kstep, voffB); PG8_STAGE(PG8_SA(1, 0), cA + kstep, voffA); PG8_STAGE(PG8_SB(1, 1), cB + hstep + kstep, voffB);
        PG8_WAIT_V(6); PG8_BAR;
    }
    for (;;) {
        const bool has_next = S.next(ui + 1, nxt);
        const char* nA = has_next ? (const char*)g.A + (size_t)nxt.pm * tstep : cA; const char* nB = has_next ? (const char*)g.Bt + (size_t)nxt.pn * tstep : cB;
        for (int t = 0; t < nt; t += 2) {
            const bool last = (t == nt - 2);
            const char* a1 = cA + (size_t)(t + 1) * kstep;
            const char* a2 = last ? nA : cA + (size_t)(t + 2) * kstep; const char* b2 = last ? nB : cB + (size_t)(t + 2) * kstep;
            const char* a3 = a2 + kstep; const char* b3 = b2 + kstep;
            if (last && has_next) S.a_ready(nxt);
            if constexpr (SP2) {
            PG8_LDB(B0, 0, 0); PG8_LDB(B1, 0, 1); PG8_SCHED; PG8_LDA(At, 0, 0); PG8_STAGE(PG8_SA(1, 1), a1 + hstep, voffA);
            PG8_WAIT_V(8); PG8_WAIT_L(0); PG8_BAR; PG8_MMA(0, 0, At, B0); PG8_MMA(0, 1, At, B1); PG8_BAR; PG8_SCHED;
            PG8_LDA(At, 0, 1); PG8_STAGE(PG8_SB(0, 0), b2, voffB); PG8_STAGE(PG8_SB(0, 1), b2 + hstep, voffB); PG8_STAGE(PG8_SA(0, 0), a2, voffA);
            PG8_WAIT_V(8); PG8_WAIT_L(0); PG8_BAR; PG8_MMA(1, 0, At, B0); PG8_MMA(1, 1, At, B1); PG8_BAR; PG8_SCHED;
            PG8_LDB(B0, 1, 0); PG8_LDB(B1, 1, 1); PG8_SCHED; PG8_LDA(At, 1, 0); PG8_STAGE(PG8_SA(0, 1), a2 + hstep, voffA);
            PG8_WAIT_V(8); PG8_WAIT_L(0); PG8_BAR; PG8_MMA(0, 0, At, B0); PG8_MMA(0, 1, At, B1); PG8_BAR; PG8_SCHED;
            PG8_LDA(At, 1, 1); PG8_STAGE(PG8_SB(1, 0), b3, voffB); PG8_STAGE(PG8_SB(1, 1), b3 + hstep, voffB); PG8_STAGE(PG8_SA(1, 0), a3, voffA);
            PG8_WAIT_V(8); PG8_WAIT_L(0); PG8_BAR; PG8_MMA(1, 0, At, B0); PG8_MMA(1, 1, At, B1); PG8_BAR; PG8_SCHED;
            } else {
            PG8_LDB(B0, 0, 0); PG8_SCHED; PG8_LDA(At, 0, 0); PG8_STAGE(PG8_SA(1, 1), a1 + hstep, voffA);
            PG8_WAIT_L(8); PG8_BAR; PG8_WAIT_L(0); PG8_MMA(0, 0, At, B0); PG8_BAR; PG8_SCHED;
            PG8_LDB(B1, 0, 1); PG8_STAGE(PG8_SB(0, 0), b2, voffB);
            PG8_BAR; PG8_WAIT_L(0); PG8_MMA(0, 1, At, B1); PG8_BAR;
            PG8_LDA(At, 0, 1); PG8_STAGE(PG8_SA(0, 0), a2, voffA);
            PG8_BAR; PG8_WAIT_L(0); PG8_MMA(1, 0, At, B0); PG8_BAR; PG8_SCHED;
            PG8_STAGE(PG8_SB(0, 1), b2 + hstep, voffB);
            PG8_WAIT_V(6); PG8_BAR; PG8_MMA(1, 1, At, B1); PG8_BAR;
            PG8_LDB(B0, 1, 0); PG8_SCHED; PG8_LDA(At, 1, 0); PG8_STAGE(PG8_SA(0, 1), a2 + hstep, voffA);
            PG8_WAIT_L(8); PG8_BAR; PG8_WAIT_L(0); PG8_MMA(0, 0, At, B0); PG8_BAR; PG8_SCHED;
            PG8_LDB(B1, 1, 1); PG8_STAGE(PG8_SB(1, 0), b3, voffB);
            PG8_BAR; PG8_WAIT_L(0); PG8_MMA(0, 1, At, B1); PG8_BAR;
            PG8_LDA(At, 1, 1); PG8_STAGE(PG8_SA(1, 0), a3, voffA);
            PG8_BAR; PG8_WAIT_L(0); PG8_MMA(1, 0, At, B0); PG8_BAR; PG8_SCHED;
            PG8_STAGE(PG8_SB(1, 1), b3 + hstep, voffB);
            PG8_WAIT_V(6); PG8_BAR; PG8_MMA(1, 1, At, B1); PG8_BAR;
            }
        }
        if constexpr (ALIGN_EPI) { if (wr == 0) PG8_BAR; }
        if constexpr (!Epi::AFTER_DRAIN) { E(acc, cur, wr, wc, fr, fq);
#if defined(XP_EPI) && XP_EPI
            asm volatile("" ::: "memory"); E(acc, cur, wr, wc, fr, fq);
#endif
            S.done(cur); }
        if (!has_next) break;
#pragma unroll
        for (int a = 0; a < 2; ++a)
#pragma unroll
            for (int b = 0; b < 2; ++b)
#pragma unroll
                for (int m = 0; m < 4; ++m)
#pragma unroll
                    for (int n = 0; n < 2; ++n) acc[a][b][m][n] = (f32x4){0.f, 0.f, 0.f, 0.f};
        cur = nxt; cA = nA; cB = nB; ++ui;
        if constexpr (ALIGN_EPI) { if (wr == 1) PG8_BAR; }
    }
    PG8_WAIT_V(0);
    if constexpr (!ALIGN_EPI) { if (wr == 0) PG8_BAR; }
    PG8_BAR;
    if constexpr (Epi::AFTER_DRAIN) { E.fused(acc, cur, wr, wc, fr, fq, lds, wid, lane); S.done(cur); }
#undef PG8_SA
#undef PG8_SB
#undef PG8_STAGE
#undef PG8_LDA
#undef PG8_LDB
#undef PG8_MMA
#undef PG8_WAIT_V
#undef PG8_WAIT_L
#undef PG8_BAR
#undef PG8_SCHED
}
}
#define GAS __attribute__((address_space(1)))
#define LAS __attribute__((address_space(3)))
typedef unsigned short bf16;
typedef unsigned v4u __attribute__((ext_vector_type(4)));
typedef float f32x4 __attribute__((ext_vector_type(4)));
typedef short bf16x8 __attribute__((ext_vector_type(8)));
typedef GAS unsigned gu32;
typedef GAS unsigned long long gu64;
#define RLX_AGENT __ATOMIC_RELAXED, __HIP_MEMORY_SCOPE_AGENT
#define LDS_WAIT() asm volatile("s_waitcnt lgkmcnt(0)" ::: "memory")
#define VM_WAIT() asm volatile("s_waitcnt vmcnt(0)" ::: "memory")
__device__ __forceinline__ unsigned long long rt() { return __builtin_amdgcn_s_memrealtime(); }
__device__ __forceinline__ unsigned f2bf(float f) { unsigned u = __builtin_bit_cast(unsigned, f); return (u + 0x7fffu + ((u >> 16) & 1u)) >> 16; }
__device__ __forceinline__ unsigned pk2(float lo, float hi) { return f2bf(lo) | (f2bf(hi) << 16); }

#define XB_TMO      128
#define XB_XCNT(j)  (256  + 64 * (j))
#define XB_XSUB(j)  (1280 + 64 * (j))
#define XB_XGEN(j)  (2304 + 64 * (j))
#define XB_TOP      3328
#define XB_TOPGEN   3392
#define XCD_BAR_WORDS 3456
#define XB_SPIN_CAP (1u << 18)

__device__ __forceinline__ unsigned xb_ld(unsigned* p)              { return __hip_atomic_load(p, __ATOMIC_RELAXED, __HIP_MEMORY_SCOPE_AGENT); }
__device__ __forceinline__ unsigned xb_add(unsigned* p, unsigned v) { return __hip_atomic_fetch_add(p, v, __ATOMIC_RELAXED, __HIP_MEMORY_SCOPE_AGENT); }
__device__ __forceinline__ unsigned xb_xcc_id() { return (unsigned)__builtin_amdgcn_s_getreg((3 << 11) | 20) & 0xFu; }
#define XB_SPIN(cond, bar) do { unsigned _sp = 0; while (cond) { __builtin_amdgcn_s_sleep(1); \
    if ((++_sp & 255u) == 0u) { if (xb_ld(&(bar)[XB_TMO])) break; if (_sp > XB_SPIN_CAP) { atomicAdd(&(bar)[XB_TMO], 1u); break; } } } } while (0)

struct XcdBarrier {
    unsigned* bar; unsigned x;
    volatile LAS unsigned* st;
};

__device__ __forceinline__ XcdBarrier xcd_barrier_post(unsigned* bar, volatile LAS unsigned* st) {
    XcdBarrier b; b.bar = bar; b.x = xb_xcc_id(); b.st = st;
    if (threadIdx.x == 0) (void)xb_add(&bar[XB_XCNT(b.x)], 1u);
    return b;
}
__device__ __forceinline__ void xcd_barrier_complete(unsigned* bar, unsigned x, unsigned& nloc, unsigned& nx) {
    const unsigned G = gridDim.x * gridDim.y * gridDim.z;
    unsigned sum, cnt, mine, sp = 0u;
    for (;;) {
        sum = 0u; cnt = 0u; mine = 0u;
#pragma unroll
        for (unsigned j = 0; j < 16; ++j) { const unsigned c = xb_ld(&bar[XB_XCNT(j)]); sum += c; cnt += (c > 0u) ? 1u : 0u; mine = (j == x) ? c : mine; }
        if (sum == G) break;
        __builtin_amdgcn_s_sleep(1);
        if ((++sp & 255u) == 0u) { if (xb_ld(&bar[XB_TMO])) break; if (sp > XB_SPIN_CAP) { atomicAdd(&bar[XB_TMO], 1u); break; } }
    }
    nloc = mine > 0u ? mine : 1u; nx = cnt > 0u ? cnt : 1u;
}

__device__ __forceinline__ void xcd_barrier(const XcdBarrier& b) {
    asm volatile("s_waitcnt vmcnt(0)" ::: "memory");
    __syncthreads();
    if (threadIdx.x == 0) {
        unsigned* bar = b.bar;
        __builtin_amdgcn_s_waitcnt(0);
        unsigned nloc = b.st[0], nx = b.st[1];
        if (nloc == 0u) { xcd_barrier_complete(bar, b.x, nloc, nx); b.st[0] = nloc; b.st[1] = nx; }
        const unsigned old = xb_add(&bar[XB_XSUB(b.x)], 1u);
        const unsigned gen = old / nloc;
        if (old + 1u == (gen + 1u) * nloc) {
            __builtin_amdgcn_fence(__ATOMIC_RELEASE, "agent");
            asm volatile("s_waitcnt vmcnt(0)" ::: "memory");
            const unsigned og = xb_add(&bar[XB_TOP], 1u);
            const unsigned tg = og / nx;
            if (og + 1u == (tg + 1u) * nx) xb_add(&bar[XB_TOPGEN], 1u);
            else XB_SPIN(xb_ld(&bar[XB_TOPGEN]) == tg, bar);
            __builtin_amdgcn_fence(__ATOMIC_ACQUIRE, "agent");
            xb_add(&bar[XB_XGEN(b.x)], 1u);
            asm volatile("s_waitcnt vmcnt(0)" ::: "memory");
        } else {
            XB_SPIN(xb_ld(&bar[XB_XGEN(b.x)]) == gen, bar);
            __builtin_amdgcn_fence(__ATOMIC_ACQUIRE, "agent");
            asm volatile("s_waitcnt vmcnt(0)" ::: "memory");
        }
    }
    __syncthreads();
}

constexpr int NWAVES = 8;
constexpr int M = 16384, D = 1024, DFF = 2816, INA = 3080, NC = 256;
constexpr float RMS_EPS = 1e-6f;
constexpr float LOG2E = 1.4426950408889634f;
constexpr float QSCALE_A = 0.08838834764831845f;
constexpr float C2 = 0.125f * LOG2E;

constexpr size_t MiB = 1u << 20;
constexpr size_t WS_CTL = 0, CTL_ZERO_BYTES = 1 * MiB;
constexpr size_t WS_SSP = 1 * MiB;
constexpr size_t WS_GATES = WS_SSP + 256 * 1024;
constexpr size_t WS_NST = 2 * MiB;
constexpr size_t WS_CH = WS_NST + 512 * 1024;
constexpr size_t WS_MS = WS_CH + 16 * 1024;
constexpr size_t WS_WGT = WS_MS + 16 * 1024;
constexpr size_t WS_BQ = WS_WGT + 64 * 1024;
constexpr size_t WS_WIN = 3 * MiB;
constexpr size_t WS_WOUT = 15 * MiB;
constexpr size_t WS_WQ2 = 19 * MiB;
constexpr size_t WS_WQ3 = WS_WQ2 + 1280 * 1024 * 2;
constexpr size_t WS_WBO = 24 * MiB;
constexpr size_t WS_WGU = 28 * MiB;
constexpr size_t WS_WD = 72 * MiB;
constexpr size_t WS_XB = 94 * MiB;
constexpr size_t WS_PROJ = 126 * MiB;
constexpr size_t WS_KV = 222 * MiB;
constexpr size_t WS_HG = 230 * MiB;
constexpr size_t WS_STATE = 262 * MiB;
constexpr size_t WS_END = 326 * MiB;
constexpr int CW_BAR = 4096;

constexpr int RING_OFF = 0, RING_BYTES = 131072;
constexpr int LDSCTL_OFF = RING_BYTES, MISC_OFF = LDSCTL_OFF + 320;
constexpr int LDS_BYTES = 147456;

typedef float f32x2 __attribute__((ext_vector_type(2)));
typedef unsigned u32x2 __attribute__((ext_vector_type(2)));
__device__ __forceinline__ float bf2f(unsigned short b) { return __builtin_bit_cast(float, (unsigned)b << 16); }
__device__ __forceinline__ float bflo(unsigned w) { return __builtin_bit_cast(float, w << 16); }
__device__ __forceinline__ float bfhi(unsigned w) { return __builtin_bit_cast(float, w & 0xffff0000u); }
__device__ __forceinline__ float wave_sum(float v) {
#pragma unroll
    for (int o = 1; o < 64; o <<= 1) v += __shfl_xor(v, o);
    return v;
}
__device__ __forceinline__ float rstd_of(const float* ssp, int row) { const f32x4 p = *(const f32x4*)(ssp + (size_t)row * 4); return rsqrtf(((p.x + p.y) + (p.z + p.w)) * (1.f / D) + RMS_EPS); }

struct EpiProj {
    static constexpr bool PERM = true, AFTER_DRAIN = false;
    bf16* O0; int ld0; bf16* O1; int ld1; int split; const float* bias; const float* ssp;
    __device__ __forceinline__ void operator()(const pg8::f32x4 (&acc)[2][2][4][2], const pg8::Unit& u, int wr, int wc, int fr, int fq) const {
        const int row0 = u.pm * 256 + wr * 64 + fr; int colt = u.pn * 256; bf16* base = O0; int ld = ld0;
        if (split && colt >= split) { base = O1; ld = ld1; colt -= split; }
        const int col0 = colt + wc * 32 + 8 * fq, bcol0 = u.pn * 256 + wc * 32 + 8 * fq;
        f32x4 bv[2][2];
#pragma unroll
        for (int bj = 0; bj < 2; ++bj)
#pragma unroll
            for (int n = 0; n < 2; ++n) bv[bj][n] = bias ? *(const f32x4*)(bias + bcol0 + bj * 128 + 4 * n) : (f32x4){0.f, 0.f, 0.f, 0.f};
#pragma unroll
        for (int ai = 0; ai < 2; ++ai)
#pragma unroll
            for (int m = 0; m < 4; ++m) { const int r = row0 + ai * 128 + m * 16; const float rs = rstd_of(ssp, r); bf16* rowp = base + (size_t)r * ld + col0;
#pragma unroll
                for (int bj = 0; bj < 2; ++bj) { const f32x4 v0 = acc[ai][bj][m][0] * rs + bv[bj][0], v1 = acc[ai][bj][m][1] * rs + bv[bj][1];
                    v4u w; w.x = pg8::cvt_pk_bf16(v0[0], v0[1]); w.y = pg8::cvt_pk_bf16(v0[2], v0[3]); w.z = pg8::cvt_pk_bf16(v1[0], v1[1]); w.w = pg8::cvt_pk_bf16(v1[2], v1[3]);
                    *(v4u*)(rowp + bj * 128) = w; } }
    }
};
__device__ __forceinline__ float silu_mul(float g, float u) { return g * __builtin_amdgcn_rcpf(1.f + __builtin_amdgcn_exp2f(-g * LOG2E)) * u; }
struct EpiSwiglu {
    static constexpr bool PERM = true, AFTER_DRAIN = false;
    bf16* H; const float* ssp;
    __device__ __forceinline__ void operator()(const pg8::f32x4 (&acc)[2][2][4][2], const pg8::Unit& u, int wr, int wc, int fr, int fq) const {
        const int row0 = u.pm * 256 + wr * 64 + fr, col0 = u.pn * 128 + wc * 32 + 8 * fq;
#pragma unroll
        for (int ai = 0; ai < 2; ++ai)
#pragma unroll
            for (int m = 0; m < 4; ++m) { const int r = row0 + ai * 128 + m * 16; const float rs = rstd_of(ssp, r);
                const f32x4 g0 = acc[ai][0][m][0] * rs, g1 = acc[ai][0][m][1] * rs, u0 = acc[ai][1][m][0] * rs, u1 = acc[ai][1][m][1] * rs;
                v4u w; w.x = pg8::cvt_pk_bf16(silu_mul(g0[0], u0[0]), silu_mul(g0[1], u0[1])); w.y = pg8::cvt_pk_bf16(silu_mul(g0[2], u0[2]), silu_mul(g0[3], u0[3]));
                w.z = pg8::cvt_pk_bf16(silu_mul(g1[0], u1[0]), silu_mul(g1[1], u1[1])); w.w = pg8::cvt_pk_bf16(silu_mul(g1[2], u1[2]), silu_mul(g1[3], u1[3]));
                *(v4u*)(H + (size_t)r * DFF + col0) = w; }
    }
};
struct EpiResid {
    static constexpr bool PERM = true, AFTER_DRAIN = true;
    const float* basef; const bf16* baseb; bf16* xb; const float* bias; float* ssp;
    __device__ __forceinline__ void fused(pg8::f32x4 (&acc)[2][2][4][2], const pg8::Unit& u, int wr, int wc, int fr, int fq, PG8_LAS unsigned char* lds, int wid, int lane) const {
        PG8_LAS float* P = (PG8_LAS float*)lds;
        const int col0 = u.pn * 256 + wc * 32 + 8 * fq;
        f32x4 bv[2][2];
#pragma unroll
        for (int bj = 0; bj < 2; ++bj)
#pragma unroll
            for (int n = 0; n < 2; ++n) bv[bj][n] = bias ? *(const f32x4*)(bias + col0 + bj * 128 + 4 * n) : (f32x4){0.f, 0.f, 0.f, 0.f};
#pragma unroll
        for (int ai = 0; ai < 2; ++ai)
#pragma unroll
            for (int m = 0; m < 4; ++m) { const int rl = ai * 128 + wr * 64 + m * 16 + fr; const size_t off = (size_t)(u.pm * 256 + rl) * D + col0; float ss = 0.f;
#pragma unroll
                for (int bj = 0; bj < 2; ++bj) { const size_t c = off + bj * 128; f32x4 b0, b1;
                    if (basef) { b0 = *(const f32x4*)(basef + c); b1 = *(const f32x4*)(basef + c + 4); }
                    else { const v4u bw = *(const v4u*)(baseb + c); b0 = (f32x4){bflo(bw.x), bfhi(bw.x), bflo(bw.y), bfhi(bw.y)}; b1 = (f32x4){bflo(bw.z), bfhi(bw.z), bflo(bw.w), bfhi(bw.w)}; }
                    const f32x4 v0 = b0 + acc[ai][bj][m][0] + bv[bj][0], v1 = b1 + acc[ai][bj][m][1] + bv[bj][1];
                    v4u w; w.x = pg8::cvt_pk_bf16(v0[0], v0[1]); w.y = pg8::cvt_pk_bf16(v0[2], v0[3]); w.z = pg8::cvt_pk_bf16(v1[0], v1[1]); w.w = pg8::cvt_pk_bf16(v1[2], v1[3]);
                    *(v4u*)(xb + c) = w;
                    const float r0 = bflo(w.x), r1 = bfhi(w.x), r2 = bflo(w.y), r3 = bfhi(w.y), r4 = bflo(w.z), r5 = bfhi(w.z), r6 = bflo(w.w), r7 = bfhi(w.w);
                    ss += ((r0 * r0 + r1 * r1) + (r2 * r2 + r3 * r3)) + ((r4 * r4 + r5 * r5) + (r6 * r6 + r7 * r7)); }
                ss += __shfl_xor(ss, 16); ss += __shfl_xor(ss, 32);
                if (fq == 0) P[rl * 4 + wc] = ss;
                if (m & 1) asm volatile("" ::: "memory"); }
        asm volatile("s_waitcnt lgkmcnt(0)" ::: "memory"); __builtin_amdgcn_s_barrier(); asm volatile("" ::: "memory");
        const int tid = wid * 64 + lane;
        if (tid < 256) { const f32x4 p = *(const PG8_LAS f32x4*)(P + tid * 4); ssp[(size_t)(u.pm * 256 + tid) * 4 + u.pn] = (p.x + p.y) + (p.z + p.w); }
        asm volatile("s_waitcnt lgkmcnt(0)" ::: "memory"); __builtin_amdgcn_s_barrier(); asm volatile("" ::: "memory");
    }
};

struct Frame {
    LAS unsigned char* lds;
    volatile LAS unsigned* MISC;
    gu32* ctl;
    int tid, lane, wave;
    int vcu, G;
};
struct Args { const float* in[19]; float* out; unsigned char* ws; };
typedef const char __attribute__((address_space(4)))* karg_ptr;
__device__ __forceinline__ karg_ptr kargs() { karg_ptr kp = (karg_ptr)__builtin_amdgcn_kernarg_segment_ptr(); asm volatile("" : "+s"(kp)); return kp; }
__device__ __forceinline__ const float* arg_in(int i) { return *(const float* const __attribute__((address_space(4)))*)(kargs() + 8 * i); }
__device__ __forceinline__ float* arg_out() { return *(float* const __attribute__((address_space(4)))*)(kargs() + 8 * 19); }
__device__ __forceinline__ unsigned char* arg_ws() { return *(unsigned char* const __attribute__((address_space(4)))*)(kargs() + 8 * 20); }
#define WSP(T, off) ((T*)(arg_ws() + (off)))


#define LAUNDER_TID(F) do { int l_ = (int)__builtin_amdgcn_mbcnt_hi(~0u, __builtin_amdgcn_mbcnt_lo(~0u, 0u)); asm volatile("" : "+v"(l_)); (F).lane = l_; (F).tid = (F).wave * 64 + l_; } while (0)
__device__ __forceinline__ void conv_item(const float* W, int ldw, int K, int nblk, const float* gain, float qscale, int qcols, bf16* WT, int rowmode, int row_off, LAS float* scr, int item, int lane) {
    const int kb = item / nblk, nb = item % nblk, k0 = 64 * kb, n0 = 32 * nb;
    const float ns = (n0 < qcols) ? qscale : 1.f;
    {
        f32x4 wv[8];
#pragma unroll
        for (int i = 0; i < 8; ++i) wv[i] = *(const f32x4*)(W + (size_t)(k0 + 8 * i + (lane >> 3)) * ldw + n0 + 4 * (lane & 7));
#pragma unroll
        for (int i = 0; i < 8; ++i) { const int kk = 8 * i + (lane >> 3); const float gk = gain ? gain[k0 + kk] * ns : ns; LAS float* d = scr + kk * 33 + 4 * (lane & 7);
            d[0] = wv[i].x * gk; d[1] = wv[i].y * gk; d[2] = wv[i].z * gk; d[3] = wv[i].w * gk; }
    }
    LDS_WAIT(); asm volatile("" ::: "memory");
    int rbase;
    if (rowmode == 0) rbase = row_off + n0;
    else { int j = n0, add = 0; if (j >= DFF) { j -= DFF; add = 128; } rbase = 256 * (j / 128) + add + (j % 128); }
    const int c = lane & 7;
#pragma unroll
    for (int j = 0; j < 4; ++j) { const int n = (lane >> 3) + 8 * j; const LAS float* s = scr + (8 * c) * 33 + n;
        v4u o; o.x = pk2(s[0 * 33], s[1 * 33]); o.y = pk2(s[2 * 33], s[3 * 33]); o.z = pk2(s[4 * 33], s[5 * 33]); o.w = pk2(s[6 * 33], s[7 * 33]);
        *(GAS v4u*)(WT + (size_t)(rbase + n) * K + k0 + 8 * c) = o; }
    LDS_WAIT(); asm volatile("" ::: "memory");
}
__device__ __forceinline__ void conv_layer(Frame& F, int l, int wi, int nw) {
    LAUNDER_TID(F);
    LAS float* scr = (LAS float*)(F.lds + RING_OFF + F.wave * 16384);
    unsigned char* ws = arg_ws();
    constexpr int I_IN = 16 * 96, I_SQ = 16 * 32, I_KV = 16 * 8, I_GU = 16 * 176, I_DN = 44 * 32;
    const int n0 = (l < 2) ? I_IN : (l == 2 ? I_SQ + I_KV : I_SQ);
    const int nitems = n0 + I_SQ + I_GU + I_DN;
    for (int it = wi; it < nitems; it += nw) {
        int r = it;
        if (r < n0) {
            if (l < 2) conv_item(arg_in(2) + (size_t)l * D * INA, INA, D, 96, arg_in(1) + l * D, QSCALE_A, 512, (bf16*)(ws + WS_WIN) + (size_t)l * 3072 * D, 0, 0, scr, r, F.lane);
            else if (r < I_SQ) conv_item(arg_in(10) + (size_t)(l - 2) * D * D, D, D, 32, arg_in(9) + (l - 2) * D, C2, 1024, (bf16*)(ws + (l == 2 ? WS_WQ2 : WS_WQ3)), 0, 0, scr, r, F.lane);
            else conv_item(arg_in(7), 256, D, 8, arg_in(6), 1.f, 0, (bf16*)(ws + WS_WQ2), 0, 1024, scr, r - I_SQ, F.lane);
            continue; }
        r -= n0;
        if (r < I_SQ) {
            if (l < 2) conv_item(arg_in(5) + (size_t)l * D * D, D, D, 32, nullptr, 1.f, 0, (bf16*)(ws + WS_WOUT) + (size_t)l * D * D, 0, 0, scr, r, F.lane);
            else conv_item(arg_in(13) + (size_t)(l - 2) * D * D, D, D, 32, nullptr, 1.f, 0, (bf16*)(ws + WS_WBO) + (size_t)(l - 2) * D * D, 0, 0, scr, r, F.lane);
            continue; }
        r -= I_SQ;
        if (r < I_GU) { conv_item(arg_in(16) + (size_t)l * D * 2 * DFF, 2 * DFF, D, 176, arg_in(15) + l * D, 1.f, 0, (bf16*)(ws + WS_WGU) + (size_t)l * 2 * DFF * D, 1, 0, scr, r, F.lane); continue; }
        r -= I_GU;
        conv_item(arg_in(17) + (size_t)l * DFF * D, D, DFF, 32, nullptr, 1.f, 0, (bf16*)(ws + WS_WD) + (size_t)l * D * DFF, 0, 0, scr, r, F.lane);
    }
}
__device__ __forceinline__ void p0_prologue(Frame& F, const Args& A, int nlayers) {
    for (int l = 0; l < nlayers; ++l) conv_layer(F, l, F.vcu * NWAVES + F.wave, F.G * NWAVES);
    LAUNDER_TID(F);
    const int gw = F.vcu * NWAVES + F.wave, NGW = F.G * NWAVES;
    unsigned char* ws = A.ws;
    const float* a_norm = A.in[1]; const float* a_w_in = A.in[2]; const float* b_kv = A.in[8]; const float* b_b_q = A.in[11];
    const float* x = A.in[0]; bf16* XB = (bf16*)(ws + WS_XB); float* SSP = (float*)(ws + WS_SSP);
    for (int m = gw; m < M; m += NGW) {
        const GAS f32x4* xr = (const GAS f32x4*)(x + (size_t)m * D) + F.lane; GAS u32x2* o8 = (GAS u32x2*)(XB + (size_t)m * D) + F.lane; float s = 0.f;
#pragma unroll
        for (int j = 0; j < 4; ++j) { const f32x4 v = xr[64 * j]; s += (v.x * v.x + v.y * v.y) + (v.z * v.z + v.w * v.w); u32x2 w; w.x = pk2(v.x, v.y); w.y = pk2(v.z, v.w); o8[64 * j] = w; }
        s = wave_sum(s);
        if (F.lane == 0) *(f32x4*)(SSP + (size_t)m * 4) = (f32x4){s, 0.f, 0.f, 0.f};
    }
    const int gt = F.vcu * (NWAVES * 64) + F.tid, NGT = F.G * NWAVES * 64;
    float* WGT = (float*)(ws + WS_WGT); float* BQ = (float*)(ws + WS_BQ);
    for (int i = gt; i < 2 * 8 * 1024; i += NGT) { const int l = i >> 13, j = (i >> 10) & 7, k = i & 1023; WGT[i] = a_w_in[(size_t)l * D * INA + (size_t)k * INA + 3072 + j] * a_norm[l * D + k]; }
    for (int i = gt; i < 2 * 1280; i += NGT) { const int l = i / 1280, c = i % 1280; BQ[i] = (c < 1024) ? b_b_q[l * D + c] * C2 : b_kv[c - 1024]; }
}

__device__ __forceinline__ float softcap15(float x) { return 15.f * tanhf(x * (1.f / 15.f)); }
__device__ __forceinline__ float logsigmoidf(float x) { return fminf(x, 0.f) - log1pf(expf(-fabsf(x))); }

__device__ __forceinline__ void gates_phase(Frame& F, const bf16* XB, const float* SSP, const float* WGTl, const float* bgl, float* GATES) {
    LAUNDER_TID(F);
    LAS float* Wl = (LAS float*)(F.lds + RING_OFF);
    for (int i = F.tid; i < 8 * 1024 / 4; i += NWAVES * 64) ((LAS f32x4*)Wl)[i] = ((const f32x4*)WGTl)[i];
    for (int blk = F.vcu; blk < M / 64; blk += F.G) {
        const int row0 = blk * 64 + F.wave * 8;
        u32x2 xw[8][4];
#pragma unroll
        for (int rr = 0; rr < 8; ++rr)
#pragma unroll
            for (int i = 0; i < 4; ++i) xw[rr][i] = *(const u32x2*)(XB + (size_t)(row0 + rr) * D + 4 * F.lane + 256 * i);
        const float rs = (F.lane < 8) ? rstd_of(SSP, row0 + F.lane) : 0.f;
        const float bg = (F.lane < 8) ? bgl[F.lane] : 0.f;
        __syncthreads();
        float res = 0.f;
#pragma unroll
        for (int rr = 0; rr < 8; ++rr) {
            float acc[8] = {0.f, 0.f, 0.f, 0.f, 0.f, 0.f, 0.f, 0.f};
#pragma unroll
            for (int i = 0; i < 4; ++i) { const int k = 4 * F.lane + 256 * i; const float x0 = bflo(xw[rr][i].x), x1 = bfhi(xw[rr][i].x), x2 = bflo(xw[rr][i].y), x3 = bfhi(xw[rr][i].y);
#pragma unroll
                for (int j = 0; j < 8; ++j) { const f32x4 w = *(const LAS f32x4*)(Wl + j * 1024 + k); acc[j] += (x0 * w.x + x1 * w.y) + (x2 * w.z + x3 * w.w); } }
#pragma unroll
            for (int j = 0; j < 8; ++j) acc[j] = wave_sum(acc[j]);
            float a = acc[0];
#pragma unroll
            for (int j = 1; j < 8; ++j) a = (F.lane == j) ? acc[j] : a;
            const float rsr = __shfl(rs, rr);
            if (F.lane < 8) { const float pre = softcap15(a * rsr + bg); GATES[(size_t)(row0 + rr) * 8 + F.lane] = (F.lane < 4) ? pre : logsigmoidf(pre); }
            (void)res;
        }
    }
    __syncthreads();
}

__device__ __forceinline__ void chunk_gates(Frame& F, const float* GATES, int c, int h, LAS float* bcum, LAS float* aval) {
    if (F.tid < 64) {
        const float lf = GATES[(size_t)(c * 64 + F.tid) * 8 + 4 + h], ig = GATES[(size_t)(c * 64 + F.tid) * 8 + h];
        float s = lf;
#pragma unroll
        for (int o = 1; o < 64; o <<= 1) { const float t = __shfl_up(s, o); if (F.lane >= o) s += t; }
        bcum[F.tid] = s; aval[F.tid] = ig - s;
    }
    __syncthreads();
}

__device__ __forceinline__ void ml_local_phase(Frame& F, const bf16* PROJ, const float* GATES, bf16* STATE, float* NST, float* CH) {
    LAUNDER_TID(F);
    LAS float* bcum = (LAS float*)(F.lds + RING_OFF); LAS float* aval = bcum + 64; LAS float* wsv = aval + 64;
    for (int unit = F.vcu; unit < NC * 4; unit += F.G) {
        const int c = unit >> 2, h = unit & 3;
        chunk_gates(F, GATES, c, h, bcum, aval);
        const float btot = bcum[63]; float amax = -INFINITY;
        for (int s = 0; s < 64; ++s) amax = fmaxf(amax, aval[s]);
        const float mloc = btot + amax;
        if (F.tid < 64) wsv[F.tid] = expf(btot + aval[F.tid] - mloc);
        __syncthreads();
        const bf16* kb = PROJ + (size_t)(c * 64) * 3072 + 512 + h * 128;
        const bf16* vb = PROJ + (size_t)(c * 64) * 3072 + 1024 + h * 256;
        const int v = F.tid >> 1, dh = F.tid & 1;
        float acc[64];
#pragma unroll
        for (int j = 0; j < 64; ++j) acc[j] = 0.f;
#pragma unroll 1
        for (int s = 0; s < 64; ++s) {
            const float wv = wsv[s] * bf2f(vb[(size_t)s * 3072 + v]);
            const v4u* kr = (const v4u*)(kb + (size_t)s * 3072 + dh * 64);
#pragma unroll
            for (int q = 0; q < 8; ++q) { const v4u kk = kr[q];
                acc[q * 8 + 0] += wv * bflo(kk.x); acc[q * 8 + 1] += wv * bfhi(kk.x); acc[q * 8 + 2] += wv * bflo(kk.y); acc[q * 8 + 3] += wv * bfhi(kk.y);
                acc[q * 8 + 4] += wv * bflo(kk.z); acc[q * 8 + 5] += wv * bfhi(kk.z); acc[q * 8 + 6] += wv * bflo(kk.w); acc[q * 8 + 7] += wv * bfhi(kk.w); }
        }
        bf16* st = STATE + ((size_t)(c * 4 + h) * 256 + v) * 128 + dh * 64;
#pragma unroll
        for (int q = 0; q < 8; ++q) { v4u o; o.x = pk2(acc[q * 8 + 0], acc[q * 8 + 1]); o.y = pk2(acc[q * 8 + 2], acc[q * 8 + 3]); o.z = pk2(acc[q * 8 + 4], acc[q * 8 + 5]); o.w = pk2(acc[q * 8 + 6], acc[q * 8 + 7]); *(v4u*)(st + q * 8) = o; }
        if (F.tid < 128) { float a = 0.f; for (int s = 0; s < 64; ++s) a += wsv[s] * bf2f(kb[(size_t)s * 3072 + F.tid]); NST[(size_t)(c * 4 + h) * 128 + F.tid] = a; }
        if (F.tid == 0) { CH[(c * 4 + h) * 2] = btot; CH[(c * 4 + h) * 2 + 1] = mloc; }
        __syncthreads();
    }
}

__device__ __forceinline__ void ml_scan_phase(Frame& F, bf16* STATE, float* NST, const float* CH, float* MS) {
    LAUNDER_TID(F);
    LAS float* f1 = (LAS float*)(F.lds + RING_OFF); LAS float* f2 = f1 + 256;
    const int h = F.vcu >> 6;
    if (F.tid < 64) {
        float bt[4], ml[4];
#pragma unroll
        for (int j = 0; j < 4; ++j) { const int c = 4 * F.lane + j; bt[j] = CH[(c * 4 + h) * 2]; ml[j] = CH[(c * 4 + h) * 2 + 1]; }
        float B = bt[0], Mx = ml[0];
#pragma unroll
        for (int j = 1; j < 4; ++j) { Mx = fmaxf(Mx + bt[j], ml[j]); B += bt[j]; }
#pragma unroll
        for (int o = 1; o < 64; o <<= 1) { const float Bp = __shfl_up(B, o), Mp = __shfl_up(Mx, o); if (F.lane >= o) { Mx = fmaxf(Mp + B, Mx); B = Bp + B; } }
        const float Bq = __shfl_up(B, 1), Mq = __shfl_up(Mx, 1);
        float m = (F.lane == 0) ? 0.f : fmaxf(Bq, Mq);
#pragma unroll
        for (int j = 0; j < 4; ++j) { const int c = 4 * F.lane + j; const float mn = fmaxf(bt[j] + m, ml[j]);
            f1[c] = expf(bt[j] + m - mn); f2[c] = expf(ml[j] - mn); if ((F.vcu & 63) == 0) MS[c * 4 + h] = m; m = mn; }
    }
    __syncthreads();
    if (F.tid < 256) {
        unsigned* base = (unsigned*)(STATE + (size_t)h * 32768) + ((F.vcu & 63) * 256 + F.tid);
        float c0v = 0.f, c1v = 0.f;
#pragma unroll 1
        for (int cb = 0; cb < NC; cb += 16) {
            unsigned u[16];
#pragma unroll
            for (int j = 0; j < 16; ++j) u[j] = base[(size_t)(cb + j) * 65536];
#pragma unroll
            for (int j = 0; j < 16; ++j) { const float a = f1[cb + j], b = f2[cb + j];
                base[(size_t)(cb + j) * 65536] = pg8::cvt_pk_bf16(c0v, c1v);
                c0v = a * c0v + b * bflo(u[j]); c1v = a * c1v + b * bfhi(u[j]); }
        }
    } else if ((F.vcu & 63) == 0 && F.tid < 384) {
        float* base = NST + h * 128 + (F.tid - 256); float nv = 0.f;
#pragma unroll 1
        for (int cb = 0; cb < NC; cb += 8) {
            float u[8];
#pragma unroll
            for (int j = 0; j < 8; ++j) u[j] = base[(size_t)(cb + j) * 512];
#pragma unroll
            for (int j = 0; j < 8; ++j) { base[(size_t)(cb + j) * 512] = nv; nv = f1[cb + j] * nv + f2[cb + j] * u[j]; }
        }
    }
    __syncthreads();
}

__device__ __forceinline__ void ml_out_phase(Frame& F, const bf16* PROJ, const float* GATES, const bf16* STATE, const float* NST, const float* MS, const float* hnorm, bf16* HG) {
    LAUNDER_TID(F);
    LAS float* bcum = (LAS float*)(F.lds + RING_OFF); LAS float* aval = bcum + 64; LAS float* mt = aval + 64; LAS float* et = mt + 64; LAS float* den = et + 64; LAS float* nq = den + 64;
    LAS float* red = nq + 64;
    LAS float* S = red + 64;
    const float scale = 1.f;
    for (int unit = F.vcu; unit < NC * 4; unit += F.G) {
        const int c = unit >> 2, h = unit & 3;
        chunk_gates(F, GATES, c, h, bcum, aval);
        const float mc = MS[c * 4 + h];
        if (F.tid < 64) { float am = -INFINITY; for (int s = 0; s <= F.tid; ++s) am = fmaxf(am, aval[s]); const float m_t = bcum[F.tid] + fmaxf(mc, am); mt[F.tid] = m_t; et[F.tid] = expf(bcum[F.tid] + mc - m_t); }
        __syncthreads();
        const bf16* qb = PROJ + (size_t)(c * 64) * 3072 + h * 128;
        const bf16* kb = PROJ + (size_t)(c * 64) * 3072 + 512 + h * 128;
        const bf16* vb = PROJ + (size_t)(c * 64) * 3072 + 1024 + h * 256;
        {
            const int t = F.tid >> 3;
#pragma unroll 1
            for (int j = 0; j < 8; ++j) { const int s = (F.tid & 7) * 8 + j; float a = 0.f;
                if (s <= t) { const v4u* qr = (const v4u*)(qb + (size_t)t * 3072); const v4u* kr = (const v4u*)(kb + (size_t)s * 3072);
#pragma unroll 4
                    for (int q = 0; q < 16; ++q) { const v4u a4 = qr[q], b4 = kr[q];
                        a += bflo(a4.x) * bflo(b4.x) + bfhi(a4.x) * bfhi(b4.x) + bflo(a4.y) * bflo(b4.y) + bfhi(a4.y) * bfhi(b4.y) + bflo(a4.z) * bflo(b4.z) + bfhi(a4.z) * bfhi(b4.z) + bflo(a4.w) * bflo(b4.w) + bfhi(a4.w) * bfhi(b4.w); }
                    a *= scale * expf(bcum[t] + aval[s] - mt[t]); }
                S[t * 65 + s] = a; }
        }
        if (F.tid < 64) { float a = 0.f; const float* nn = NST + (size_t)(c * 4 + h) * 128; for (int d = 0; d < 128; ++d) a += nn[d] * bf2f(qb[(size_t)F.tid * 3072 + d]); nq[F.tid] = a * scale; }
        __syncthreads();
        if (F.tid < 64) { float a = 0.f; for (int s = 0; s < 64; ++s) a += S[F.tid * 65 + s]; a += et[F.tid] * nq[F.tid]; den[F.tid] = fmaxf(fabsf(a), expf(-mt[F.tid])); }
        __syncthreads();
        const int v = F.tid & 255, th = F.tid >> 8;
        v4u Cc[16];
        { const v4u* st = (const v4u*)(STATE + ((size_t)(c * 4 + h) * 256 + v) * 128);
#pragma unroll
          for (int q = 0; q < 16; ++q) Cc[q] = st[q]; }
        const float gain = hnorm[h * 256 + v];
#pragma unroll 1
        for (int tt = 0; tt < 32; ++tt) {
            const int t = th * 32 + tt;
            float a = 0.f;
            for (int s = 0; s <= t; ++s) a += S[t * 65 + s] * bf2f(vb[(size_t)s * 3072 + v]);
            float b = 0.f; const v4u* qr = (const v4u*)(qb + (size_t)t * 3072);
#pragma unroll
            for (int q = 0; q < 16; ++q) { const v4u a4 = qr[q], b4 = Cc[q];
                b += bflo(a4.x) * bflo(b4.x) + bfhi(a4.x) * bfhi(b4.x) + bflo(a4.y) * bflo(b4.y) + bfhi(a4.y) * bfhi(b4.y) + bflo(a4.z) * bflo(b4.z) + bfhi(a4.z) * bfhi(b4.z) + bflo(a4.w) * bflo(b4.w) + bfhi(a4.w) * bfhi(b4.w); }
            const float hv = (a + et[t] * scale * b) / den[t];
            const float ss = wave_sum(hv * hv);
            __syncthreads();
            if (F.lane == 0) red[F.wave] = ss;
            __syncthreads();
            const float tot = (red[th * 4] + red[th * 4 + 1]) + (red[th * 4 + 2] + red[th * 4 + 3]);
            const float r = rsqrtf(tot * (1.f / 256.f) + RMS_EPS);
            const size_t row = (size_t)(c * 64 + t);
            const float o = bf2f(PROJ[row * 3072 + 2048 + h * 256 + v]);
            HG[row * D + h * 256 + v] = (bf16)f2bf(hv * r * gain / (1.f + expf(-o)));
        }
        __syncthreads();
    }
}

__device__ __forceinline__ void attn_phase(Frame& F, const bf16* Q, const bf16* KV, const float* sinks, bf16* O) {
    LAUNDER_TID(F);
    for (int unit = F.vcu; unit < 128 * 16; unit += F.G) {
        const int nb = unit >> 4, head = unit & 15, kvh = head >> 3;
        const int i = F.tid >> 2, part = F.tid & 3;
        const int qpos = nb * 128 + i;
        float q[16], o[16];
        { const v4u* qr = (const v4u*)(Q + (size_t)qpos * D + head * 64 + part * 16);
#pragma unroll
          for (int w = 0; w < 2; ++w) { const v4u a = qr[w]; q[w * 8 + 0] = bflo(a.x); q[w * 8 + 1] = bfhi(a.x); q[w * 8 + 2] = bflo(a.y); q[w * 8 + 3] = bfhi(a.y); q[w * 8 + 4] = bflo(a.z); q[w * 8 + 5] = bfhi(a.z); q[w * 8 + 6] = bflo(a.w); q[w * 8 + 7] = bfhi(a.w); } }
        float m = sinks[head] * LOG2E, l = 1.f;
#pragma unroll
        for (int d = 0; d < 16; ++d) o[d] = 0.f;
        const int j0 = (nb == 0) ? 128 : 0;
#pragma unroll 1
        for (int j = j0; j < 256; ++j) {
            const int kpos = (nb - 1) * 128 + j;
            const int rel = i + 128 - j;
            const bool valid = (rel >= 0) && (rel < 128);
            const v4u* kr = (const v4u*)(KV + (size_t)kpos * 256 + kvh * 64 + part * 16);
            const v4u* vr = (const v4u*)(KV + (size_t)kpos * 256 + 128 + kvh * 64 + part * 16);
            float kf[16], vf[16];
#pragma unroll
            for (int w = 0; w < 2; ++w) { const v4u a = kr[w]; kf[w * 8 + 0] = bflo(a.x); kf[w * 8 + 1] = bfhi(a.x); kf[w * 8 + 2] = bflo(a.y); kf[w * 8 + 3] = bfhi(a.y); kf[w * 8 + 4] = bflo(a.z); kf[w * 8 + 5] = bfhi(a.z); kf[w * 8 + 6] = bflo(a.w); kf[w * 8 + 7] = bfhi(a.w);
                const v4u b = vr[w]; vf[w * 8 + 0] = bflo(b.x); vf[w * 8 + 1] = bfhi(b.x); vf[w * 8 + 2] = bflo(b.y); vf[w * 8 + 3] = bfhi(b.y); vf[w * 8 + 4] = bflo(b.z); vf[w * 8 + 5] = bfhi(b.z); vf[w * 8 + 6] = bflo(b.w); vf[w * 8 + 7] = bfhi(b.w); }
            float s = 0.f;
#pragma unroll
            for (int d = 0; d < 16; ++d) s += q[d] * kf[d];
            s += __shfl_xor(s, 1); s += __shfl_xor(s, 2);
            if (valid) {
                const float mn = fmaxf(m, s), corr = __builtin_amdgcn_exp2f(m - mn), p = __builtin_amdgcn_exp2f(s - mn);
                l = l * corr + p;
#pragma unroll
                for (int d = 0; d < 16; ++d) o[d] = o[d] * corr + p * vf[d];
                m = mn;
            }
        }
        const float inv = 1.f / l;
        v4u w0, w1;
        w0.x = pk2(o[0] * inv, o[1] * inv); w0.y = pk2(o[2] * inv, o[3] * inv); w0.z = pk2(o[4] * inv, o[5] * inv); w0.w = pk2(o[6] * inv, o[7] * inv);
        w1.x = pk2(o[8] * inv, o[9] * inv); w1.y = pk2(o[10] * inv, o[11] * inv); w1.z = pk2(o[12] * inv, o[13] * inv); w1.w = pk2(o[14] * inv, o[15] * inv);
        v4u* op = (v4u*)(O + (size_t)qpos * D + head * 64 + part * 16); op[0] = w0; op[1] = w1;
    }
}

__device__ __forceinline__ void final_norm_phase(Frame& F, float* out, const bf16* XB, const float* SSP, const float* g) {
    LAUNDER_TID(F);
    const int gw = F.vcu * NWAVES + F.wave, NGW = F.G * NWAVES;
    for (int m = gw; m < M; m += NGW) {
        const float rs = rstd_of(SSP, m);
        GAS f32x4* xr = (GAS f32x4*)(out + (size_t)m * D) + F.lane; const f32x4* gg = (const f32x4*)g + F.lane; const u32x2* xb = (const u32x2*)(XB + (size_t)m * D) + F.lane;
#pragma unroll
        for (int j = 0; j < 4; ++j) { const u32x2 v = xb[64 * j]; const f32x4 w = gg[64 * j]; xr[64 * j] = (f32x4){bflo(v.x) * rs * w.x, bfhi(v.x) * rs * w.y, bflo(v.y) * rs * w.z, bfhi(v.y) * rs * w.w}; }
    }
}

typedef float f32x16 __attribute__((ext_vector_type(16)));
typedef short s16x4 __attribute__((ext_vector_type(4)));
typedef short v4i16_t __attribute__((ext_vector_type(4)));
__device__ __forceinline__ s16x4 tr16(const LAS unsigned char* p) { return __builtin_bit_cast(s16x4, __builtin_amdgcn_ds_read_tr16_b64_v4i16((LAS v4i16_t*)p)); }
__device__ __forceinline__ bf16x8 cat8(s16x4 a, s16x4 b) { return (bf16x8){a[0], a[1], a[2], a[3], b[0], b[1], b[2], b[3]}; }
__device__ __forceinline__ unsigned cvtpk(float lo, float hi) { return pg8::cvt_pk_bf16(lo, hi); }
__device__ __forceinline__ bf16x8 pack8(const f32x16& p, int s) {
    v4u w; w.x = cvtpk(p[8 * s + 0], p[8 * s + 1]); w.y = cvtpk(p[8 * s + 2], p[8 * s + 3]); w.z = cvtpk(p[8 * s + 4], p[8 * s + 5]); w.w = cvtpk(p[8 * s + 6], p[8 * s + 7]);
    return __builtin_bit_cast(bf16x8, w);
}
#define MFMA32(a, b, c) __builtin_amdgcn_mfma_f32_32x32x16_bf16((a), (b), (c), 0, 0, 0)
#define CROW(r, hi) (((r) & 3) + 8 * ((r) >> 2) + 4 * (hi))

__device__ __forceinline__ void attn_phase_mfma(Frame& F, const bf16* Q, const bf16* KV, const float* sinks, bf16* O) {
    LAUNDER_TID(F);
    LAS unsigned char* Kl = F.lds + RING_OFF;
    LAS unsigned char* Vl = Kl + 32768;
    const int lane = F.lane, r32 = lane & 31, hi = lane >> 5;
    for (int unit = F.vcu; unit < 256; unit += F.G) {
        const int nb = unit >> 1, kvh = unit & 1, head = kvh * 8 + F.wave;
#pragma unroll
        for (int i = 0; i < 4; ++i) { const int p = F.tid + 512 * i, key = p >> 3, c = p & 7, kpos = (nb - 1) * 128 + key;
            if (kpos >= 0) { const v4u kk = *(const v4u*)(KV + (size_t)kpos * 256 + kvh * 64 + c * 8); const v4u vv = *(const v4u*)(KV + (size_t)kpos * 256 + 128 + kvh * 64 + c * 8);
                *(LAS v4u*)(Kl + key * 128 + ((c ^ ((key >> 1) & 7)) << 4)) = kk; *(LAS v4u*)(Vl + (c >> 2) * 16384 + key * 64 + (c & 3) * 16) = vv; } }
        __syncthreads();
        const float sk = sinks[head] * LOG2E;
#pragma unroll 1
        for (int qb = 0; qb < 4; ++qb) {
            const int qpos = nb * 128 + qb * 32 + r32;
            bf16x8 qf[4];
#pragma unroll
            for (int kk = 0; kk < 4; ++kk) qf[kk] = *(const bf16x8*)(Q + (size_t)qpos * D + head * 64 + kk * 16 + hi * 8);
            f32x16 sacc[5];
#pragma unroll
            for (int t = 0; t < 5; ++t) {
#pragma unroll
                for (int r = 0; r < 16; ++r) sacc[t][r] = 0.f;
                if (nb > 0 || qb + t >= 4) { const int key = (qb + t) * 32 + r32;
#pragma unroll
                    for (int kk = 0; kk < 4; ++kk) { const int c = 2 * kk + hi; const bf16x8 kf = *(const LAS bf16x8*)(Kl + key * 128 + ((c ^ ((key >> 1) & 7)) << 4)); sacc[t] = MFMA32(kf, qf[kk], sacc[t]); } }
            }
            float mx = sk;
#pragma unroll
            for (int t = 0; t < 5; ++t) { const bool live = (nb > 0 || qb + t >= 4);
#pragma unroll
                for (int r = 0; r < 16; ++r) { const int cr = CROW(r, hi); bool valid = live; if (t == 0) valid = valid && (cr > r32); if (t == 4) valid = valid && (cr <= r32);
                    const float s = valid ? sacc[t][r] : -INFINITY; sacc[t][r] = s; mx = fmaxf(mx, s); } }
            mx = fmaxf(mx, __shfl_xor(mx, 32));
            float l = 0.f;
#pragma unroll
            for (int t = 0; t < 5; ++t)
#pragma unroll
                for (int r = 0; r < 16; ++r) { const float p = __builtin_amdgcn_exp2f(sacc[t][r] - mx); sacc[t][r] = p; l += p; }
            l += __shfl_xor(l, 32); l += __builtin_amdgcn_exp2f(sk - mx);
            f32x16 oacc[2];
#pragma unroll
            for (int r = 0; r < 16; ++r) { oacc[0][r] = 0.f; oacc[1][r] = 0.f; }
#pragma unroll
            for (int t = 0; t < 5; ++t) if (nb > 0 || qb + t >= 4) {
#pragma unroll
                for (int s = 0; s < 2; ++s) { const bf16x8 pf = pack8(sacc[t], s);
#pragma unroll
                    for (int dt = 0; dt < 2; ++dt) { const LAS unsigned char* vp = Vl + dt * 16384 + ((qb + t) * 32 + 16 * s + 4 * hi + ((lane & 15) >> 2)) * 64 + ((lane >> 4) & 1) * 32 + (lane & 3) * 8;
                        const bf16x8 vf = cat8(tr16(vp), tr16(vp + 8 * 64)); oacc[dt] = MFMA32(vf, pf, oacc[dt]); } } }
            const float inv = 1.f / l;
            bf16* orow = O + (size_t)qpos * D + head * 64 + 4 * hi;
#pragma unroll
            for (int dt = 0; dt < 2; ++dt)
#pragma unroll
                for (int gq = 0; gq < 4; ++gq) { u32x2 w; w.x = cvtpk(oacc[dt][4 * gq] * inv, oacc[dt][4 * gq + 1] * inv); w.y = cvtpk(oacc[dt][4 * gq + 2] * inv, oacc[dt][4 * gq + 3] * inv);
                    *(u32x2*)(orow + 32 * dt + 8 * gq) = w; }
        }
        __syncthreads();
    }
}

__device__ __forceinline__ void ml_local_phase_mfma(Frame& F, const bf16* PROJ, const float* GATES, bf16* STATE, float* NST, float* CH) {
    LAUNDER_TID(F);
    LAS unsigned char* Kl = F.lds + RING_OFF;
    LAS unsigned char* Vl = Kl + 16384;
    LAS float* bcum = (LAS float*)(Vl + 32768); LAS float* aval = bcum + 64; LAS float* wsv = aval + 64;
    const int lane = F.lane, r32 = lane & 31, hi = lane >> 5;
    for (int unit = F.vcu; unit < NC * 4; unit += F.G) {
        const int c = unit >> 2, h = unit & 3;
        chunk_gates(F, GATES, c, h, bcum, aval);
        const float btot = bcum[63]; float amax = -INFINITY;
        for (int s = 0; s < 64; ++s) amax = fmaxf(amax, aval[s]);
        const float mloc = btot + amax;
        if (F.tid < 64) wsv[F.tid] = expf(btot + aval[F.tid] - mloc);
        __syncthreads();
        const bf16* kb = PROJ + (size_t)(c * 64) * 3072 + 512 + h * 128;
        const bf16* vb = PROJ + (size_t)(c * 64) * 3072 + 1024 + h * 256;
#pragma unroll
        for (int i = 0; i < 2; ++i) { const int p = F.tid + 512 * i, s = p >> 4, cc = p & 15; const v4u kk = *(const v4u*)(kb + (size_t)s * 3072 + cc * 8); const float w = wsv[s];
            v4u o; o.x = pk2(bflo(kk.x) * w, bfhi(kk.x) * w); o.y = pk2(bflo(kk.y) * w, bfhi(kk.y) * w); o.z = pk2(bflo(kk.z) * w, bfhi(kk.z) * w); o.w = pk2(bflo(kk.w) * w, bfhi(kk.w) * w);
            *(LAS v4u*)(Kl + (cc >> 2) * 4096 + s * 64 + (cc & 3) * 16) = o; }
#pragma unroll
        for (int i = 0; i < 4; ++i) { const int p = F.tid + 512 * i, s = p >> 5, cc = p & 31; const v4u vv = *(const v4u*)(vb + (size_t)s * 3072 + cc * 8);
            *(LAS v4u*)(Vl + (cc >> 2) * 4096 + s * 64 + (cc & 3) * 16) = vv; }
        if (F.tid == 0) { CH[(c * 4 + h) * 2] = btot; CH[(c * 4 + h) * 2 + 1] = mloc; }
        __syncthreads();
        if (F.tid >= 384) { const int d = F.tid - 384; float a = 0.f; const LAS unsigned short* kc = (const LAS unsigned short*)(Kl + (d >> 5) * 4096 + (d & 31) * 2);
#pragma unroll 16
            for (int s = 0; s < 64; ++s) a += bf2f(kc[s * 32]);
            NST[(size_t)(c * 4 + h) * 128 + d] = a; }
        f32x16 acc[4];
#pragma unroll
        for (int dt = 0; dt < 4; ++dt)
#pragma unroll
            for (int r = 0; r < 16; ++r) acc[dt][r] = 0.f;
        const int troff = (4 * hi + ((lane & 15) >> 2)) * 64 + ((lane >> 4) & 1) * 32 + (lane & 3) * 8;
#pragma unroll
        for (int ks = 0; ks < 4; ++ks) {
            const LAS unsigned char* vp = Vl + F.wave * 4096 + ks * 16 * 64 + troff;
            const bf16x8 vf = cat8(tr16(vp), tr16(vp + 8 * 64));
#pragma unroll
            for (int dt = 0; dt < 4; ++dt) { const LAS unsigned char* kp = Kl + dt * 4096 + ks * 16 * 64 + troff;
                const bf16x8 kf = cat8(tr16(kp), tr16(kp + 8 * 64));
                acc[dt] = MFMA32(kf, vf, acc[dt]); }
        }
        bf16* st = STATE + ((size_t)(c * 4 + h) * 256 + F.wave * 32 + r32) * 128 + 4 * hi;
#pragma unroll
        for (int dt = 0; dt < 4; ++dt)
#pragma unroll
            for (int gq = 0; gq < 4; ++gq) { u32x2 w; w.x = cvtpk(acc[dt][4 * gq], acc[dt][4 * gq + 1]); w.y = cvtpk(acc[dt][4 * gq + 2], acc[dt][4 * gq + 3]); *(u32x2*)(st + 32 * dt + 8 * gq) = w; }
        __syncthreads();
    }
}

__device__ __forceinline__ void ml_out_phase_mfma(Frame& F, const bf16* PROJ, const float* GATES, const bf16* STATE, const float* NST, const float* MS, const float* hnorm, bf16* HG) {
    LAUNDER_TID(F);
    LAS unsigned char* Vl = F.lds + RING_OFF;
    LAS float* bcum = (LAS float*)(Vl + 32768); LAS float* aval = bcum + 64; LAS float* mt = aval + 64; LAS float* et = mt + 64; LAS float* nst = et + 64  ; LAS float* red = nst + 128  ;
    const int lane = F.lane, r32 = lane & 31, hi = lane >> 5, tb = F.wave >> 2, vq = F.wave & 3;
    for (int unit = F.vcu; unit < NC * 4; unit += F.G) {
        const int c = unit >> 2, h = unit & 3;
        const float mc = MS[c * 4 + h];
        if (F.tid < 64) {
            const float lf = GATES[(size_t)(c * 64 + F.tid) * 8 + 4 + h], ig = GATES[(size_t)(c * 64 + F.tid) * 8 + h];
            float s = lf;
#pragma unroll
            for (int o = 1; o < 64; o <<= 1) { const float t = __shfl_up(s, o); if (lane >= o) s += t; }
            const float a = ig - s; float am = a;
#pragma unroll
            for (int o = 1; o < 64; o <<= 1) { const float t = __shfl_up(am, o); if (lane >= o) am = fmaxf(am, t); }
            const float m_t = s + fmaxf(mc, am);
            bcum[F.tid] = s; aval[F.tid] = a; mt[F.tid] = m_t; et[F.tid] = expf(s + mc - m_t);
        }
        if (F.tid >= 64 && F.tid < 192) nst[F.tid - 64] = NST[(size_t)(c * 4 + h) * 128 + F.tid - 64];
        const bf16* qb = PROJ + (size_t)(c * 64) * 3072 + h * 128;
        const bf16* kb = PROJ + (size_t)(c * 64) * 3072 + 512 + h * 128;
        const bf16* vb = PROJ + (size_t)(c * 64) * 3072 + 1024 + h * 256;
#pragma unroll
        for (int i = 0; i < 4; ++i) { const int p = F.tid + 512 * i, s = p >> 5, cc = p & 31; const v4u vv = *(const v4u*)(vb + (size_t)s * 3072 + cc * 8);
            *(LAS v4u*)(Vl + (cc >> 2) * 4096 + s * 64 + (cc & 3) * 16) = vv; }
        const int t = tb * 32 + r32;
        bf16x8 qf[8];
#pragma unroll
        for (int kk = 0; kk < 8; ++kk) qf[kk] = *(const bf16x8*)(qb + (size_t)t * 3072 + kk * 16 + hi * 8);
        f32x16 sacc[2];
#pragma unroll
        for (int sb = 0; sb < 2; ++sb) {
#pragma unroll
            for (int r = 0; r < 16; ++r) sacc[sb][r] = 0.f;
            if (sb <= tb) {
#pragma unroll
                for (int kk = 0; kk < 8; ++kk) { const bf16x8 kf = *(const bf16x8*)(kb + (size_t)(sb * 32 + r32) * 3072 + kk * 16 + hi * 8); sacc[sb] = MFMA32(kf, qf[kk], sacc[sb]); } }
        }
        __syncthreads();
        const float b_t = bcum[t], m_t = mt[t], e_t = et[t];
        float dsum = 0.f;
#pragma unroll
        for (int sb = 0; sb < 2; ++sb)
#pragma unroll
            for (int gq = 0; gq < 4; ++gq) { const f32x4 a4 = *(const LAS f32x4*)(aval + sb * 32 + 8 * gq + 4 * hi);
#pragma unroll
                for (int i = 0; i < 4; ++i) { const int r = 4 * gq + i, cr = 8 * gq + 4 * hi + i; const bool valid = (sb < tb) || (sb == tb && cr <= r32);
                    const float w = valid ? sacc[sb][r] * expf(b_t + a4[i] - m_t) : 0.f; sacc[sb][r] = w; dsum += w; } }
        float nq = 0.f;
#pragma unroll
        for (int kk = 0; kk < 8; ++kk) { const v4u qw = __builtin_bit_cast(v4u, qf[kk]); const f32x4 n0 = *(const LAS f32x4*)(nst + kk * 16 + hi * 8), n1 = *(const LAS f32x4*)(nst + kk * 16 + hi * 8 + 4);
            nq += (bflo(qw.x) * n0.x + bfhi(qw.x) * n0.y) + (bflo(qw.y) * n0.z + bfhi(qw.y) * n0.w) + (bflo(qw.z) * n1.x + bfhi(qw.z) * n1.y) + (bflo(qw.w) * n1.z + bfhi(qw.w) * n1.w); }
        dsum += __shfl_xor(dsum, 32); nq += __shfl_xor(nq, 32);
        const float dd = fmaxf(fabsf(dsum + e_t * nq), expf(-m_t));
        const float dinv = 1.f / dd;
        f32x16 hacc[2];
        const int troff = (4 * hi + ((lane & 15) >> 2)) * 64 + ((lane >> 4) & 1) * 32 + (lane & 3) * 8;
        float ss = 0.f;
#pragma unroll
        for (int vt = 0; vt < 2; ++vt) {
            f32x16 ia, xa;
#pragma unroll
            for (int r = 0; r < 16; ++r) { ia[r] = 0.f; xa[r] = 0.f; }
#pragma unroll
            for (int sb = 0; sb < 2; ++sb) if (sb <= tb) {
#pragma unroll
                for (int s16 = 0; s16 < 2; ++s16) { const LAS unsigned char* vp = Vl + (vq * 2 + vt) * 4096 + (sb * 32 + s16 * 16) * 64 + troff;
                    const bf16x8 vf = cat8(tr16(vp), tr16(vp + 8 * 64)); ia = MFMA32(vf, pack8(sacc[sb], s16), ia); } }
            const bf16* cb = STATE + ((size_t)(c * 4 + h) * 256 + vq * 64 + vt * 32 + r32) * 128 + hi * 8;
#pragma unroll
            for (int kk = 0; kk < 8; ++kk) { const bf16x8 cf = *(const bf16x8*)(cb + kk * 16); xa = MFMA32(cf, qf[kk], xa); }
#pragma unroll
            for (int r = 0; r < 16; ++r) { const float hv = (ia[r] + e_t * xa[r]) * dinv; hacc[vt][r] = hv; ss += hv * hv; }
        }
        ss += __shfl_xor(ss, 32);
        if (hi == 0) red[(tb * 4 + vq) * 32 + r32] = ss;
        __syncthreads();
        const float tot = (red[(tb * 4 + 0) * 32 + r32] + red[(tb * 4 + 1) * 32 + r32]) + (red[(tb * 4 + 2) * 32 + r32] + red[(tb * 4 + 3) * 32 + r32]);
        const float rn = rsqrtf(tot * (1.f / 256.f) + RMS_EPS);
        const size_t row = (size_t)(c * 64 + t);
#pragma unroll
        for (int vt = 0; vt < 2; ++vt)
#pragma unroll
            for (int gq = 0; gq < 4; ++gq) { const int v0 = h * 256 + vq * 64 + vt * 32 + 8 * gq + 4 * hi;
                const f32x4 gn = *(const f32x4*)(hnorm + v0); const u32x2 ow = *(const u32x2*)(PROJ + row * 3072 + 2048 + v0);
                const float o0 = bflo(ow.x), o1 = bfhi(ow.x), o2 = bflo(ow.y), o3 = bfhi(ow.y);
                const float y0 = hacc[vt][4 * gq] * rn * gn.x / (1.f + expf(-o0)), y1 = hacc[vt][4 * gq + 1] * rn * gn.y / (1.f + expf(-o1));
                const float y2 = hacc[vt][4 * gq + 2] * rn * gn.z / (1.f + expf(-o2)), y3 = hacc[vt][4 * gq + 3] * rn * gn.w / (1.f + expf(-o3));
                u32x2 w; w.x = cvtpk(y0, y1); w.y = cvtpk(y2, y3); *(u32x2*)(HG + row * D + v0) = w; }
        __syncthreads();
    }
}


constexpr int NSC = 64;
constexpr int GA_OFF = 132096;
__device__ __forceinline__ void sc_gates(const float* GATES, int sc, int h, int lane, LAS float* bcum, LAS float* aval, LAS float* amc, float& btot, float& amax) {
    float lf[4], ig[4];
#pragma unroll
    for (int j = 0; j < 4; ++j) { const size_t row = (size_t)sc * 256 + 4 * lane + j; lf[j] = GATES[row * 8 + 4 + h]; ig[j] = GATES[row * 8 + h]; }
    float b[4]; b[0] = lf[0]; b[1] = b[0] + lf[1]; b[2] = b[1] + lf[2]; b[3] = b[2] + lf[3];
    float inc = b[3];
#pragma unroll
    for (int o = 1; o < 64; o <<= 1) { const float t = __shfl_up(inc, o); if (lane >= o) inc += t; }
    const float excl = inc - b[3];
    float a[4], cm[4];
#pragma unroll
    for (int j = 0; j < 4; ++j) { b[j] += excl; a[j] = ig[j] - b[j]; }
    cm[0] = a[0]; cm[1] = fmaxf(cm[0], a[1]); cm[2] = fmaxf(cm[1], a[2]); cm[3] = fmaxf(cm[2], a[3]);
    float inc2 = cm[3];
#pragma unroll
    for (int o = 1; o < 64; o <<= 1) { const float t = __shfl_up(inc2, o); if (lane >= o) inc2 = fmaxf(inc2, t); }
    float prev = __shfl_up(inc2, 1); if (lane == 0) prev = -INFINITY;
#pragma unroll
    for (int j = 0; j < 4; ++j) cm[j] = fmaxf(cm[j], prev);
    *(LAS f32x4*)(bcum + 4 * lane) = (f32x4){b[0], b[1], b[2], b[3]};
    *(LAS f32x4*)(aval + 4 * lane) = (f32x4){a[0], a[1], a[2], a[3]};
    *(LAS f32x4*)(amc + 4 * lane) = (f32x4){cm[0], cm[1], cm[2], cm[3]};
    btot = __shfl(inc, 63); amax = __shfl(inc2, 63);
}

__device__ __forceinline__ void ml_local256(Frame& F, const bf16* PROJ, const float* GATES, bf16* STATE, float* NST, float* CH) {
    LAUNDER_TID(F);
    LAS unsigned char* Kl = F.lds + RING_OFF;
    LAS unsigned char* Vl = Kl + 16384;
    LAS float* bcum = (LAS float*)(F.lds + GA_OFF); LAS float* aval = bcum + 256; LAS float* amc = aval + 256; LAS float* wsv = amc + 256;
    const int lane = F.lane, r32 = lane & 31, hi = lane >> 5;
    for (int unit = F.vcu; unit < NSC * 4; unit += F.G) {
        const int sc = unit >> 2, h = unit & 3;
        const bf16* kb = PROJ + (size_t)(sc * 256) * 3072 + 512 + h * 128;
        const bf16* vb = PROJ + (size_t)(sc * 256) * 3072 + 1024 + h * 256;
        v4u kreg[2], vreg[4];
#define ML_LOAD(j) do { _Pragma("unroll") for (int i = 0; i < 2; ++i) { const int p = F.tid + 512 * i, s = p >> 4, cc = p & 15; kreg[i] = *(const v4u*)(kb + (size_t)((j) * 64 + s) * 3072 + cc * 8); } \
                        _Pragma("unroll") for (int i = 0; i < 4; ++i) { const int p = F.tid + 512 * i, s = p >> 5, cc = p & 31; vreg[i] = *(const v4u*)(vb + (size_t)((j) * 64 + s) * 3072 + cc * 8); } } while (0)
        ML_LOAD(0);
        if (F.tid < 64) {
            float btot, amax; sc_gates(GATES, sc, h, lane, bcum, aval, amc, btot, amax);
            const float mloc = btot + amax; const f32x4 a4 = *(const LAS f32x4*)(aval + 4 * lane);
            *(LAS f32x4*)(wsv + 4 * lane) = (f32x4){expf(btot + a4.x - mloc), expf(btot + a4.y - mloc), expf(btot + a4.z - mloc), expf(btot + a4.w - mloc)};
            if (lane == 0) { CH[(sc * 4 + h) * 2] = btot; CH[(sc * 4 + h) * 2 + 1] = mloc; }
        }
        f32x16 acc[4];
#pragma unroll
        for (int dt = 0; dt < 4; ++dt)
#pragma unroll
            for (int r = 0; r < 16; ++r) acc[dt][r] = 0.f;
        float nsum = 0.f;
        const int troff = (4 * hi + ((lane & 15) >> 2)) * 64 + ((lane >> 4) & 1) * 32 + (lane & 3) * 8;
        __syncthreads();
#pragma unroll 1
        for (int j = 0; j < 4; ++j) {
#pragma unroll
            for (int i = 0; i < 2; ++i) { const int p = F.tid + 512 * i, s = p >> 4, cc = p & 15; const v4u kk = kreg[i]; const float w = wsv[j * 64 + s];
                v4u o; o.x = pk2(bflo(kk.x) * w, bfhi(kk.x) * w); o.y = pk2(bflo(kk.y) * w, bfhi(kk.y) * w); o.z = pk2(bflo(kk.z) * w, bfhi(kk.z) * w); o.w = pk2(bflo(kk.w) * w, bfhi(kk.w) * w);
                *(LAS v4u*)(Kl + (cc >> 2) * 4096 + s * 64 + (cc & 3) * 16) = o; }
#pragma unroll
            for (int i = 0; i < 4; ++i) { const int p = F.tid + 512 * i, s = p >> 5, cc = p & 31; *(LAS v4u*)(Vl + (cc >> 2) * 4096 + s * 64 + (cc & 3) * 16) = vreg[i]; }
            if (j < 3) ML_LOAD(j + 1);
            __syncthreads();
#pragma unroll
            for (int ks = 0; ks < 4; ++ks) {
                const LAS unsigned char* vp = Vl + F.wave * 4096 + ks * 16 * 64 + troff;
                const bf16x8 vf = cat8(tr16(vp), tr16(vp + 8 * 64));
#pragma unroll
                for (int dt = 0; dt < 4; ++dt) { const LAS unsigned char* kp = Kl + dt * 4096 + ks * 16 * 64 + troff;
                    const bf16x8 kf = cat8(tr16(kp), tr16(kp + 8 * 64)); acc[dt] = MFMA32(kf, vf, acc[dt]); }
            }
            if (F.tid >= 384) { const int d = F.tid - 384; const LAS unsigned short* kc = (const LAS unsigned short*)(Kl + (d >> 5) * 4096 + (d & 31) * 2);
#pragma unroll 16
                for (int s = 0; s < 64; ++s) nsum += bf2f(kc[s * 32]); }
            __syncthreads();
        }
#undef ML_LOAD
        bf16* st = STATE + ((size_t)(sc * 4 + h) * 256 + F.wave * 32 + r32) * 128 + 4 * hi;
#pragma unroll
        for (int dt = 0; dt < 4; ++dt)
#pragma unroll
            for (int gq = 0; gq < 4; ++gq) { u32x2 w; w.x = cvtpk(acc[dt][4 * gq], acc[dt][4 * gq + 1]); w.y = cvtpk(acc[dt][4 * gq + 2], acc[dt][4 * gq + 3]); *(u32x2*)(st + 32 * dt + 8 * gq) = w; }
        if (F.tid >= 384) NST[(size_t)(sc * 4 + h) * 128 + F.tid - 384] = nsum;
    }
}

__device__ __forceinline__ void ml_scan256(Frame& F, bf16* STATE, float* NST, const float* CH, float* MS, bf16* DST, float* NDST) {
    LAUNDER_TID(F);
    LAS float* f1 = (LAS float*)(F.lds + RING_OFF); LAS float* f2 = f1 + 64;
    const int h = F.vcu >> 6;
    if (F.tid < 64) {
        const int c = F.lane; const float bt = CH[(c * 4 + h) * 2], ml = CH[(c * 4 + h) * 2 + 1];
        float B = bt, Mx = ml;
#pragma unroll
        for (int o = 1; o < 64; o <<= 1) { const float Bp = __shfl_up(B, o), Mp = __shfl_up(Mx, o); if (F.lane >= o) { Mx = fmaxf(Mp + B, Mx); B = Bp + B; } }
        const float Bq = __shfl_up(B, 1), Mq = __shfl_up(Mx, 1);
        const float m = (F.lane == 0) ? 0.f : fmaxf(Bq, Mq);
        const float mn = fmaxf(bt + m, ml);
        f1[c] = expf(bt + m - mn); f2[c] = expf(ml - mn);
        if ((F.vcu & 63) == 0) MS[c * 4 + h] = m;
    }
    __syncthreads();
    if (F.tid < 256) {
        unsigned* base = (unsigned*)(STATE + (size_t)h * 32768) + ((F.vcu & 63) * 256 + F.tid);
        unsigned* dbase = (unsigned*)(DST + (size_t)h * 32768) + ((F.vcu & 63) * 256 + F.tid);
        float c0v = 0.f, c1v = 0.f;
#pragma unroll 1
        for (int cb = 0; cb < NSC; cb += 32) {
            unsigned u[32];
#pragma unroll
            for (int j = 0; j < 32; ++j) u[j] = base[(size_t)(cb + j) * 65536];
#pragma unroll
            for (int j = 0; j < 32; ++j) { const float a = f1[cb + j], b = f2[cb + j];
                dbase[(size_t)(cb + j) * 65536] = pg8::cvt_pk_bf16(c0v, c1v);
                c0v = a * c0v + b * bflo(u[j]); c1v = a * c1v + b * bfhi(u[j]); }
        }
    } else if ((F.vcu & 63) == 0 && F.tid < 384) {
        float* base = NST + h * 128 + (F.tid - 256); float* dbase = NDST + h * 128 + (F.tid - 256); float nv = 0.f;
#pragma unroll 1
        for (int cb = 0; cb < NSC; cb += 16) {
            float u[16];
#pragma unroll
            for (int j = 0; j < 16; ++j) u[j] = base[(size_t)(cb + j) * 512];
#pragma unroll
            for (int j = 0; j < 16; ++j) { dbase[(size_t)(cb + j) * 512] = nv; nv = f1[cb + j] * nv + f2[cb + j] * u[j]; }
        }
    }
    __syncthreads();
}

__device__ __forceinline__ float fexp(float x) { return __builtin_amdgcn_exp2f(x * LOG2E); }
__device__ __forceinline__ void ml_out256(Frame& F, const bf16* PROJ, const float* GATES, const bf16* STATE, const float* NST, const float* MS, const float* hnorm, bf16* HG) {
    LAUNDER_TID(F);
    LAS unsigned char* Vl = F.lds + RING_OFF;
    LAS float* bcum = (LAS float*)(F.lds + GA_OFF); LAS float* aval = bcum + 256; LAS float* amc = aval + 256; LAS float* nst = amc + 256;
    const int lane = F.lane, r32 = lane & 31, hi = lane >> 5, w = F.wave;
    for (int unit = F.vcu; unit < NSC * 4; unit += F.G) {
        const int sc = unit >> 2, h = unit & 3;
        const float mc = MS[sc * 4 + h];
        const bf16* qb = PROJ + (size_t)(sc * 256) * 3072 + h * 128;
        const bf16* kb = PROJ + (size_t)(sc * 256) * 3072 + 512 + h * 128;
        const bf16* vb = PROJ + (size_t)(sc * 256) * 3072 + 1024 + h * 256;
#pragma unroll
        for (int half = 0; half < 2; ++half) { v4u vr[8];
#pragma unroll
            for (int i = 0; i < 8; ++i) { const int p = F.tid + 512 * (half * 8 + i), s = p >> 5, cc = p & 31; vr[i] = *(const v4u*)(vb + (size_t)s * 3072 + cc * 8); }
#pragma unroll
            for (int i = 0; i < 8; ++i) { const int p = F.tid + 512 * (half * 8 + i), s = p >> 5, cc = p & 31; *(LAS v4u*)(Vl + (cc >> 2) * 16384 + s * 64 + (cc & 3) * 16) = vr[i]; } }
        asm volatile("" ::: "memory");
        if (F.tid < 64) { float btot, amax; sc_gates(GATES, sc, h, lane, bcum, aval, amc, btot, amax); }
        if (F.tid >= 64 && F.tid < 192) nst[F.tid - 64] = NST[(size_t)(sc * 4 + h) * 128 + F.tid - 64];
        asm volatile("" ::: "memory");
        const int t = w * 32 + r32;
        bf16x8 qf[8];
#pragma unroll
        for (int kk = 0; kk < 8; ++kk) qf[kk] = *(const bf16x8*)(qb + (size_t)t * 3072 + kk * 16 + hi * 8);
        __syncthreads();
        const float b_t = bcum[t], m_t = b_t + fmaxf(mc, amc[t]), e_t = fexp(b_t + mc - m_t);
        float nq = 0.f;
#pragma unroll
        for (int kk = 0; kk < 8; ++kk) { const v4u qw = __builtin_bit_cast(v4u, qf[kk]); const f32x4 n0 = *(const LAS f32x4*)(nst + kk * 16 + hi * 8), n1 = *(const LAS f32x4*)(nst + kk * 16 + hi * 8 + 4);
            nq += (bflo(qw.x) * n0.x + bfhi(qw.x) * n0.y) + (bflo(qw.y) * n0.z + bfhi(qw.y) * n0.w) + (bflo(qw.z) * n1.x + bfhi(qw.z) * n1.y) + (bflo(qw.w) * n1.z + bfhi(qw.w) * n1.w); }
        nq += __shfl_xor(nq, 32);
        const int troff = (4 * hi + ((lane & 15) >> 2)) * 64 + ((lane >> 4) & 1) * 32 + (lane & 3) * 8;
        const size_t row = (size_t)(sc * 256 + t);
        float ss = 0.f, dinv = 0.f;
#pragma unroll 1
        for (int vh = 0; vh < 2; ++vh) {
            f32x16 acc[4];
#pragma unroll
            for (int i = 0; i < 4; ++i) { f32x16 xa;
#pragma unroll
                for (int r = 0; r < 16; ++r) xa[r] = 0.f;
                const bf16* cb = STATE + ((size_t)(sc * 4 + h) * 256 + (vh * 4 + i) * 32 + r32) * 128 + hi * 8;
#pragma unroll
                for (int kk = 0; kk < 8; ++kk) { const bf16x8 cf = *(const bf16x8*)(cb + kk * 16); xa = MFMA32(cf, qf[kk], xa); }
#pragma unroll
                for (int r = 0; r < 16; ++r) acc[i][r] = e_t * xa[r];
                asm volatile("" ::: "memory"); }
            float dsum = 0.f;
#pragma unroll 1
            for (int sb = 0; sb <= w; ++sb) {
                f32x16 st;
#pragma unroll
                for (int r = 0; r < 16; ++r) st[r] = 0.f;
#pragma unroll
                for (int kk = 0; kk < 8; ++kk) { const bf16x8 kf = *(const bf16x8*)(kb + (size_t)(sb * 32 + r32) * 3072 + kk * 16 + hi * 8); st = MFMA32(kf, qf[kk], st); }
#pragma unroll
                for (int gq = 0; gq < 4; ++gq) { const f32x4 a4 = *(const LAS f32x4*)(aval + sb * 32 + 8 * gq + 4 * hi);
#pragma unroll
                    for (int i = 0; i < 4; ++i) { const int r = 4 * gq + i, cr = 8 * gq + 4 * hi + i; const bool valid = (sb < w) || (cr <= r32);
                        const float wg = valid ? st[r] * fexp(b_t + a4[i] - m_t) : 0.f; st[r] = wg; dsum += wg; } }
                const bf16x8 pf0 = pack8(st, 0), pf1 = pack8(st, 1);
#pragma unroll
                for (int i = 0; i < 4; ++i) { const LAS unsigned char* vp = Vl + (vh * 4 + i) * 16384 + (sb * 32) * 64 + troff;
                    const bf16x8 vf0 = cat8(tr16(vp), tr16(vp + 8 * 64)), vf1 = cat8(tr16(vp + 16 * 64), tr16(vp + 24 * 64));
                    acc[i] = MFMA32(vf0, pf0, acc[i]); acc[i] = MFMA32(vf1, pf1, acc[i]); }
            }
            if (vh == 0) { dsum += __shfl_xor(dsum, 32); dinv = 1.f / fmaxf(fabsf(dsum + e_t * nq), fexp(-m_t)); }
#pragma unroll
            for (int i = 0; i < 4; ++i)
#pragma unroll
                for (int gq = 0; gq < 4; ++gq) { const float h0 = acc[i][4 * gq] * dinv, h1 = acc[i][4 * gq + 1] * dinv, h2 = acc[i][4 * gq + 2] * dinv, h3 = acc[i][4 * gq + 3] * dinv;
                    ss += (h0 * h0 + h1 * h1) + (h2 * h2 + h3 * h3); u32x2 wv; wv.x = cvtpk(h0, h1); wv.y = cvtpk(h2, h3);
                    *(u32x2*)(HG + row * D + h * 256 + (vh * 4 + i) * 32 + 8 * gq + 4 * hi) = wv; }
        }
        ss += __shfl_xor(ss, 32);
        const float rn = rsqrtf(ss * (1.f / 256.f) + RMS_EPS);
#pragma unroll 1
        for (int vi = 0; vi < 8; ++vi)
#pragma unroll
                for (int gq = 0; gq < 4; ++gq) { const int v0 = h * 256 + vi * 32 + 8 * gq + 4 * hi;
                    const f32x4 gn = *(const f32x4*)(hnorm + v0); const u32x2 ow = *(const u32x2*)(PROJ + row * 3072 + 2048 + v0);
                    const u32x2 hp = *(const u32x2*)(HG + row * D + v0); const unsigned p0 = hp.x, p1 = hp.y;
                    const float y0 = bflo(p0) * rn * gn.x * __builtin_amdgcn_rcpf(1.f + fexp(-bflo(ow.x))), y1 = bfhi(p0) * rn * gn.y * __builtin_amdgcn_rcpf(1.f + fexp(-bfhi(ow.x)));
                    const float y2 = bflo(p1) * rn * gn.z * __builtin_amdgcn_rcpf(1.f + fexp(-bflo(ow.y))), y3 = bfhi(p1) * rn * gn.w * __builtin_amdgcn_rcpf(1.f + fexp(-bfhi(ow.y)));
                    u32x2 wv; wv.x = cvtpk(y0, y1); wv.y = cvtpk(y2, y3); *(u32x2*)(HG + row * D + v0) = wv;
                    if (gq == 3) asm volatile("" ::: "memory"); }
        __syncthreads();
    }
}

#ifndef ML256
#define ML256 1
#endif
#ifndef OVERLAP_CONV
#define OVERLAP_CONV 1
#endif
#ifndef XP_EPI
#define XP_EPI 0
#endif
#ifndef XP_PRO
#define XP_PRO 0
#endif
#ifndef XP_GEMM
#define XP_GEMM 0
#endif
#ifndef XP_ML
#define XP_ML 0
#endif
#ifndef XP_ATTN
#define XP_ATTN 0
#endif
#ifndef XP_GATES
#define XP_GATES 0
#endif
#ifndef XP_RES
#define XP_RES 0
#endif
#ifndef XP_SCAN
#define XP_SCAN 0
#endif
#ifndef XP_BAR
#define XP_BAR 0
#endif
#ifndef ATTN_MFMA
#define ATTN_MFMA 1
#endif
#ifndef MLL_MFMA
#define MLL_MFMA 1
#endif
#ifndef MLO_MFMA
#define MLO_MFMA 1
#endif
#ifndef PG8_SP2
#define PG8_SP2 true
#endif
#ifndef PG8_ALIGN
#define PG8_ALIGN true
#endif
__global__ void __launch_bounds__(NWAVES * 64, 2) yoco_fwd(Args args) {
    extern __shared__ __attribute__((aligned(16))) unsigned char lds[];
    Frame F;
    F.lds = (LAS unsigned char*)lds;
    F.MISC = (volatile LAS unsigned*)(F.lds + MISC_OFF);
    F.tid = threadIdx.x; F.lane = F.tid & 63; F.wave = __builtin_amdgcn_readfirstlane(F.tid >> 6);
    F.G = gridDim.x; { const int bx = blockIdx.x; F.vcu = (F.G % 8 == 0) ? (bx % 8) * (F.G / 8) + bx / 8 : bx; }
    F.ctl = (gu32*)(args.ws + WS_CTL);
    for (int u = F.tid; u < (LDS_BYTES - LDSCTL_OFF) / 4; u += NWAVES * 64) ((LAS unsigned*)(F.lds + LDSCTL_OFF))[u] = 0u;
    __syncthreads();
    unsigned bar_x; { XcdBarrier bar = xcd_barrier_post((unsigned*)(F.ctl + CW_BAR), F.MISC + 8); bar_x = __builtin_amdgcn_readfirstlane(bar.x); }
#define GRID_BAR() do { XcdBarrier b_; b_.bar = (unsigned*)(arg_ws() + WS_CTL) + CW_BAR; b_.x = bar_x; b_.st = (volatile LAS unsigned*)(F.lds + MISC_OFF) + 8; asm volatile("" : "+s"(b_.x)); xcd_barrier(b_); } while (0)

    for (int rep = 0; rep <= XP_PRO; ++rep) p0_prologue(F, args, OVERLAP_CONV ? 1 : 4);
    GRID_BAR();
    for (int rep = 0; rep < XP_BAR; ++rep) GRID_BAR();

#pragma unroll 1
    for (int l = 0; l < 4; ++l) {
        if (l < 2) {
            {
                pg8::Gemm g{WSP(const bf16, WS_XB), WSP(const bf16, WS_WIN) + (size_t)l * 3072 * D, M, 3072, D}; pg8::StaticOrder S; S.init(M, 3072, F.G, (int)blockIdx.x);
                EpiProj E{WSP(bf16, WS_PROJ), 3072, nullptr, 3072, 0, nullptr, WSP(const float, WS_SSP)};
                for (int rep = 0; rep <= XP_GEMM; ++rep) pg8::gemm_phase<EpiProj, pg8::StaticOrder, PG8_ALIGN, PG8_SP2>(F.lds + RING_OFF, g, S, E);
                for (int rep = 0; rep <= XP_GATES; ++rep) gates_phase(F, WSP(const bf16, WS_XB), WSP(const float, WS_SSP), WSP(const float, WS_WGT) + l * 8 * 1024, arg_in(3) + l * 8, WSP(float, WS_GATES));
            }
            GRID_BAR();
            for (int rep = 0; rep <= XP_ML; ++rep) ml_local256(F, WSP(const bf16, WS_PROJ), WSP(const float, WS_GATES), WSP(bf16, WS_STATE), WSP(float, WS_NST), WSP(float, WS_CH));
            GRID_BAR();
            for (int rep = 0; rep < XP_SCAN; ++rep) ml_scan256(F, WSP(bf16, WS_STATE), WSP(float, WS_NST), WSP(const float, WS_CH), WSP(float, WS_MS), WSP(bf16, WS_HG), (float*)(arg_ws() + WS_HG + 20 * MiB));
            ml_scan256(F, WSP(bf16, WS_STATE), WSP(float, WS_NST), WSP(const float, WS_CH), WSP(float, WS_MS), WSP(bf16, WS_STATE), WSP(float, WS_NST));
            GRID_BAR();
            for (int rep = 0; rep <= XP_ML; ++rep) ml_out256(F, WSP(const bf16, WS_PROJ), WSP(const float, WS_GATES), WSP(const bf16, WS_STATE), WSP(const float, WS_NST), WSP(const float, WS_MS), arg_in(4) + l * D, WSP(bf16, WS_HG));
            GRID_BAR();
            {
                pg8::Gemm g{WSP(const bf16, WS_HG), WSP(const bf16, WS_WOUT) + (size_t)l * D * D, M, D, D}; pg8::StaticOrder S; S.init(M, D, F.G, (int)blockIdx.x);
                for (int rep = 0; rep < XP_RES; ++rep) { EpiResid E0{(l == 0) ? arg_in(0) : nullptr, WSP(const bf16, WS_XB), WSP(bf16, WS_PROJ), nullptr, WSP(float, WS_GATES)}; pg8::gemm_phase<EpiResid, pg8::StaticOrder, false, PG8_SP2>(F.lds + RING_OFF, g, S, E0); }
                EpiResid E{(l == 0) ? arg_in(0) : nullptr, WSP(const bf16, WS_XB), WSP(bf16, WS_XB), nullptr, WSP(float, WS_SSP)};
                pg8::gemm_phase<EpiResid, pg8::StaticOrder, false, PG8_SP2>(F.lds + RING_OFF, g, S, E);
            }
            GRID_BAR();
        } else {
            const int j = l - 2;
            {
                const int N = (j == 0) ? 1280 : 1024;
                pg8::Gemm g{WSP(const bf16, WS_XB), (const bf16*)(arg_ws() + (j == 0 ? WS_WQ2 : WS_WQ3)), M, N, D}; pg8::StaticOrder S; S.init(M, N, F.G, (int)blockIdx.x);
                EpiProj E{WSP(bf16, WS_PROJ), D, WSP(bf16, WS_KV), 256, 1024, WSP(const float, WS_BQ) + j * 1280, WSP(const float, WS_SSP)};
                for (int rep = 0; rep <= XP_GEMM; ++rep) pg8::gemm_phase<EpiProj, pg8::StaticOrder, PG8_ALIGN, PG8_SP2>(F.lds + RING_OFF, g, S, E);
            }
            GRID_BAR();
            for (int rep = 0; rep <= XP_ATTN; ++rep) attn_phase_mfma(F, WSP(const bf16, WS_PROJ), WSP(const bf16, WS_KV), arg_in(12) + j * 16, WSP(bf16, WS_HG));
            GRID_BAR();
            {
                pg8::Gemm g{WSP(const bf16, WS_HG), WSP(const bf16, WS_WBO) + (size_t)j * D * D, M, D, D}; pg8::StaticOrder S; S.init(M, D, F.G, (int)blockIdx.x);
                for (int rep = 0; rep < XP_RES; ++rep) { EpiResid E0{nullptr, WSP(const bf16, WS_XB), WSP(bf16, WS_PROJ), arg_in(14) + j * D, WSP(float, WS_GATES)}; pg8::gemm_phase<EpiResid, pg8::StaticOrder, false, PG8_SP2>(F.lds + RING_OFF, g, S, E0); }
                EpiResid E{nullptr, WSP(const bf16, WS_XB), WSP(bf16, WS_XB), arg_in(14) + j * D, WSP(float, WS_SSP)};
                pg8::gemm_phase<EpiResid, pg8::StaticOrder, false, PG8_SP2>(F.lds + RING_OFF, g, S, E);
            }
            GRID_BAR();
        }
        {
            pg8::Gemm g{WSP(const bf16, WS_XB), WSP(const bf16, WS_WGU) + (size_t)l * 2 * DFF * D, M, 2 * DFF, D}; pg8::StaticOrder S; S.init(M, 2 * DFF, F.G, (int)blockIdx.x);
            EpiSwiglu E{WSP(bf16, WS_PROJ), WSP(const float, WS_SSP)};
            for (int rep = 0; rep <= XP_GEMM; ++rep) pg8::gemm_phase<EpiSwiglu, pg8::StaticOrder, PG8_ALIGN, PG8_SP2>(F.lds + RING_OFF, g, S, E);
        }
#if OVERLAP_CONV
        if (l < 3 && blockIdx.x >= 128) conv_layer(F, l + 1, ((int)blockIdx.x - 128) * NWAVES + F.wave, 128 * NWAVES);
#endif
        GRID_BAR();
        {
            pg8::Gemm g{WSP(const bf16, WS_PROJ), WSP(const bf16, WS_WD) + (size_t)l * D * DFF, M, D, DFF}; pg8::StaticOrder S; S.init(M, D, F.G, (int)blockIdx.x);
            for (int rep = 0; rep < XP_RES; ++rep) { EpiResid E0{nullptr, WSP(const bf16, WS_XB), WSP(bf16, WS_HG), nullptr, WSP(float, WS_GATES)}; pg8::gemm_phase<EpiResid, pg8::StaticOrder, false, PG8_SP2>(F.lds + RING_OFF, g, S, E0); }
            EpiResid E{nullptr, WSP(const bf16, WS_XB), WSP(bf16, WS_XB), nullptr, WSP(float, WS_SSP)};
            pg8::gemm_phase<EpiResid, pg8::StaticOrder, false, PG8_SP2>(F.lds + RING_OFF, g, S, E);
        }
        GRID_BAR();
    }
    final_norm_phase(F, arg_out(), WSP(const bf16, WS_XB), WSP(const float, WS_SSP), arg_in(18));
}

extern "C" void kernel_launch(void* const* d_in, const int* in_sizes, int n_in, void* d_out, int out_size, void* d_ws, size_t ws_size, hipStream_t stream) {
    static int grid = 0;
    if (grid == 0) {
        if (n_in != 19 || in_sizes[0] != M * D || out_size != M * D || ws_size < WS_END) { fprintf(stderr, "kernel_launch: unexpected shapes / workspace (n_in %d, ws %zu < %zu)\n", n_in, ws_size, (size_t)WS_END); grid = -1; return; }
        int dev = 0, cus = 0, per_cu = 0;
        if (hipGetDevice(&dev) != hipSuccess || hipDeviceGetAttribute(&cus, hipDeviceAttributeMultiprocessorCount, dev) != hipSuccess) { grid = -1; return; }
        if (hipFuncSetAttribute((const void*)yoco_fwd, hipFuncAttributeMaxDynamicSharedMemorySize, LDS_BYTES) != hipSuccess) { fprintf(stderr, "kernel_launch: hipFuncSetAttribute failed\n"); grid = -1; return; }
        if (hipOccupancyMaxActiveBlocksPerMultiprocessor(&per_cu, (const void*)yoco_fwd, NWAVES * 64, LDS_BYTES) != hipSuccess || per_cu < 1) { fprintf(stderr, "kernel_launch: occupancy query says %d blocks per CU\n", per_cu); (void)hipGetLastError(); grid = -1; return; }
        grid = cus;
        if (grid != 256) fprintf(stderr, "kernel_launch: %d CUs; this kernel is laid out for 256\n", grid);
    }
    if (grid < 0) return;
    if (hipMemsetAsync((char*)d_ws + WS_CTL, 0, CTL_ZERO_BYTES, stream) != hipSuccess) return;
    Args a{};
    for (int i = 0; i < 19; ++i) a.in[i] = (const float*)d_in[i];
    a.out = (float*)d_out; a.ws = (unsigned char*)d_ws;
    hipLaunchKernelGGL(yoco_fwd, dim3(grid), dim3(NWAVES * 64), LDS_BYTES, stream, a);
}
```

```cpp
#include <hip/hip_runtime.h>
#include <cstdio>
#include <cstdint>
#include <cmath>
namespace pg8 {
#define PG8_LAS __attribute__((address_space(3)))
typedef unsigned short bf16_t;
typedef short bf16x8 __attribute__((ext_vector_type(8)));
typedef float f32x4 __attribute__((ext_vector_type(4)));
typedef unsigned u32x4 __attribute__((ext_vector_type(4)));
constexpr int BM = 256, BK = 64, HALF = 128, HTB = HALF * BK * 2  , STAGE_BYTES = 8 * HTB, NXCD = 8, WGM = 8;

__host__ __device__ __forceinline__ int lds_byte(int r, int c) { const int st = (r >> 4) * 2 + (c >> 5), rr = r & 15, cc = c & 31, ob = rr * 64 + cc * 2; return st * 1024 + (ob ^ (((ob >> 9) & 1) << 5)); }
__host__ __device__ __forceinline__ void stage_rc(int b, int& R, int& C) { const int st = b / 1024, sb = b % 1024, swz = sb ^ (((sb >> 9) & 1) << 5); R = (st >> 1) * 16 + swz / 64; C = (st & 1) * 32 + (swz % 64) / 2; }
__host__ __device__ __forceinline__ int perm32(int rho) { const int n = rho >> 4, i = rho & 15; return 8 * (i >> 2) + 4 * n + (i & 3); }

struct Unit { int pm, pn; };
struct Gemm { const bf16_t* A; const bf16_t* Bt; int M, N, K; };

struct StaticOrder {
    int nM, nN, nwg, G, c;
    __host__ __device__ void init(int M, int N, int G_, int c_) { nM = M / BM; nN = N / BM; nwg = nM * nN; G = G_; c = c_; }
    __host__ __device__ bool next(int i, Unit& u) const {
        const long L = (long)i * G + c; if (L >= nwg) return false;
        int wgid = (int)L; { const int q = nwg / NXCD, r = nwg % NXCD, xcd = wgid % NXCD, off = wgid / NXCD; wgid = (xcd < r ? xcd * (q + 1) : r * (q + 1) + (xcd - r) * q) + off; }
        const int nig = WGM * nN, gid = wgid / nig, fm = gid * WGM, gsz = (nM - fm) < WGM ? (nM - fm) : WGM;
        u.pm = fm + ((wgid % nig) % gsz); u.pn = (wgid % nig) / gsz; return true;
    }
    __device__ __forceinline__ void a_ready(const Unit&) const {}
    __device__ __forceinline__ void done(const Unit&) const {}
};

__device__ __forceinline__ unsigned cvt_pk_bf16(float lo, float hi) { unsigned r; asm volatile("v_cvt_pk_bf16_f32 %0, %1, %2" : "=v"(r) : "v"(lo), "v"(hi)); return r; }
typedef float f32x2 __attribute__((ext_vector_type(2)));
template <class Epi, class Sched, bool ALIGN_EPI = false, bool SP2 = false>
__device__ __forceinline__ void gemm_phase(PG8_LAS unsigned char* lds, const Gemm g, const Sched& S, const Epi& E) {
    int tid_ = (int)__builtin_amdgcn_mbcnt_hi(~0u, __builtin_amdgcn_mbcnt_lo(~0u, 0u)); asm volatile("" : "+v"(tid_)); tid_ += 64 * __builtin_amdgcn_readfirstlane((int)threadIdx.x >> 6);
    const int tid = tid_, wid = __builtin_amdgcn_readfirstlane(tid >> 6), lane = tid & 63, wr = wid >> 2, wc = wid & 3, fr = lane & 15, fq = lane >> 4;
    const int K = g.K, nt = K / BK;
    unsigned voffA[2], voffB[2];
#pragma unroll
    for (int i = 0; i < 2; ++i) { int R, C; stage_rc(tid * 16 + i * 8192, R, C); const int Rb = Epi::PERM ? ((R & ~31) + perm32(R & 31)) : R;
        voffA[i] = (unsigned)(R * K + C) * 2u; voffB[i] = (unsigned)(Rb * K + C) * 2u; }
    const size_t kstep = (size_t)(BK * 2);
    const size_t hstep = (size_t)HALF * K * 2;
    const size_t tstep = 2 * hstep;
    const unsigned ldsw = (unsigned)wid * 1024u;
    const int aoff = lds_byte(wr * 64 + fr, fq * 8), boff = lds_byte(wc * 32 + fr, fq * 8);
#define PG8_SA(b, h) (((b) * 2 + (h)) * HTB)
#define PG8_SB(b, h) ((4 + (b) * 2 + (h)) * HTB)
#define PG8_STAGE(bufoff, gbase, voff) do { _Pragma("unroll") for (int _i = 0; _i < 2; ++_i) \
        __builtin_amdgcn_global_load_lds((const unsigned*)((const char*)(gbase) + (voff)[_i]), (PG8_LAS unsigned*)(lds + (bufoff) + ldsw + _i * 8192), 16, 0, 0); } while (0)
#define PG8_LDA(dst, b, h) do { _Pragma("unroll") for (int m = 0; m < 4; ++m) _Pragma("unroll") for (int k = 0; k < 2; ++k) dst[m][k] = *(const PG8_LAS bf16x8*)(lds + PG8_SA(b, h) + aoff + m * 2048 + k * 1024); } while (0)
#define PG8_LDB(dst, b, h) do { _Pragma("unroll") for (int n = 0; n < 2; ++n) _Pragma("unroll") for (int k = 0; k < 2; ++k) dst[n][k] = *(const PG8_LAS bf16x8*)(lds + PG8_SB(b, h) + boff + n * 2048 + k * 1024); } while (0)
#define PG8_MMA(ai, bj, At, Bt) do { __builtin_amdgcn_s_setprio(1); _Pragma("unroll") for (int m = 0; m < 4; ++m) _Pragma("unroll") for (int n = 0; n < 2; ++n) _Pragma("unroll") for (int k = 0; k < 2; ++k) \
        acc[ai][bj][m][n] = __builtin_amdgcn_mfma_f32_16x16x32_bf16(Bt[n][k], At[m][k], acc[ai][bj][m][n], 0, 0, 0); __builtin_amdgcn_s_setprio(0); } while (0)
#define PG8_WAIT_V(n) asm volatile("s_waitcnt vmcnt(" #n ")" ::: "memory")
#define PG8_WAIT_L(n) asm volatile("s_waitcnt lgkmcnt(" #n ")" ::: "memory")
#define PG8_BAR __builtin_amdgcn_s_barrier()
#define PG8_SCHED __builtin_amdgcn_sched_barrier(0)
    Unit cur, nxt; int ui = 0;
    if (!S.next(0, cur)) return;
    f32x4 acc[2][2][4][2];
#pragma unroll
    for (int a = 0; a < 2; ++a)
#pragma unroll
        for (int b = 0; b < 2; ++b)
#pragma unroll
            for (int m = 0; m < 4; ++m)
#pragma unroll
                for (int n = 0; n < 2; ++n) acc[a][b][m][n] = (f32x4){0.f, 0.f, 0.f, 0.f};
    bf16x8 At[4][2], B0[2][2], B1[2][2];
    const char* cA = (const char*)g.A + (size_t)cur.pm * tstep; const char* cB = (const char*)g.Bt + (size_t)cur.pn * tstep;
    S.a_ready(cur);
    if constexpr (SP2) {
        PG8_STAGE(PG8_SB(0, 0), cB, voffB); PG8_STAGE(PG8_SB(0, 1), cB + hstep, voffB); PG8_STAGE(PG8_SA(0, 0), cA, voffA); PG8_STAGE(PG8_SA(0, 1), cA + hstep, voffA);
        if (wr == 1) PG8_BAR;
        PG8_WAIT_V(2); PG8_BAR;
        PG8_STAGE(PG8_SB(1, 0), cB + kstep, voffB); PG8_STAGE(PG8_SA(1, 0), cA + kstep, voffA); PG8_STAGE(PG8_SB(1, 1), cB + hstep + kstep, voffB);
        PG8_WAIT_V(6); PG8_BAR;
    } else {
        PG8_STAGE(PG8_SB(0, 0), cB, voffB); PG8_STAGE(PG8_SA(0, 0), cA, voffA); PG8_STAGE(PG8_SB(0, 1), cB + hstep, voffB); PG8_STAGE(PG8_SA(0, 1), cA + hstep, voffA);
        if (wr == 1) PG8_BAR;
        PG8_WAIT_V(4); PG8_BAR;
        PG8_STAGE(PG8_SB(1, 0), cB + kstep, voffB); PG8_STAGE(PG8_SA(1, 0), cA + kstep, voffA); PG8_STAGE(PG8_SB(1, 1), cB + hstep + kstep, voffB);
        PG8_WAIT_V(6); PG8_BAR;
    }
    for (;;) {
        const bool has_next = S.next(ui + 1, nxt);
        const char* nA = has_next ? (const char*)g.A + (size_t)nxt.pm * tstep : cA; const char* nB = has_next ? (const char*)g.Bt + (size_t)nxt.pn * tstep : cB;
        for (int t = 0; t < nt; t += 2) {
            const bool last = (t == nt - 2);
            const char* a1 = cA + (size_t)(t + 1) * kstep;
            const char* a2 = last ? nA : cA + (size_t)(t + 2) * kstep; const char* b2 = last ? nB : cB + (size_t)(t + 2) * kstep;
            const char* a3 = a2 + kstep; const char* b3 = b2 + kstep;
            if (last && has_next) S.a_ready(nxt);
            if constexpr (SP2) {
            PG8_LDB(B0, 0, 0); PG8_LDB(B1, 0, 1); PG8_SCHED; PG8_LDA(At, 0, 0); PG8_STAGE(PG8_SA(1, 1), a1 + hstep, voffA);
            PG8_WAIT_V(8); PG8_WAIT_L(0); PG8_BAR; PG8_MMA(0, 0, At, B0); PG8_MMA(0, 1, At, B1); PG8_BAR; PG8_SCHED;
            PG8_LDA(At, 0, 1); PG8_STAGE(PG8_SB(0, 0), b2, voffB); PG8_STAGE(PG8_SB(0, 1), b2 + hstep, voffB); PG8_STAGE(PG8_SA(0, 0), a2, voffA);
            PG8_WAIT_V(8); PG8_WAIT_L(0); PG8_BAR; PG8_MMA(1, 0, At, B0); PG8_MMA(1, 1, At, B1); PG8_BAR; PG8_SCHED;
            PG8_LDB(B0, 1, 0); PG8_LDB(B1, 1, 1); PG8_SCHED; PG8_LDA(At, 1, 0); PG8_STAGE(PG8_SA(0, 1), a2 + hstep, voffA);
            PG8_WAIT_V(8); PG8_WAIT_L(0); PG8_BAR; PG8_MMA(0, 0, At, B0); PG8_MMA(0, 1, At, B1); PG8_BAR; PG8_SCHED;
            PG8_LDA(At, 1, 1); PG8_STAGE(PG8_SB(1, 0), b3, voffB); PG8_STAGE(PG8_SB(1, 1), b3 + hstep, voffB); PG8_STAGE(PG8_SA(1, 0), a3, voffA);
            PG8_WAIT_V(8); PG8_WAIT_L(0); PG8_BAR; PG8_MMA(1, 0, At, B0); PG8_MMA(1, 1, At, B1); PG8_BAR; PG8_SCHED;
            } else {
            PG8_LDB(B0, 0, 0); PG8_SCHED; PG8_LDA(At, 0, 0); PG8_STAGE(PG8_SA(1, 1), a1 + hstep, voffA);
            PG8_WAIT_L(8); PG8_BAR; PG8_WAIT_L(0); PG8_MMA(0, 0, At, B0); PG8_BAR; PG8_SCHED;
            PG8_LDB(B1, 0, 1); PG8_STAGE(PG8_SB(0, 0), b2, voffB);
            PG8_BAR; PG8_WAIT_L(0); PG8_MMA(0, 1, At, B1); PG8_BAR;
            PG8_LDA(At, 0, 1); PG8_STAGE(PG8_SA(0, 0), a2, voffA);
            PG8_BAR; PG8_WAIT_L(0); PG8_MMA(1, 0, At, B0); PG8_BAR; PG8_SCHED;
            PG8_STAGE(PG8_SB(0, 1), b2 + hstep, voffB);
            PG8_WAIT_V(6); PG8_BAR; PG8_MMA(1, 1, At, B1); PG8_BAR;
            PG8_LDB(B0, 1, 0); PG8_SCHED; PG8_LDA(At, 1, 0); PG8_STAGE(PG8_SA(0, 1), a2 + hstep, voffA);
            PG8_WAIT_L(8); PG8_BAR; PG8_WAIT_L(0); PG8_MMA(0, 0, At, B0); PG8_BAR; PG8_SCHED;
            PG8_LDB(B1, 1, 1); PG8_STAGE(PG8_SB(1, 0), b3, voffB);
            PG8_BAR; PG8_WAIT_L(0); PG8_MMA(0, 1, At, B1); PG8_BAR;
            PG8_LDA(At, 1, 1); PG8_STAGE(PG8_SA(1, 0), a3, voffA);
            PG8_BAR; PG8_WAIT_L(0); PG8_MMA(1, 0, At, B0); PG8_BAR; PG8_SCHED;
            PG8_STAGE(PG8_SB(1, 1), b3 + hstep, voffB);
            PG8_WAIT_V(6); PG8_BAR; PG8_MMA(1, 1, At, B1); PG8_BAR;
            }
        }
        if constexpr (ALIGN_EPI) { if (wr == 0) PG8_BAR; }
        if constexpr (!Epi::AFTER_DRAIN) { E(acc, cur, wr, wc, fr, fq);
#if defined(XP_EPI) && XP_EPI
            asm volatile("" ::: "memory"); E(acc, cur, wr, wc, fr, fq);
#endif
            S.done(cur); }
        if (!has_next) break;
#pragma unroll
        for (int a = 0; a < 2; ++a)
#pragma unroll
            for (int b = 0; b < 2; ++b)
#pragma unroll
                for (int m = 0; m < 4; ++m)
#pragma unroll
                    for (int n = 0; n < 2; ++n) acc[a][b][m][n] = (f32x4){0.f, 0.f, 0.f, 0.f};
        cur = nxt; cA = nA; cB = nB; ++ui;
        if constexpr (ALIGN_EPI) { if (wr == 1) PG8_BAR; }
    }
    PG8_WAIT_V(0);
    if constexpr (!ALIGN_EPI) { if (wr == 0) PG8_BAR; }
    PG8_BAR;
    if constexpr (Epi::AFTER_DRAIN) { E.fused(acc, cur, wr, wc, fr, fq, lds, wid, lane); S.done(cur); }
#undef PG8_SA
#undef PG8_SB
#undef PG8_STAGE
#undef PG8_LDA
#undef PG8_LDB
#undef PG8_MMA
#undef PG8_WAIT_V
#undef PG8_WAIT_L
#undef PG8_BAR
#undef PG8_SCHED
}
}
#define GAS __attribute__((address_space(1)))
#define LAS __attribute__((address_space(3)))
typedef unsigned short bf16;
typedef unsigned v4u __attribute__((ext_vector_type(4)));
typedef float f32x4 __attribute__((ext_vector_type(4)));
typedef short bf16x8 __attribute__((ext_vector_type(8)));
typedef GAS unsigned gu32;
typedef GAS unsigned long long gu64;
#define RLX_AGENT __ATOMIC_RELAXED, __HIP_MEMORY_SCOPE_AGENT
#define LDS_WAIT() asm volatile("s_waitcnt lgkmcnt(0)" ::: "memory")
#define VM_WAIT() asm volatile("s_waitcnt vmcnt(0)" ::: "memory")
__device__ __forceinline__ unsigned long long rt() { return __builtin_amdgcn_s_memrealtime(); }
__device__ __forceinline__ unsigned f2bf(float f) { unsigned u = __builtin_bit_cast(unsigned, f); return (u + 0x7fffu + ((u >> 16) & 1u)) >> 16; }
__device__ __forceinline__ unsigned pk2(float lo, float hi) { return f2bf(lo) | (f2bf(hi) << 16); }

#define XB_TMO      128
#define XB_XCNT(j)  (256  + 64 * (j))
#define XB_XSUB(j)  (1280 + 64 * (j))
#define XB_XGEN(j)  (2304 + 64 * (j))
#define XB_TOP      3328
#define XB_TOPGEN   3392
#define XCD_BAR_WORDS 3456
#define XB_SPIN_CAP (1u << 18)

__device__ __forceinline__ unsigned xb_ld(unsigned* p)              { return __hip_atomic_load(p, __ATOMIC_RELAXED, __HIP_MEMORY_SCOPE_AGENT); }
__device__ __forceinline__ unsigned xb_add(unsigned* p, unsigned v) { return __hip_atomic_fetch_add(p, v, __ATOMIC_RELAXED, __HIP_MEMORY_SCOPE_AGENT); }
__device__ __forceinline__ unsigned xb_xcc_id() { return (unsigned)__builtin_amdgcn_s_getreg((3 << 11) | 20) & 0xFu; }
#define XB_SPIN(cond, bar) do { unsigned _sp = 0; while (cond) { __builtin_amdgcn_s_sleep(1); \
    if ((++_sp & 255u) == 0u) { if (xb_ld(&(bar)[XB_TMO])) break; if (_sp > XB_SPIN_CAP) { atomicAdd(&(bar)[XB_TMO], 1u); break; } } } } while (0)

struct XcdBarrier {
    unsigned* bar; unsigned x;
    volatile LAS unsigned* st;
};

__device__ __forceinline__ XcdBarrier xcd_barrier_post(unsigned* bar, volatile LAS unsigned* st) {
    XcdBarrier b; b.bar = bar; b.x = xb_xcc_id(); b.st = st;
    if (threadIdx.x == 0) (void)xb_add(&bar[XB_XCNT(b.x)], 1u);
    return b;
}
__device__ __forceinline__ void xcd_barrier_complete(unsigned* bar, unsigned x, unsigned& nloc, unsigned& nx) {
    const unsigned G = gridDim.x * gridDim.y * gridDim.z;
    unsigned sum, cnt, mine, sp = 0u;
    for (;;) {
        sum = 0u; cnt = 0u; mine = 0u;
#pragma unroll
        for (unsigned j = 0; j < 16; ++j) { const unsigned c = xb_ld(&bar[XB_XCNT(j)]); sum += c; cnt += (c > 0u) ? 1u : 0u; mine = (j == x) ? c : mine; }
        if (sum == G) break;
        __builtin_amdgcn_s_sleep(1);
        if ((++sp & 255u) == 0u) { if (xb_ld(&bar[XB_TMO])) break; if (sp > XB_SPIN_CAP) { atomicAdd(&bar[XB_TMO], 1u); break; } }
    }
    nloc = mine > 0u ? mine : 1u; nx = cnt > 0u ? cnt : 1u;
}

__device__ __forceinline__ void xcd_barrier(const XcdBarrier& b) {
    asm volatile("s_waitcnt vmcnt(0)" ::: "memory");
    __syncthreads();
    if (threadIdx.x == 0) {
        unsigned* bar = b.bar;
        __builtin_amdgcn_s_waitcnt(0);
        unsigned nloc = b.st[0], nx = b.st[1];
        if (nloc == 0u) { xcd_barrier_complete(bar, b.x, nloc, nx); b.st[0] = nloc; b.st[1] = nx; }
        const unsigned old = xb_add(&bar[XB_XSUB(b.x)], 1u);
        const unsigned gen = old / nloc;
        if (old + 1u == (gen + 1u) * nloc) {
            __builtin_amdgcn_fence(__ATOMIC_RELEASE, "agent");
            asm volatile("s_waitcnt vmcnt(0)" ::: "memory");
            const unsigned og = xb_add(&bar[XB_TOP], 1u);
            const unsigned tg = og / nx;
            if (og + 1u == (tg + 1u) * nx) xb_add(&bar[XB_TOPGEN], 1u);
            else XB_SPIN(xb_ld(&bar[XB_TOPGEN]) == tg, bar);
            __builtin_amdgcn_fence(__ATOMIC_ACQUIRE, "agent");
            xb_add(&bar[XB_XGEN(b.x)], 1u);
            asm volatile("s_waitcnt vmcnt(0)" ::: "memory");
        } else {
            XB_SPIN(xb_ld(&bar[XB_XGEN(b.x)]) == gen, bar);
            __builtin_amdgcn_fence(__ATOMIC_ACQUIRE, "agent");
            asm volatile("s_waitcnt vmcnt(0)" ::: "memory");
        }
    }
    __syncthreads();
}

constexpr int NWAVES = 8;
constexpr int M = 16384, D = 1024, DFF = 2816, INA = 3080, NC = 256;
constexpr float RMS_EPS = 1e-6f;
constexpr float LOG2E = 1.4426950408889634f;
constexpr float QSCALE_A = 0.08838834764831845f;
constexpr float C2 = 0.125f * LOG2E;

constexpr size_t MiB = 1u << 20;
constexpr size_t WS_CTL = 0, CTL_ZERO_BYTES = 1 * MiB;
constexpr size_t WS_SSP = 1 * MiB;
constexpr size_t WS_GATES = WS_SSP + 256 * 1024;
constexpr size_t WS_NST = 2 * MiB;
constexpr size_t WS_CH = WS_NST + 512 * 1024;
constexpr size_t WS_MS = WS_CH + 16 * 1024;
constexpr size_t WS_WGT = WS_MS + 16 * 1024;
constexpr size_t WS_BQ = WS_WGT + 64 * 1024;
constexpr size_t WS_WIN = 3 * MiB;
constexpr size_t WS_WOUT = 15 * MiB;
constexpr size_t WS_WQ2 = 19 * MiB;
constexpr size_t WS_WQ3 = WS_WQ2 + 1280 * 1024 * 2;
constexpr size_t WS_WBO = 24 * MiB;
constexpr size_t WS_WGU = 28 * MiB;
constexpr size_t WS_WD = 72 * MiB;
constexpr size_t WS_XB = 94 * MiB;
constexpr size_t WS_PROJ = 126 * MiB;
constexpr size_t WS_KV = 222 * MiB;
constexpr size_t WS_HG = 230 * MiB;
constexpr size_t WS_STATE = 262 * MiB;
constexpr size_t WS_END = 326 * MiB;
constexpr int CW_BAR = 4096;

constexpr int RING_OFF = 0, RING_BYTES = 131072;
constexpr int LDSCTL_OFF = RING_BYTES, MISC_OFF = LDSCTL_OFF + 320;
constexpr int LDS_BYTES = 147456;

typedef float f32x2 __attribute__((ext_vector_type(2)));
typedef unsigned u32x2 __attribute__((ext_vector_type(2)));
__device__ __forceinline__ float bf2f(unsigned short b) { return __builtin_bit_cast(float, (unsigned)b << 16); }
__device__ __forceinline__ float bflo(unsigned w) { return __builtin_bit_cast(float, w << 16); }
__device__ __forceinline__ float bfhi(unsigned w) { return __builtin_bit_cast(float, w & 0xffff0000u); }
template <int MASK> __device__ __forceinline__ float swz_xor(float x) { return __builtin_bit_cast(float, __builtin_amdgcn_ds_swizzle(__builtin_bit_cast(int, x), 0x1F | (MASK << 10))); }
__device__ __forceinline__ float xor32_add(float x) { float a = x, b = x; asm volatile("s_nop 1\n\tv_permlane32_swap_b32 %0, %1" : "+v"(a), "+v"(b)); return a + b; }
__device__ __forceinline__ float xor32_max(float x) { float a = x, b = x; asm volatile("s_nop 1\n\tv_permlane32_swap_b32 %0, %1" : "+v"(a), "+v"(b)); return fmaxf(a, b); }
__device__ __forceinline__ float wave_sum(float v) { v += swz_xor<1>(v); v += swz_xor<2>(v); v += swz_xor<4>(v); v += swz_xor<8>(v); v += swz_xor<16>(v); return xor32_add(v); }
__device__ __forceinline__ float shfl_up_l(float v, int o, int lane) { const int src = (lane >= o) ? lane - o : lane; return __builtin_bit_cast(float, __builtin_amdgcn_ds_bpermute(src << 2, __builtin_bit_cast(int, v))); }
__device__ __forceinline__ float bcast_lane(float v, int l) { return __builtin_bit_cast(float, __builtin_amdgcn_readlane(__builtin_bit_cast(int, v), l)); }
__device__ __forceinline__ float rstd_of(const float* ssp, int row) { const f32x4 p = *(const f32x4*)(ssp + (size_t)row * 4); return rsqrtf(((p.x + p.y) + (p.z + p.w)) * (1.f / D) + RMS_EPS); }

struct EpiProj {
    static constexpr bool PERM = true, AFTER_DRAIN = false;
    bf16* O0; int ld0; bf16* O1; int ld1; int split; const float* bias; const float* ssp;
    __device__ __forceinline__ void operator()(const pg8::f32x4 (&acc)[2][2][4][2], const pg8::Unit& u, int wr, int wc, int fr, int fq) const {
        const int row0 = u.pm * 256 + wr * 64 + fr; int colt = u.pn * 256; bf16* base = O0; int ld = ld0;
        if (split && colt >= split) { base = O1; ld = ld1; colt -= split; }
        const int col0 = colt + wc * 32 + 8 * fq, bcol0 = u.pn * 256 + wc * 32 + 8 * fq;
        f32x4 bv[2][2];
#pragma unroll
        for (int bj = 0; bj < 2; ++bj)
#pragma unroll
            for (int n = 0; n < 2; ++n) bv[bj][n] = bias ? *(const f32x4*)(bias + bcol0 + bj * 128 + 4 * n) : (f32x4){0.f, 0.f, 0.f, 0.f};
#pragma unroll
        for (int ai = 0; ai < 2; ++ai)
#pragma unroll
            for (int m = 0; m < 4; ++m) { const int r = row0 + ai * 128 + m * 16; const float rs = rstd_of(ssp, r); bf16* rowp = base + (size_t)r * ld + col0;
#pragma unroll
                for (int bj = 0; bj < 2; ++bj) { const f32x4 v0 = acc[ai][bj][m][0] * rs + bv[bj][0], v1 = acc[ai][bj][m][1] * rs + bv[bj][1];
                    v4u w; w.x = pg8::cvt_pk_bf16(v0[0], v0[1]); w.y = pg8::cvt_pk_bf16(v0[2], v0[3]); w.z = pg8::cvt_pk_bf16(v1[0], v1[1]); w.w = pg8::cvt_pk_bf16(v1[2], v1[3]);
                    *(v4u*)(rowp + bj * 128) = w; } }
    }
};
struct EpiProjML {
    static constexpr bool PERM = true, AFTER_DRAIN = false;
    bf16* P; const float* ssp;
    __device__ __forceinline__ void operator()(const pg8::f32x4 (&acc)[2][2][4][2], const pg8::Unit& u, int wr, int wc, int fr, int fq) const {
        const int row0 = u.pm * 256 + wr * 64 + fr, region = u.pn >> 1;
#pragma unroll
        for (int ai = 0; ai < 2; ++ai)
#pragma unroll
            for (int m = 0; m < 4; ++m) { const int r = row0 + ai * 128 + m * 16; const float rs = rstd_of(ssp, r); const int rb = r >> 5, rr = r & 31;
#pragma unroll
                for (int bj = 0; bj < 2; ++bj) { const f32x4 v0 = acc[ai][bj][m][0] * rs, v1 = acc[ai][bj][m][1] * rs;
                    v4u w; w.x = pg8::cvt_pk_bf16(v0[0], v0[1]); w.y = pg8::cvt_pk_bf16(v0[2], v0[3]); w.z = pg8::cvt_pk_bf16(v1[0], v1[1]); w.w = pg8::cvt_pk_bf16(v1[2], v1[3]);
                    const int c0 = u.pn * 256 + bj * 128 + wc * 32 + 8 * fq; size_t off;
                    if (region < 2) { const int cq = c0 & 511, h = cq >> 7, d0 = cq & 127; off = (size_t)region * M * 512 + ((size_t)(((rb * 4 + h) * 8 + (d0 >> 4)) * 2 + ((d0 >> 3) & 1)) * 256 + rr * 8); }
                    else if (region < 4) off = (size_t)M * 1024 + (size_t)r * 1024 + (c0 - 1024);
                    else { const int co = c0 - 2048, h = co >> 8, v = co & 255; off = (size_t)M * 2048 + ((size_t)((((rb * 4 + h) * 8 + (v >> 5)) * 4 + ((v >> 3) & 3)) * 32 + rr) * 8); }
                    *(v4u*)(P + off) = w; } }
    }
};
__device__ __forceinline__ float silu_mul(float g, float u) { return g * __builtin_amdgcn_rcpf(1.f + __builtin_amdgcn_exp2f(-g * LOG2E)) * u; }
struct EpiSwiglu {
    static constexpr bool PERM = true, AFTER_DRAIN = false;
    bf16* H; const float* ssp;
    __device__ __forceinline__ void operator()(const pg8::f32x4 (&acc)[2][2][4][2], const pg8::Unit& u, int wr, int wc, int fr, int fq) const {
        const int row0 = u.pm * 256 + wr * 64 + fr, col0 = u.pn * 128 + wc * 32 + 8 * fq;
#pragma unroll
        for (int ai = 0; ai < 2; ++ai)
#pragma unroll
            for (int m = 0; m < 4; ++m) { const int r = row0 + ai * 128 + m * 16; const float rs = rstd_of(ssp, r);
                const f32x4 g0 = acc[ai][0][m][0] * rs, g1 = acc[ai][0][m][1] * rs, u0 = acc[ai][1][m][0] * rs, u1 = acc[ai][1][m][1] * rs;
                v4u w; w.x = pg8::cvt_pk_bf16(silu_mul(g0[0], u0[0]), silu_mul(g0[1], u0[1])); w.y = pg8::cvt_pk_bf16(silu_mul(g0[2], u0[2]), silu_mul(g0[3], u0[3]));
                w.z = pg8::cvt_pk_bf16(silu_mul(g1[0], u1[0]), silu_mul(g1[1], u1[1])); w.w = pg8::cvt_pk_bf16(silu_mul(g1[2], u1[2]), silu_mul(g1[3], u1[3]));
                *(v4u*)(H + (size_t)r * DFF + col0) = w; }
    }
};
struct EpiResid {
    static constexpr bool PERM = true, AFTER_DRAIN = true;
    const float* basef; const bf16* baseb; bf16* xb; const float* bias; float* ssp;
    __device__ __forceinline__ void fused(pg8::f32x4 (&acc)[2][2][4][2], const pg8::Unit& u, int wr, int wc, int fr, int fq, PG8_LAS unsigned char* lds, int wid, int lane) const {
        PG8_LAS float* P = (PG8_LAS float*)lds;
        const int col0 = u.pn * 256 + wc * 32 + 8 * fq;
        f32x4 bv[2][2];
#pragma unroll
        for (int bj = 0; bj < 2; ++bj)
#pragma unroll
            for (int n = 0; n < 2; ++n) bv[bj][n] = bias ? *(const f32x4*)(bias + col0 + bj * 128 + 4 * n) : (f32x4){0.f, 0.f, 0.f, 0.f};
#pragma unroll
        for (int ai = 0; ai < 2; ++ai)
#pragma unroll
            for (int m = 0; m < 4; ++m) { const int rl = ai * 128 + wr * 64 + m * 16 + fr; const size_t off = (size_t)(u.pm * 256 + rl) * D + col0; float ss = 0.f;
#pragma unroll
                for (int bj = 0; bj < 2; ++bj) { const size_t c = off + bj * 128; f32x4 b0, b1;
                    if (basef) { b0 = *(const f32x4*)(basef + c); b1 = *(const f32x4*)(basef + c + 4); }
                    else { const v4u bw = *(const v4u*)(baseb + c); b0 = (f32x4){bflo(bw.x), bfhi(bw.x), bflo(bw.y), bfhi(bw.y)}; b1 = (f32x4){bflo(bw.z), bfhi(bw.z), bflo(bw.w), bfhi(bw.w)}; }
                    const f32x4 v0 = b0 + acc[ai][bj][m][0] + bv[bj][0], v1 = b1 + acc[ai][bj][m][1] + bv[bj][1];
                    v4u w; w.x = pg8::cvt_pk_bf16(v0[0], v0[1]); w.y = pg8::cvt_pk_bf16(v0[2], v0[3]); w.z = pg8::cvt_pk_bf16(v1[0], v1[1]); w.w = pg8::cvt_pk_bf16(v1[2], v1[3]);
                    *(v4u*)(xb + c) = w;
                    const float r0 = bflo(w.x), r1 = bfhi(w.x), r2 = bflo(w.y), r3 = bfhi(w.y), r4 = bflo(w.z), r5 = bfhi(w.z), r6 = bflo(w.w), r7 = bfhi(w.w);
                    ss += ((r0 * r0 + r1 * r1) + (r2 * r2 + r3 * r3)) + ((r4 * r4 + r5 * r5) + (r6 * r6 + r7 * r7)); }
                ss += swz_xor<16>(ss); ss = xor32_add(ss);
                if (fq == 0) P[rl * 4 + wc] = ss;
                if (m & 1) asm volatile("" ::: "memory"); }
        asm volatile("s_waitcnt lgkmcnt(0)" ::: "memory"); __builtin_amdgcn_s_barrier(); asm volatile("" ::: "memory");
        const int tid = wid * 64 + lane;
        if (tid < 256) { const f32x4 p = *(const PG8_LAS f32x4*)(P + tid * 4); ssp[(size_t)(u.pm * 256 + tid) * 4 + u.pn] = (p.x + p.y) + (p.z + p.w); }
        asm volatile("s_waitcnt lgkmcnt(0)" ::: "memory"); __builtin_amdgcn_s_barrier(); asm volatile("" ::: "memory");
    }
};

struct Frame {
    LAS unsigned char* lds;
    volatile LAS unsigned* MISC;
    gu32* ctl;
    int tid, lane, wave;
    int vcu, G;
};
struct Args { const float* in[19]; float* out; unsigned char* ws; };
typedef const char __attribute__((address_space(4)))* karg_ptr;
__device__ __forceinline__ karg_ptr kargs() { karg_ptr kp = (karg_ptr)__builtin_amdgcn_kernarg_segment_ptr(); asm volatile("" : "+s"(kp)); return kp; }
__device__ __forceinline__ const float* arg_in(int i) { return *(const float* const __attribute__((address_space(4)))*)(kargs() + 8 * i); }
__device__ __forceinline__ float* arg_out() { return *(float* const __attribute__((address_space(4)))*)(kargs() + 8 * 19); }
__device__ __forceinline__ unsigned char* arg_ws() { return *(unsigned char* const __attribute__((address_space(4)))*)(kargs() + 8 * 20); }
#define WSP(T, off) ((T*)(arg_ws() + (off)))


#define LAUNDER_TID(F) do { int l_ = (int)__builtin_amdgcn_mbcnt_hi(~0u, __builtin_amdgcn_mbcnt_lo(~0u, 0u)); asm volatile("" : "+v"(l_)); (F).lane = l_; (F).tid = (F).wave * 64 + l_; } while (0)
__device__ __forceinline__ void conv_item(const float* W, int ldw, int K, int nblk, const float* gain, float qscale, int qcols, bf16* WT, int rowmode, int row_off, LAS float* scr, int item, int lane) {
    const int kb = item / nblk, nb = item % nblk, k0 = 64 * kb, n0 = 32 * nb;
    const float ns = (n0 < qcols) ? qscale : 1.f;
    {
        f32x4 wv[8];
#pragma unroll
        for (int i = 0; i < 8; ++i) wv[i] = *(const f32x4*)(W + (size_t)(k0 + 8 * i + (lane >> 3)) * ldw + n0 + 4 * (lane & 7));
#pragma unroll
        for (int i = 0; i < 8; ++i) { const int kk = 8 * i + (lane >> 3); const float gk = gain ? gain[k0 + kk] * ns : ns; LAS float* d = scr + kk * 33 + 4 * (lane & 7);
            d[0] = wv[i].x * gk; d[1] = wv[i].y * gk; d[2] = wv[i].z * gk; d[3] = wv[i].w * gk; }
    }
    LDS_WAIT(); asm volatile("" ::: "memory");
    int rbase;
    if (rowmode == 0) rbase = row_off + n0;
    else { int j = n0, add = 0; if (j >= DFF) { j -= DFF; add = 128; } rbase = 256 * (j / 128) + add + (j % 128); }
    const int c = lane & 7;
#pragma unroll
    for (int j = 0; j < 4; ++j) { const int n = (lane >> 3) + 8 * j; const LAS float* s = scr + (8 * c) * 33 + n;
        v4u o; o.x = pk2(s[0 * 33], s[1 * 33]); o.y = pk2(s[2 * 33], s[3 * 33]); o.z = pk2(s[4 * 33], s[5 * 33]); o.w = pk2(s[6 * 33], s[7 * 33]);
        *(GAS v4u*)(WT + (size_t)(rbase + n) * K + k0 + 8 * c) = o; }
    LDS_WAIT(); asm volatile("" ::: "memory");
}
__device__ __forceinline__ void conv_layer(Frame& F, int l, int wi, int nw) {
    LAUNDER_TID(F);
    LAS float* scr = (LAS float*)(F.lds + RING_OFF + F.wave * 16384);
    unsigned char* ws = arg_ws();
    constexpr int I_IN = 16 * 96, I_SQ = 16 * 32, I_KV = 16 * 8, I_GU = 16 * 176, I_DN = 44 * 32;
    const int n0 = (l < 2) ? I_IN : (l == 2 ? I_SQ + I_KV : I_SQ);
    const int nitems = n0 + I_SQ + I_GU + I_DN;
    for (int it = wi; it < nitems; it += nw) {
        int r = it;
        if (r < n0) {
            if (l < 2) conv_item(arg_in(2) + (size_t)l * D * INA, INA, D, 96, arg_in(1) + l * D, QSCALE_A, 512, (bf16*)(ws + WS_WIN) + (size_t)l * 3072 * D, 0, 0, scr, r, F.lane);
            else if (r < I_SQ) conv_item(arg_in(10) + (size_t)(l - 2) * D * D, D, D, 32, arg_in(9) + (l - 2) * D, C2, 1024, (bf16*)(ws + (l == 2 ? WS_WQ2 : WS_WQ3)), 0, 0, scr, r, F.lane);
            else conv_item(arg_in(7), 256, D, 8, arg_in(6), 1.f, 0, (bf16*)(ws + WS_WQ2), 0, 1024, scr, r - I_SQ, F.lane);
            continue; }
        r -= n0;
        if (r < I_SQ) {
            if (l < 2) conv_item(arg_in(5) + (size_t)l * D * D, D, D, 32, nullptr, 1.f, 0, (bf16*)(ws + WS_WOUT) + (size_t)l * D * D, 0, 0, scr, r, F.lane);
            else conv_item(arg_in(13) + (size_t)(l - 2) * D * D, D, D, 32, nullptr, 1.f, 0, (bf16*)(ws + WS_WBO) + (size_t)(l - 2) * D * D, 0, 0, scr, r, F.lane);
            continue; }
        r -= I_SQ;
        if (r < I_GU) { conv_item(arg_in(16) + (size_t)l * D * 2 * DFF, 2 * DFF, D, 176, arg_in(15) + l * D, 1.f, 0, (bf16*)(ws + WS_WGU) + (size_t)l * 2 * DFF * D, 1, 0, scr, r, F.lane); continue; }
        r -= I_GU;
        conv_item(arg_in(17) + (size_t)l * DFF * D, D, DFF, 32, nullptr, 1.f, 0, (bf16*)(ws + WS_WD) + (size_t)l * D * DFF, 0, 0, scr, r, F.lane);
    }
}
__device__ __forceinline__ void p0_prologue(Frame& F, const Args& A, int nlayers) {
    for (int l = 0; l < nlayers; ++l) conv_layer(F, l, F.vcu * NWAVES + F.wave, F.G * NWAVES);
    LAUNDER_TID(F);
    const int gw = F.vcu * NWAVES + F.wave, NGW = F.G * NWAVES;
    unsigned char* ws = A.ws;
    const float* a_norm = A.in[1]; const float* a_w_in = A.in[2]; const float* b_kv = A.in[8]; const float* b_b_q = A.in[11];
    const float* x = A.in[0]; bf16* XB = (bf16*)(ws + WS_XB); float* SSP = (float*)(ws + WS_SSP);
    for (int m = gw; m < M; m += NGW) {
        const GAS f32x4* xr = (const GAS f32x4*)(x + (size_t)m * D) + F.lane; GAS u32x2* o8 = (GAS u32x2*)(XB + (size_t)m * D) + F.lane; float s = 0.f;
#pragma unroll
        for (int j = 0; j < 4; ++j) { const f32x4 v = xr[64 * j]; s += (v.x * v.x + v.y * v.y) + (v.z * v.z + v.w * v.w); u32x2 w; w.x = pk2(v.x, v.y); w.y = pk2(v.z, v.w); o8[64 * j] = w; }
        s = wave_sum(s);
        if (F.lane == 0) *(f32x4*)(SSP + (size_t)m * 4) = (f32x4){s, 0.f, 0.f, 0.f};
    }
    const int gt = F.vcu * (NWAVES * 64) + F.tid, NGT = F.G * NWAVES * 64;
    float* WGT = (float*)(ws + WS_WGT); float* BQ = (float*)(ws + WS_BQ);
    for (int i = gt; i < 2 * 8 * 1024; i += NGT) { const int l = i >> 13, j = (i >> 10) & 7, k = i & 1023; WGT[i] = a_w_in[(size_t)l * D * INA + (size_t)k * INA + 3072 + j] * a_norm[l * D + k]; }
    for (int i = gt; i < 2 * 1280; i += NGT) { const int l = i / 1280, c = i % 1280; BQ[i] = (c < 1024) ? b_b_q[l * D + c] * C2 : b_kv[c - 1024]; }
}

__device__ __forceinline__ float fexp(float x) { return __builtin_amdgcn_exp2f(x * LOG2E); }
__device__ __forceinline__ float softcap15(float x) { return 15.f - 30.f * __builtin_amdgcn_rcpf(fexp(x * (2.f / 15.f)) + 1.f); }
__device__ __forceinline__ float logsigmoidf(float x) { return fminf(x, 0.f) - 0.6931471805599453f * __builtin_amdgcn_logf(1.f + fexp(-fabsf(x))); }

__device__ __forceinline__ void gates_phase(Frame& F, const bf16* XB, const float* SSP, const float* WGTl, const float* bgl, float* GATES) {
    LAUNDER_TID(F);
    LAS float* Wl = (LAS float*)(F.lds + RING_OFF);
    for (int i = F.tid; i < 8 * 1024 / 4; i += NWAVES * 64) ((LAS f32x4*)Wl)[i] = ((const f32x4*)WGTl)[i];
    for (int blk = F.vcu; blk < M / 64; blk += F.G) {
        const int row0 = blk * 64 + F.wave * 8;
        u32x2 xw[8][4];
#pragma unroll
        for (int rr = 0; rr < 8; ++rr)
#pragma unroll
            for (int i = 0; i < 4; ++i) xw[rr][i] = *(const u32x2*)(XB + (size_t)(row0 + rr) * D + 4 * F.lane + 256 * i);
        const float rs = (F.lane < 8) ? rstd_of(SSP, row0 + F.lane) : 0.f;
        const float bg = (F.lane < 8) ? bgl[F.lane] : 0.f;
        __syncthreads();
        float res = 0.f;
#pragma unroll
        for (int rr = 0; rr < 8; ++rr) {
            float acc[8] = {0.f, 0.f, 0.f, 0.f, 0.f, 0.f, 0.f, 0.f};
#pragma unroll
            for (int i = 0; i < 4; ++i) { const int k = 4 * F.lane + 256 * i; const float x0 = bflo(xw[rr][i].x), x1 = bfhi(xw[rr][i].x), x2 = bflo(xw[rr][i].y), x3 = bfhi(xw[rr][i].y);
#pragma unroll
                for (int j = 0; j < 8; ++j) { const f32x4 w = *(const LAS f32x4*)(Wl + j * 1024 + k); acc[j] += (x0 * w.x + x1 * w.y) + (x2 * w.z + x3 * w.w); } }
#pragma unroll
            for (int j = 0; j < 8; ++j) acc[j] = wave_sum(acc[j]);
            float a = acc[0];
#pragma unroll
            for (int j = 1; j < 8; ++j) a = (F.lane == j) ? acc[j] : a;
            const float rsr = bcast_lane(rs, rr);
            if (F.lane < 8) { const float pre = softcap15(a * rsr + bg); GATES[(size_t)(row0 + rr) * 8 + F.lane] = (F.lane < 4) ? pre : logsigmoidf(pre); }
            (void)res;
        }
    }
    __syncthreads();
}

__device__ __forceinline__ void chunk_gates(Frame& F, const float* GATES, int c, int h, LAS float* bcum, LAS float* aval) {
    if (F.tid < 64) {
        const float lf = GATES[(size_t)(c * 64 + F.tid) * 8 + 4 + h], ig = GATES[(size_t)(c * 64 + F.tid) * 8 + h];
        float s = lf;
#pragma unroll
        for (int o = 1; o < 64; o <<= 1) { const float t = __shfl_up(s, o); if (F.lane >= o) s += t; }
        bcum[F.tid] = s; aval[F.tid] = ig - s;
    }
    __syncthreads();
}

__device__ __forceinline__ void ml_local_phase(Frame& F, const bf16* PROJ, const float* GATES, bf16* STATE, float* NST, float* CH) {
    LAUNDER_TID(F);
    LAS float* bcum = (LAS float*)(F.lds + RING_OFF); LAS float* aval = bcum + 64; LAS float* wsv = aval + 64;
    for (int unit = F.vcu; unit < NC * 4; unit += F.G) {
        const int c = unit >> 2, h = unit & 3;
        chunk_gates(F, GATES, c, h, bcum, aval);
        const float btot = bcum[63]; float amax = -INFINITY;
        for (int s = 0; s < 64; ++s) amax = fmaxf(amax, aval[s]);
        const float mloc = btot + amax;
        if (F.tid < 64) wsv[F.tid] = expf(btot + aval[F.tid] - mloc);
        __syncthreads();
        const bf16* kb = PROJ + (size_t)(c * 64) * 3072 + 512 + h * 128;
        const bf16* vb = PROJ + (size_t)(c * 64) * 3072 + 1024 + h * 256;
        const int v = F.tid >> 1, dh = F.tid & 1;
        float acc[64];
#pragma unroll
        for (int j = 0; j < 64; ++j) acc[j] = 0.f;
#pragma unroll 1
        for (int s = 0; s < 64; ++s) {
            const float wv = wsv[s] * bf2f(vb[(size_t)s * 3072 + v]);
            const v4u* kr = (const v4u*)(kb + (size_t)s * 3072 + dh * 64);
#pragma unroll
            for (int q = 0; q < 8; ++q) { const v4u kk = kr[q];
                acc[q * 8 + 0] += wv * bflo(kk.x); acc[q * 8 + 1] += wv * bfhi(kk.x); acc[q * 8 + 2] += wv * bflo(kk.y); acc[q * 8 + 3] += wv * bfhi(kk.y);
                acc[q * 8 + 4] += wv * bflo(kk.z); acc[q * 8 + 5] += wv * bfhi(kk.z); acc[q * 8 + 6] += wv * bflo(kk.w); acc[q * 8 + 7] += wv * bfhi(kk.w); }
        }
        bf16* st = STATE + ((size_t)(c * 4 + h) * 256 + v) * 128 + dh * 64;
#pragma unroll
        for (int q = 0; q < 8; ++q) { v4u o; o.x = pk2(acc[q * 8 + 0], acc[q * 8 + 1]); o.y = pk2(acc[q * 8 + 2], acc[q * 8 + 3]); o.z = pk2(acc[q * 8 + 4], acc[q * 8 + 5]); o.w = pk2(acc[q * 8 + 6], acc[q * 8 + 7]); *(v4u*)(st + q * 8) = o; }
        if (F.tid < 128) { float a = 0.f; for (int s = 0; s < 64; ++s) a += wsv[s] * bf2f(kb[(size_t)s * 3072 + F.tid]); NST[(size_t)(c * 4 + h) * 128 + F.tid] = a; }
        if (F.tid == 0) { CH[(c * 4 + h) * 2] = btot; CH[(c * 4 + h) * 2 + 1] = mloc; }
        __syncthreads();
    }
}

__device__ __forceinline__ void ml_scan_phase(Frame& F, bf16* STATE, float* NST, const float* CH, float* MS) {
    LAUNDER_TID(F);
    LAS float* f1 = (LAS float*)(F.lds + RING_OFF); LAS float* f2 = f1 + 256;
    const int h = F.vcu >> 6;
    if (F.tid < 64) {
        float bt[4], ml[4];
#pragma unroll
        for (int j = 0; j < 4; ++j) { const int c = 4 * F.lane + j; bt[j] = CH[(c * 4 + h) * 2]; ml[j] = CH[(c * 4 + h) * 2 + 1]; }
        float B = bt[0], Mx = ml[0];
#pragma unroll
        for (int j = 1; j < 4; ++j) { Mx = fmaxf(Mx + bt[j], ml[j]); B += bt[j]; }
#pragma unroll
        for (int o = 1; o < 64; o <<= 1) { const float Bp = __shfl_up(B, o), Mp = __shfl_up(Mx, o); if (F.lane >= o) { Mx = fmaxf(Mp + B, Mx); B = Bp + B; } }
        const float Bq = __shfl_up(B, 1), Mq = __shfl_up(Mx, 1);
        float m = (F.lane == 0) ? 0.f : fmaxf(Bq, Mq);
#pragma unroll
        for (int j = 0; j < 4; ++j) { const int c = 4 * F.lane + j; const float mn = fmaxf(bt[j] + m, ml[j]);
            f1[c] = expf(bt[j] + m - mn); f2[c] = expf(ml[j] - mn); if ((F.vcu & 63) == 0) MS[c * 4 + h] = m; m = mn; }
    }
    __syncthreads();
    if (F.tid < 256) {
        unsigned* base = (unsigned*)(STATE + (size_t)h * 32768) + ((F.vcu & 63) * 256 + F.tid);
        float c0v = 0.f, c1v = 0.f;
#pragma unroll 1
        for (int cb = 0; cb < NC; cb += 16) {
            unsigned u[16];
#pragma unroll
            for (int j = 0; j < 16; ++j) u[j] = base[(size_t)(cb + j) * 65536];
#pragma unroll
            for (int j = 0; j < 16; ++j) { const float a = f1[cb + j], b = f2[cb + j];
                base[(size_t)(cb + j) * 65536] = pg8::cvt_pk_bf16(c0v, c1v);
                c0v = a * c0v + b * bflo(u[j]); c1v = a * c1v + b * bfhi(u[j]); }
        }
    } else if ((F.vcu & 63) == 0 && F.tid < 384) {
        float* base = NST + h * 128 + (F.tid - 256); float nv = 0.f;
#pragma unroll 1
        for (int cb = 0; cb < NC; cb += 8) {
            float u[8];
#pragma unroll
            for (int j = 0; j < 8; ++j) u[j] = base[(size_t)(cb + j) * 512];
#pragma unroll
            for (int j = 0; j < 8; ++j) { base[(size_t)(cb + j) * 512] = nv; nv = f1[cb + j] * nv + f2[cb + j] * u[j]; }
        }
    }
    __syncthreads();
}

__device__ __forceinline__ void ml_out_phase(Frame& F, const bf16* PROJ, const float* GATES, const bf16* STATE, const float* NST, const float* MS, const float* hnorm, bf16* HG) {
    LAUNDER_TID(F);
    LAS float* bcum = (LAS float*)(F.lds + RING_OFF); LAS float* aval = bcum + 64; LAS float* mt = aval + 64; LAS float* et = mt + 64; LAS float* den = et + 64; LAS float* nq = den + 64;
    LAS float* red = nq + 64;
    LAS float* S = red + 64;
    const float scale = 1.f;
    for (int unit = F.vcu; unit < NC * 4; unit += F.G) {
        const int c = unit >> 2, h = unit & 3;
        chunk_gates(F, GATES, c, h, bcum, aval);
        const float mc = MS[c * 4 + h];
        if (F.tid < 64) { float am = -INFINITY; for (int s = 0; s <= F.tid; ++s) am = fmaxf(am, aval[s]); const float m_t = bcum[F.tid] + fmaxf(mc, am); mt[F.tid] = m_t; et[F.tid] = expf(bcum[F.tid] + mc - m_t); }
        __syncthreads();
        const bf16* qb = PROJ + (size_t)(c * 64) * 3072 + h * 128;
        const bf16* kb = PROJ + (size_t)(c * 64) * 3072 + 512 + h * 128;
        const bf16* vb = PROJ + (size_t)(c * 64) * 3072 + 1024 + h * 256;
        {
            const int t = F.tid >> 3;
#pragma unroll 1
            for (int j = 0; j < 8; ++j) { const int s = (F.tid & 7) * 8 + j; float a = 0.f;
                if (s <= t) { const v4u* qr = (const v4u*)(qb + (size_t)t * 3072); const v4u* kr = (const v4u*)(kb + (size_t)s * 3072);
#pragma unroll 4
                    for (int q = 0; q < 16; ++q) { const v4u a4 = qr[q], b4 = kr[q];
                        a += bflo(a4.x) * bflo(b4.x) + bfhi(a4.x) * bfhi(b4.x) + bflo(a4.y) * bflo(b4.y) + bfhi(a4.y) * bfhi(b4.y) + bflo(a4.z) * bflo(b4.z) + bfhi(a4.z) * bfhi(b4.z) + bflo(a4.w) * bflo(b4.w) + bfhi(a4.w) * bfhi(b4.w); }
                    a *= scale * expf(bcum[t] + aval[s] - mt[t]); }
                S[t * 65 + s] = a; }
        }
        if (F.tid < 64) { float a = 0.f; const float* nn = NST + (size_t)(c * 4 + h) * 128; for (int d = 0; d < 128; ++d) a += nn[d] * bf2f(qb[(size_t)F.tid * 3072 + d]); nq[F.tid] = a * scale; }
        __syncthreads();
        if (F.tid < 64) { float a = 0.f; for (int s = 0; s < 64; ++s) a += S[F.tid * 65 + s]; a += et[F.tid] * nq[F.tid]; den[F.tid] = fmaxf(fabsf(a), expf(-mt[F.tid])); }
        __syncthreads();
        const int v = F.tid & 255, th = F.tid >> 8;
        v4u Cc[16];
        { const v4u* st = (const v4u*)(STATE + ((size_t)(c * 4 + h) * 256 + v) * 128);
#pragma unroll
          for (int q = 0; q < 16; ++q) Cc[q] = st[q]; }
        const float gain = hnorm[h * 256 + v];
#pragma unroll 1
        for (int tt = 0; tt < 32; ++tt) {
            const int t = th * 32 + tt;
            float a = 0.f;
            for (int s = 0; s <= t; ++s) a += S[t * 65 + s] * bf2f(vb[(size_t)s * 3072 + v]);
            float b = 0.f; const v4u* qr = (const v4u*)(qb + (size_t)t * 3072);
#pragma unroll
            for (int q = 0; q < 16; ++q) { const v4u a4 = qr[q], b4 = Cc[q];
                b += bflo(a4.x) * bflo(b4.x) + bfhi(a4.x) * bfhi(b4.x) + bflo(a4.y) * bflo(b4.y) + bfhi(a4.y) * bfhi(b4.y) + bflo(a4.z) * bflo(b4.z) + bfhi(a4.z) * bfhi(b4.z) + bflo(a4.w) * bflo(b4.w) + bfhi(a4.w) * bfhi(b4.w); }
            const float hv = (a + et[t] * scale * b) / den[t];
            const float ss = wave_sum(hv * hv);
            __syncthreads();
            if (F.lane == 0) red[F.wave] = ss;
            __syncthreads();
            const float tot = (red[th * 4] + red[th * 4 + 1]) + (red[th * 4 + 2] + red[th * 4 + 3]);
            const float r = rsqrtf(tot * (1.f / 256.f) + RMS_EPS);
            const size_t row = (size_t)(c * 64 + t);
            const float o = bf2f(PROJ[row * 3072 + 2048 + h * 256 + v]);
            HG[row * D + h * 256 + v] = (bf16)f2bf(hv * r * gain / (1.f + expf(-o)));
        }
        __syncthreads();
    }
}

__device__ __forceinline__ void attn_phase(Frame& F, const bf16* Q, const bf16* KV, const float* sinks, bf16* O) {
    LAUNDER_TID(F);
    for (int unit = F.vcu; unit < 128 * 16; unit += F.G) {
        const int nb = unit >> 4, head = unit & 15, kvh = head >> 3;
        const int i = F.tid >> 2, part = F.tid & 3;
        const int qpos = nb * 128 + i;
        float q[16], o[16];
        { const v4u* qr = (const v4u*)(Q + (size_t)qpos * D + head * 64 + part * 16);
#pragma unroll
          for (int w = 0; w < 2; ++w) { const v4u a = qr[w]; q[w * 8 + 0] = bflo(a.x); q[w * 8 + 1] = bfhi(a.x); q[w * 8 + 2] = bflo(a.y); q[w * 8 + 3] = bfhi(a.y); q[w * 8 + 4] = bflo(a.z); q[w * 8 + 5] = bfhi(a.z); q[w * 8 + 6] = bflo(a.w); q[w * 8 + 7] = bfhi(a.w); } }
        float m = sinks[head] * LOG2E, l = 1.f;
#pragma unroll
        for (int d = 0; d < 16; ++d) o[d] = 0.f;
        const int j0 = (nb == 0) ? 128 : 0;
#pragma unroll 1
        for (int j = j0; j < 256; ++j) {
            const int kpos = (nb - 1) * 128 + j;
            const int rel = i + 128 - j;
            const bool valid = (rel >= 0) && (rel < 128);
            const v4u* kr = (const v4u*)(KV + (size_t)kpos * 256 + kvh * 64 + part * 16);
            const v4u* vr = (const v4u*)(KV + (size_t)kpos * 256 + 128 + kvh * 64 + part * 16);
            float kf[16], vf[16];
#pragma unroll
            for (int w = 0; w < 2; ++w) { const v4u a = kr[w]; kf[w * 8 + 0] = bflo(a.x); kf[w * 8 + 1] = bfhi(a.x); kf[w * 8 + 2] = bflo(a.y); kf[w * 8 + 3] = bfhi(a.y); kf[w * 8 + 4] = bflo(a.z); kf[w * 8 + 5] = bfhi(a.z); kf[w * 8 + 6] = bflo(a.w); kf[w * 8 + 7] = bfhi(a.w);
                const v4u b = vr[w]; vf[w * 8 + 0] = bflo(b.x); vf[w * 8 + 1] = bfhi(b.x); vf[w * 8 + 2] = bflo(b.y); vf[w * 8 + 3] = bfhi(b.y); vf[w * 8 + 4] = bflo(b.z); vf[w * 8 + 5] = bfhi(b.z); vf[w * 8 + 6] = bflo(b.w); vf[w * 8 + 7] = bfhi(b.w); }
            float s = 0.f;
#pragma unroll
            for (int d = 0; d < 16; ++d) s += q[d] * kf[d];
            s += __shfl_xor(s, 1); s += __shfl_xor(s, 2);
            if (valid) {
                const float mn = fmaxf(m, s), corr = __builtin_amdgcn_exp2f(m - mn), p = __builtin_amdgcn_exp2f(s - mn);
                l = l * corr + p;
#pragma unroll
                for (int d = 0; d < 16; ++d) o[d] = o[d] * corr + p * vf[d];
                m = mn;
            }
        }
        const float inv = 1.f / l;
        v4u w0, w1;
        w0.x = pk2(o[0] * inv, o[1] * inv); w0.y = pk2(o[2] * inv, o[3] * inv); w0.z = pk2(o[4] * inv, o[5] * inv); w0.w = pk2(o[6] * inv, o[7] * inv);
        w1.x = pk2(o[8] * inv, o[9] * inv); w1.y = pk2(o[10] * inv, o[11] * inv); w1.z = pk2(o[12] * inv, o[13] * inv); w1.w = pk2(o[14] * inv, o[15] * inv);
        v4u* op = (v4u*)(O + (size_t)qpos * D + head * 64 + part * 16); op[0] = w0; op[1] = w1;
    }
}

__device__ __forceinline__ void final_norm_phase(Frame& F, float* out, const bf16* XB, const float* SSP, const float* g) {
    LAUNDER_TID(F);
    const int gw = F.vcu * NWAVES + F.wave, NGW = F.G * NWAVES;
    for (int m = gw; m < M; m += NGW) {
        const float rs = rstd_of(SSP, m);
        GAS f32x4* xr = (GAS f32x4*)(out + (size_t)m * D) + F.lane; const f32x4* gg = (const f32x4*)g + F.lane; const u32x2* xb = (const u32x2*)(XB + (size_t)m * D) + F.lane;
#pragma unroll
        for (int j = 0; j < 4; ++j) { const u32x2 v = xb[64 * j]; const f32x4 w = gg[64 * j]; xr[64 * j] = (f32x4){bflo(v.x) * rs * w.x, bfhi(v.x) * rs * w.y, bflo(v.y) * rs * w.z, bfhi(v.y) * rs * w.w}; }
    }
}

typedef float f32x16 __attribute__((ext_vector_type(16)));
typedef short s16x4 __attribute__((ext_vector_type(4)));
typedef short v4i16_t __attribute__((ext_vector_type(4)));
__device__ __forceinline__ s16x4 tr16(const LAS unsigned char* p) { return __builtin_bit_cast(s16x4, __builtin_amdgcn_ds_read_tr16_b64_v4i16((LAS v4i16_t*)p)); }
__device__ __forceinline__ bf16x8 cat8(s16x4 a, s16x4 b) { return (bf16x8){a[0], a[1], a[2], a[3], b[0], b[1], b[2], b[3]}; }
__device__ __forceinline__ unsigned cvtpk(float lo, float hi) { return pg8::cvt_pk_bf16(lo, hi); }
__device__ __forceinline__ bf16x8 pack8(const f32x16& p, int s) {
    v4u w; w.x = cvtpk(p[8 * s + 0], p[8 * s + 1]); w.y = cvtpk(p[8 * s + 2], p[8 * s + 3]); w.z = cvtpk(p[8 * s + 4], p[8 * s + 5]); w.w = cvtpk(p[8 * s + 6], p[8 * s + 7]);
    return __builtin_bit_cast(bf16x8, w);
}
#define MFMA32(a, b, c) __builtin_amdgcn_mfma_f32_32x32x16_bf16((a), (b), (c), 0, 0, 0)
#define CROW(r, hi) (((r) & 3) + 8 * ((r) >> 2) + 4 * (hi))

__device__ __forceinline__ void attn_phase_mfma(Frame& F, const bf16* Q, const bf16* KV, const float* sinks, bf16* O) {
    LAUNDER_TID(F);
    LAS unsigned char* Kl = F.lds + RING_OFF;
    LAS unsigned char* Vl = Kl + 32768;
    const int lane = F.lane, r32 = lane & 31, hi = lane >> 5;
    for (int unit = F.vcu; unit < 256; unit += F.G) {
        const int nb = unit >> 1, kvh = unit & 1, head = kvh * 8 + F.wave;
#pragma unroll
        for (int i = 0; i < 4; ++i) { const int p = F.tid + 512 * i, key = p >> 3, c = p & 7, kpos = (nb - 1) * 128 + key;
            if (kpos >= 0) { const v4u kk = *(const v4u*)(KV + (size_t)kpos * 256 + kvh * 64 + c * 8); const v4u vv = *(const v4u*)(KV + (size_t)kpos * 256 + 128 + kvh * 64 + c * 8);
                *(LAS v4u*)(Kl + key * 128 + ((c ^ ((key >> 1) & 7)) << 4)) = kk; *(LAS v4u*)(Vl + (c >> 2) * 16384 + key * 64 + (c & 3) * 16) = vv; } }
        __syncthreads();
        const float sk = sinks[head] * LOG2E;
#pragma unroll 1
        for (int qb = 0; qb < 4; ++qb) {
            const int qpos = nb * 128 + qb * 32 + r32;
            bf16x8 qf[4];
#pragma unroll
            for (int kk = 0; kk < 4; ++kk) qf[kk] = *(const bf16x8*)(Q + (size_t)qpos * D + head * 64 + kk * 16 + hi * 8);
            f32x16 sacc[5];
#pragma unroll
            for (int t = 0; t < 5; ++t) {
#pragma unroll
                for (int r = 0; r < 16; ++r) sacc[t][r] = 0.f;
                if (nb > 0 || qb + t >= 4) { const int key = (qb + t) * 32 + r32;
#pragma unroll
                    for (int kk = 0; kk < 4; ++kk) { const int c = 2 * kk + hi; const bf16x8 kf = *(const LAS bf16x8*)(Kl + key * 128 + ((c ^ ((key >> 1) & 7)) << 4)); sacc[t] = MFMA32(kf, qf[kk], sacc[t]); } }
            }
            float mx = sk;
#pragma unroll
            for (int t = 0; t < 5; ++t) { const bool live = (nb > 0 || qb + t >= 4);
#pragma unroll
                for (int r = 0; r < 16; ++r) { const int cr = CROW(r, hi); bool valid = live; if (t == 0) valid = valid && (cr > r32); if (t == 4) valid = valid && (cr <= r32);
                    const float s = valid ? sacc[t][r] : -INFINITY; sacc[t][r] = s; mx = fmaxf(mx, s); } }
            mx = xor32_max(mx);
            float l = 0.f;
#pragma unroll
            for (int t = 0; t < 5; ++t)
#pragma unroll
                for (int r = 0; r < 16; ++r) { const float p = __builtin_amdgcn_exp2f(sacc[t][r] - mx); sacc[t][r] = p; l += p; }
            l = xor32_add(l); l += __builtin_amdgcn_exp2f(sk - mx);
            f32x16 oacc[2];
#pragma unroll
            for (int r = 0; r < 16; ++r) { oacc[0][r] = 0.f; oacc[1][r] = 0.f; }
#pragma unroll
            for (int t = 0; t < 5; ++t) if (nb > 0 || qb + t >= 4) {
#pragma unroll
                for (int s = 0; s < 2; ++s) { const bf16x8 pf = pack8(sacc[t], s);
#pragma unroll
                    for (int dt = 0; dt < 2; ++dt) { const LAS unsigned char* vp = Vl + dt * 16384 + ((qb + t) * 32 + 16 * s + 4 * hi + ((lane & 15) >> 2)) * 64 + ((lane >> 4) & 1) * 32 + (lane & 3) * 8;
                        const bf16x8 vf = cat8(tr16(vp), tr16(vp + 8 * 64)); oacc[dt] = MFMA32(vf, pf, oacc[dt]); } } }
            const float inv = 1.f / l;
            bf16* orow = O + (size_t)qpos * D + head * 64 + 4 * hi;
#pragma unroll
            for (int dt = 0; dt < 2; ++dt)
#pragma unroll
                for (int gq = 0; gq < 4; ++gq) { u32x2 w; w.x = cvtpk(oacc[dt][4 * gq] * inv, oacc[dt][4 * gq + 1] * inv); w.y = cvtpk(oacc[dt][4 * gq + 2] * inv, oacc[dt][4 * gq + 3] * inv);
                    *(u32x2*)(orow + 32 * dt + 8 * gq) = w; }
        }
        __syncthreads();
    }
}

__device__ __forceinline__ void ml_local_phase_mfma(Frame& F, const bf16* PROJ, const float* GATES, bf16* STATE, float* NST, float* CH) {
    LAUNDER_TID(F);
    LAS unsigned char* Kl = F.lds + RING_OFF;
    LAS unsigned char* Vl = Kl + 16384;
    LAS float* bcum = (LAS float*)(Vl + 32768); LAS float* aval = bcum + 64; LAS float* wsv = aval + 64;
    const int lane = F.lane, r32 = lane & 31, hi = lane >> 5;
    for (int unit = F.vcu; unit < NC * 4; unit += F.G) {
        const int c = unit >> 2, h = unit & 3;
        chunk_gates(F, GATES, c, h, bcum, aval);
        const float btot = bcum[63]; float amax = -INFINITY;
        for (int s = 0; s < 64; ++s) amax = fmaxf(amax, aval[s]);
        const float mloc = btot + amax;
        if (F.tid < 64) wsv[F.tid] = expf(btot + aval[F.tid] - mloc);
        __syncthreads();
        const bf16* kb = PROJ + (size_t)(c * 64) * 3072 + 512 + h * 128;
        const bf16* vb = PROJ + (size_t)(c * 64) * 3072 + 1024 + h * 256;
#pragma unroll
        for (int i = 0; i < 2; ++i) { const int p = F.tid + 512 * i, s = p >> 4, cc = p & 15; const v4u kk = *(const v4u*)(kb + (size_t)s * 3072 + cc * 8); const float w = wsv[s];
            v4u o; o.x = pk2(bflo(kk.x) * w, bfhi(kk.x) * w); o.y = pk2(bflo(kk.y) * w, bfhi(kk.y) * w); o.z = pk2(bflo(kk.z) * w, bfhi(kk.z) * w); o.w = pk2(bflo(kk.w) * w, bfhi(kk.w) * w);
            *(LAS v4u*)(Kl + (cc >> 2) * 4096 + s * 64 + (cc & 3) * 16) = o; }
#pragma unroll
        for (int i = 0; i < 4; ++i) { const int p = F.tid + 512 * i, s = p >> 5, cc = p & 31; const v4u vv = *(const v4u*)(vb + (size_t)s * 3072 + cc * 8);
            *(LAS v4u*)(Vl + (cc >> 2) * 4096 + s * 64 + (cc & 3) * 16) = vv; }
        if (F.tid == 0) { CH[(c * 4 + h) * 2] = btot; CH[(c * 4 + h) * 2 + 1] = mloc; }
        __syncthreads();
        if (F.tid >= 384) { const int d = F.tid - 384; float a = 0.f; const LAS unsigned short* kc = (const LAS unsigned short*)(Kl + (d >> 5) * 4096 + (d & 31) * 2);
#pragma unroll 16
            for (int s = 0; s < 64; ++s) a += bf2f(kc[s * 32]);
            NST[(size_t)(c * 4 + h) * 128 + d] = a; }
        f32x16 acc[4];
#pragma unroll
        for (int dt = 0; dt < 4; ++dt)
#pragma unroll
            for (int r = 0; r < 16; ++r) acc[dt][r] = 0.f;
        const int troff = (4 * hi + ((lane & 15) >> 2)) * 64 + ((lane >> 4) & 1) * 32 + (lane & 3) * 8;
#pragma unroll
        for (int ks = 0; ks < 4; ++ks) {
            const LAS unsigned char* vp = Vl + F.wave * 4096 + ks * 16 * 64 + troff;
            const bf16x8 vf = cat8(tr16(vp), tr16(vp + 8 * 64));
#pragma unroll
            for (int dt = 0; dt < 4; ++dt) { const LAS unsigned char* kp = Kl + dt * 4096 + ks * 16 * 64 + troff;
                const bf16x8 kf = cat8(tr16(kp), tr16(kp + 8 * 64));
                acc[dt] = MFMA32(kf, vf, acc[dt]); }
        }
        bf16* st = STATE + ((size_t)(c * 4 + h) * 256 + F.wave * 32 + r32) * 128 + 4 * hi;
#pragma unroll
        for (int dt = 0; dt < 4; ++dt)
#pragma unroll
            for (int gq = 0; gq < 4; ++gq) { u32x2 w; w.x = cvtpk(acc[dt][4 * gq], acc[dt][4 * gq + 1]); w.y = cvtpk(acc[dt][4 * gq + 2], acc[dt][4 * gq + 3]); *(u32x2*)(st + 32 * dt + 8 * gq) = w; }
        __syncthreads();
    }
}

__device__ __forceinline__ void ml_out_phase_mfma(Frame& F, const bf16* PROJ, const float* GATES, const bf16* STATE, const float* NST, const float* MS, const float* hnorm, bf16* HG) {
    LAUNDER_TID(F);
    LAS unsigned char* Vl = F.lds + RING_OFF;
    LAS float* bcum = (LAS float*)(Vl + 32768); LAS float* aval = bcum + 64; LAS float* mt = aval + 64; LAS float* et = mt + 64; LAS float* nst = et + 64  ; LAS float* red = nst + 128  ;
    const int lane = F.lane, r32 = lane & 31, hi = lane >> 5, tb = F.wave >> 2, vq = F.wave & 3;
    for (int unit = F.vcu; unit < NC * 4; unit += F.G) {
        const int c = unit >> 2, h = unit & 3;
        const float mc = MS[c * 4 + h];
        if (F.tid < 64) {
            const float lf = GATES[(size_t)(c * 64 + F.tid) * 8 + 4 + h], ig = GATES[(size_t)(c * 64 + F.tid) * 8 + h];
            float s = lf;
#pragma unroll
            for (int o = 1; o < 64; o <<= 1) { const float t = __shfl_up(s, o); if (lane >= o) s += t; }
            const float a = ig - s; float am = a;
#pragma unroll
            for (int o = 1; o < 64; o <<= 1) { const float t = __shfl_up(am, o); if (lane >= o) am = fmaxf(am, t); }
            const float m_t = s + fmaxf(mc, am);
            bcum[F.tid] = s; aval[F.tid] = a; mt[F.tid] = m_t; et[F.tid] = expf(s + mc - m_t);
        }
        if (F.tid >= 64 && F.tid < 192) nst[F.tid - 64] = NST[(size_t)(c * 4 + h) * 128 + F.tid - 64];
        const bf16* qb = PROJ + (size_t)(c * 64) * 3072 + h * 128;
        const bf16* kb = PROJ + (size_t)(c * 64) * 3072 + 512 + h * 128;
        const bf16* vb = PROJ + (size_t)(c * 64) * 3072 + 1024 + h * 256;
#pragma unroll
        for (int i = 0; i < 4; ++i) { const int p = F.tid + 512 * i, s = p >> 5, cc = p & 31; const v4u vv = *(const v4u*)(vb + (size_t)s * 3072 + cc * 8);
            *(LAS v4u*)(Vl + (cc >> 2) * 4096 + s * 64 + (cc & 3) * 16) = vv; }
        const int t = tb * 32 + r32;
        bf16x8 qf[8];
#pragma unroll
        for (int kk = 0; kk < 8; ++kk) qf[kk] = *(const bf16x8*)(qb + (size_t)t * 3072 + kk * 16 + hi * 8);
        f32x16 sacc[2];
#pragma unroll
        for (int sb = 0; sb < 2; ++sb) {
#pragma unroll
            for (int r = 0; r < 16; ++r) sacc[sb][r] = 0.f;
            if (sb <= tb) {
#pragma unroll
                for (int kk = 0; kk < 8; ++kk) { const bf16x8 kf = *(const bf16x8*)(kb + (size_t)(sb * 32 + r32) * 3072 + kk * 16 + hi * 8); sacc[sb] = MFMA32(kf, qf[kk], sacc[sb]); } }
        }
        __syncthreads();
        const float b_t = bcum[t], m_t = mt[t], e_t = et[t];
        float dsum = 0.f;
#pragma unroll
        for (int sb = 0; sb < 2; ++sb)
#pragma unroll
            for (int gq = 0; gq < 4; ++gq) { const f32x4 a4 = *(const LAS f32x4*)(aval + sb * 32 + 8 * gq + 4 * hi);
#pragma unroll
                for (int i = 0; i < 4; ++i) { const int r = 4 * gq + i, cr = 8 * gq + 4 * hi + i; const bool valid = (sb < tb) || (sb == tb && cr <= r32);
                    const float w = valid ? sacc[sb][r] * expf(b_t + a4[i] - m_t) : 0.f; sacc[sb][r] = w; dsum += w; } }
        float nq = 0.f;
#pragma unroll
        for (int kk = 0; kk < 8; ++kk) { const v4u qw = __builtin_bit_cast(v4u, qf[kk]); const f32x4 n0 = *(const LAS f32x4*)(nst + kk * 16 + hi * 8), n1 = *(const LAS f32x4*)(nst + kk * 16 + hi * 8 + 4);
            nq += (bflo(qw.x) * n0.x + bfhi(qw.x) * n0.y) + (bflo(qw.y) * n0.z + bfhi(qw.y) * n0.w) + (bflo(qw.z) * n1.x + bfhi(qw.z) * n1.y) + (bflo(qw.w) * n1.z + bfhi(qw.w) * n1.w); }
        dsum = xor32_add(dsum); nq = xor32_add(nq);
        const float dd = fmaxf(fabsf(dsum + e_t * nq), expf(-m_t));
        const float dinv = 1.f / dd;
        f32x16 hacc[2];
        const int troff = (4 * hi + ((lane & 15) >> 2)) * 64 + ((lane >> 4) & 1) * 32 + (lane & 3) * 8;
        float ss = 0.f;
#pragma unroll
        for (int vt = 0; vt < 2; ++vt) {
            f32x16 ia, xa;
#pragma unroll
            for (int r = 0; r < 16; ++r) { ia[r] = 0.f; xa[r] = 0.f; }
#pragma unroll
            for (int sb = 0; sb < 2; ++sb) if (sb <= tb) {
#pragma unroll
                for (int s16 = 0; s16 < 2; ++s16) { const LAS unsigned char* vp = Vl + (vq * 2 + vt) * 4096 + (sb * 32 + s16 * 16) * 64 + troff;
                    const bf16x8 vf = cat8(tr16(vp), tr16(vp + 8 * 64)); ia = MFMA32(vf, pack8(sacc[sb], s16), ia); } }
            const bf16* cb = STATE + ((size_t)(c * 4 + h) * 256 + vq * 64 + vt * 32 + r32) * 128 + hi * 8;
#pragma unroll
            for (int kk = 0; kk < 8; ++kk) { const bf16x8 cf = *(const bf16x8*)(cb + kk * 16); xa = MFMA32(cf, qf[kk], xa); }
#pragma unroll
            for (int r = 0; r < 16; ++r) { const float hv = (ia[r] + e_t * xa[r]) * dinv; hacc[vt][r] = hv; ss += hv * hv; }
        }
        ss = xor32_add(ss);
        if (hi == 0) red[(tb * 4 + vq) * 32 + r32] = ss;
        __syncthreads();
        const float tot = (red[(tb * 4 + 0) * 32 + r32] + red[(tb * 4 + 1) * 32 + r32]) + (red[(tb * 4 + 2) * 32 + r32] + red[(tb * 4 + 3) * 32 + r32]);
        const float rn = rsqrtf(tot * (1.f / 256.f) + RMS_EPS);
        const size_t row = (size_t)(c * 64 + t);
#pragma unroll
        for (int vt = 0; vt < 2; ++vt)
#pragma unroll
            for (int gq = 0; gq < 4; ++gq) { const int v0 = h * 256 + vq * 64 + vt * 32 + 8 * gq + 4 * hi;
                const f32x4 gn = *(const f32x4*)(hnorm + v0); const u32x2 ow = *(const u32x2*)(PROJ + row * 3072 + 2048 + v0);
                const float o0 = bflo(ow.x), o1 = bfhi(ow.x), o2 = bflo(ow.y), o3 = bfhi(ow.y);
                const float y0 = hacc[vt][4 * gq] * rn * gn.x / (1.f + expf(-o0)), y1 = hacc[vt][4 * gq + 1] * rn * gn.y / (1.f + expf(-o1));
                const float y2 = hacc[vt][4 * gq + 2] * rn * gn.z / (1.f + expf(-o2)), y3 = hacc[vt][4 * gq + 3] * rn * gn.w / (1.f + expf(-o3));
                u32x2 w; w.x = cvtpk(y0, y1); w.y = cvtpk(y2, y3); *(u32x2*)(HG + row * D + v0) = w; }
        __syncthreads();
    }
}


constexpr int NSC = 64;
constexpr int GA_OFF = 132096;
__device__ __forceinline__ void sc_gates(const float* GATES, int sc, int h, int lane, LAS float* bcum, LAS float* aval, LAS float* amc, float& btot, float& amax) {
    float lf[4], ig[4];
#pragma unroll
    for (int j = 0; j < 4; ++j) { const size_t row = (size_t)sc * 256 + 4 * lane + j; lf[j] = GATES[row * 8 + 4 + h]; ig[j] = GATES[row * 8 + h]; }
    float b[4]; b[0] = lf[0]; b[1] = b[0] + lf[1]; b[2] = b[1] + lf[2]; b[3] = b[2] + lf[3];
    float inc = b[3];
#pragma unroll
    for (int o = 1; o < 64; o <<= 1) { const float t = shfl_up_l(inc, o, lane); if (lane >= o) inc += t; }
    const float excl = inc - b[3];
    float a[4], cm[4];
#pragma unroll
    for (int j = 0; j < 4; ++j) { b[j] += excl; a[j] = ig[j] - b[j]; }
    cm[0] = a[0]; cm[1] = fmaxf(cm[0], a[1]); cm[2] = fmaxf(cm[1], a[2]); cm[3] = fmaxf(cm[2], a[3]);
    float inc2 = cm[3];
#pragma unroll
    for (int o = 1; o < 64; o <<= 1) { const float t = shfl_up_l(inc2, o, lane); if (lane >= o) inc2 = fmaxf(inc2, t); }
    float prev = shfl_up_l(inc2, 1, lane); if (lane == 0) prev = -INFINITY;
#pragma unroll
    for (int j = 0; j < 4; ++j) cm[j] = fmaxf(cm[j], prev);
    *(LAS f32x4*)(bcum + 4 * lane) = (f32x4){b[0], b[1], b[2], b[3]};
    *(LAS f32x4*)(aval + 4 * lane) = (f32x4){a[0], a[1], a[2], a[3]};
    *(LAS f32x4*)(amc + 4 * lane) = (f32x4){cm[0], cm[1], cm[2], cm[3]};
    btot = bcast_lane(inc, 63); amax = bcast_lane(inc2, 63);
}

__device__ __forceinline__ void ml_local256(Frame& F, const bf16* PROJ, const float* GATES, bf16* STATE, float* NST, float* CH) {
    LAUNDER_TID(F);
    LAS unsigned char* Kl = F.lds + RING_OFF;
    LAS unsigned char* Vl = Kl + 16384;
    LAS float* bcum = (LAS float*)(F.lds + GA_OFF); LAS float* aval = bcum + 256; LAS float* amc = aval + 256; LAS float* wsv = amc + 256;
    const int lane = F.lane, r32 = lane & 31, hi = lane >> 5;
    for (int unit = F.vcu; unit < NSC * 4; unit += F.G) {
        const int sc = unit >> 2, h = unit & 3;
        const bf16* kfb = PROJ + (size_t)M * 512;
        const bf16* vb = PROJ + (size_t)M * 1024 + (size_t)(sc * 256) * 1024 + h * 256;
        v4u kreg[2], vreg[4];
#define ML_LOAD(j) do { _Pragma("unroll") for (int i = 0; i < 2; ++i) { const int p = F.tid + 512 * i, cc = p >> 6, s = p & 63, sg = sc * 256 + (j) * 64 + s; kreg[i] = *(const v4u*)(kfb + ((size_t)((((sg >> 5) * 4 + h) * 16 + cc)) * 256 + (sg & 31) * 8)); } \
                        _Pragma("unroll") for (int i = 0; i < 4; ++i) { const int p = F.tid + 512 * i, s = p >> 5, cc = p & 31; vreg[i] = *(const v4u*)(vb + (size_t)((j) * 64 + s) * 1024 + cc * 8); } } while (0)
        ML_LOAD(0);
        if (F.tid < 64) {
            float btot, amax; sc_gates(GATES, sc, h, lane, bcum, aval, amc, btot, amax);
            const float mloc = btot + amax; const f32x4 a4 = *(const LAS f32x4*)(aval + 4 * lane);
            *(LAS f32x4*)(wsv + 4 * lane) = (f32x4){fexp(btot + a4.x - mloc), fexp(btot + a4.y - mloc), fexp(btot + a4.z - mloc), fexp(btot + a4.w - mloc)};
            if (lane == 0) { CH[(sc * 4 + h) * 2] = btot; CH[(sc * 4 + h) * 2 + 1] = mloc; }
        }
        f32x16 acc[4];
#pragma unroll
        for (int dt = 0; dt < 4; ++dt)
#pragma unroll
            for (int r = 0; r < 16; ++r) acc[dt][r] = 0.f;
        float nsum = 0.f;
        const int troff = (4 * hi + ((lane & 15) >> 2)) * 64 + ((lane >> 4) & 1) * 32 + (lane & 3) * 8;
        __syncthreads();
#pragma unroll 1
        for (int j = 0; j < 4; ++j) {
#pragma unroll
            for (int i = 0; i < 2; ++i) { const int p = F.tid + 512 * i, cc = p >> 6, s = p & 63; const v4u kk = kreg[i]; const float w = wsv[j * 64 + s];
                v4u o; o.x = pk2(bflo(kk.x) * w, bfhi(kk.x) * w); o.y = pk2(bflo(kk.y) * w, bfhi(kk.y) * w); o.z = pk2(bflo(kk.z) * w, bfhi(kk.z) * w); o.w = pk2(bflo(kk.w) * w, bfhi(kk.w) * w);
                *(LAS v4u*)(Kl + (cc >> 2) * 4096 + s * 64 + (cc & 3) * 16) = o; }
#pragma unroll
            for (int i = 0; i < 4; ++i) { const int p = F.tid + 512 * i, s = p >> 5, cc = p & 31; *(LAS v4u*)(Vl + (cc >> 2) * 4096 + s * 64 + (cc & 3) * 16) = vreg[i]; }
            if (j < 3) ML_LOAD(j + 1);
            __syncthreads();
#pragma unroll
            for (int ks = 0; ks < 4; ++ks) {
                const LAS unsigned char* vp = Vl + F.wave * 4096 + ks * 16 * 64 + troff;
                const bf16x8 vf = cat8(tr16(vp), tr16(vp + 8 * 64));
#pragma unroll
                for (int dt = 0; dt < 4; ++dt) { const LAS unsigned char* kp = Kl + dt * 4096 + ks * 16 * 64 + troff;
                    const bf16x8 kf = cat8(tr16(kp), tr16(kp + 8 * 64)); acc[dt] = MFMA32(kf, vf, acc[dt]); }
            }
            if (F.tid >= 384) { const int d = F.tid - 384; const LAS unsigned short* kc = (const LAS unsigned short*)(Kl + (d >> 5) * 4096 + (d & 31) * 2);
#pragma unroll 16
                for (int s = 0; s < 64; ++s) nsum += bf2f(kc[s * 32]); }
            __syncthreads();
        }
#undef ML_LOAD
        bf16* st = STATE + (size_t)((sc * 4 + h) * 8 + F.wave) * 4096 + r32 * 8 + 4 * hi;
#pragma unroll
        for (int dt = 0; dt < 4; ++dt)
#pragma unroll
            for (int gq = 0; gq < 4; ++gq) { u32x2 w; w.x = cvtpk(acc[dt][4 * gq], acc[dt][4 * gq + 1]); w.y = cvtpk(acc[dt][4 * gq + 2], acc[dt][4 * gq + 3]); *(u32x2*)(st + ((2 * dt + (gq >> 1)) * 2 + (gq & 1)) * 256) = w; }
        if (F.tid >= 384) NST[(size_t)(sc * 4 + h) * 128 + F.tid - 384] = nsum;
    }
}

__device__ __forceinline__ void ml_scan256(Frame& F, bf16* STATE, float* NST, const float* CH, float* MS, bf16* DST, float* NDST) {
    LAUNDER_TID(F);
    LAS float* f1 = (LAS float*)(F.lds + RING_OFF); LAS float* f2 = f1 + 64;
    const int h = F.vcu >> 6;
    if (F.tid < 64) {
        const int c = F.lane; const float bt = CH[(c * 4 + h) * 2], ml = CH[(c * 4 + h) * 2 + 1];
        float B = bt, Mx = ml;
#pragma unroll
        for (int o = 1; o < 64; o <<= 1) { const float Bp = shfl_up_l(B, o, F.lane), Mp = shfl_up_l(Mx, o, F.lane); if (F.lane >= o) { Mx = fmaxf(Mp + B, Mx); B = Bp + B; } }
        const float Bq = shfl_up_l(B, 1, F.lane), Mq = shfl_up_l(Mx, 1, F.lane);
        const float m = (F.lane == 0) ? 0.f : fmaxf(Bq, Mq);
        const float mn = fmaxf(bt + m, ml);
        f1[c] = fexp(bt + m - mn); f2[c] = fexp(ml - mn);
        if ((F.vcu & 63) == 0) MS[c * 4 + h] = m;
    }
    __syncthreads();
    if (F.tid < 256) {
        unsigned* base = (unsigned*)(STATE + (size_t)h * 32768) + ((F.vcu & 63) * 256 + F.tid);
        unsigned* dbase = (unsigned*)(DST + (size_t)h * 32768) + ((F.vcu & 63) * 256 + F.tid);
        float c0v = 0.f, c1v = 0.f;
#pragma unroll 1
        for (int cb = 0; cb < NSC; cb += 32) {
            unsigned u[32];
#pragma unroll
            for (int j = 0; j < 32; ++j) u[j] = base[(size_t)(cb + j) * 65536];
#pragma unroll
            for (int j = 0; j < 32; ++j) { const float a = f1[cb + j], b = f2[cb + j];
                dbase[(size_t)(cb + j) * 65536] = pg8::cvt_pk_bf16(c0v, c1v);
                c0v = a * c0v + b * bflo(u[j]); c1v = a * c1v + b * bfhi(u[j]); }
        }
    } else if ((F.vcu & 63) == 0 && F.tid < 384) {
        float* base = NST + h * 128 + (F.tid - 256); float* dbase = NDST + h * 128 + (F.tid - 256); float nv = 0.f;
#pragma unroll 1
        for (int cb = 0; cb < NSC; cb += 16) {
            float u[16];
#pragma unroll
            for (int j = 0; j < 16; ++j) u[j] = base[(size_t)(cb + j) * 512];
#pragma unroll
            for (int j = 0; j < 16; ++j) { dbase[(size_t)(cb + j) * 512] = nv; nv = f1[cb + j] * nv + f2[cb + j] * u[j]; }
        }
    }
    __syncthreads();
}

__device__ __forceinline__ void ml_out256(Frame& F, const bf16* PROJ, const float* GATES, const bf16* STATE, const float* NST, const float* MS, const float* hnorm, bf16* HG, bf16* SH) {
    LAUNDER_TID(F);
    LAS unsigned char* Vl = F.lds + RING_OFF;
    LAS float* bcum = (LAS float*)(F.lds + GA_OFF); LAS float* aval = bcum + 256; LAS float* amc = aval + 256; LAS float* nst = amc + 256  ; LAS float* ssb = nst + 128  ;
    const int lane = F.lane, r32 = lane & 31, hi = lane >> 5, w = F.wave;
    for (int unit = F.vcu; unit < NSC * 4; unit += F.G) {
        const int sc = unit >> 2, h = unit & 3;
        const float mc = MS[sc * 4 + h];
        const bf16* qfb = PROJ;
        const bf16* kfb = PROJ + (size_t)M * 512;
        const bf16* vb = PROJ + (size_t)M * 1024 + (size_t)(sc * 256) * 1024 + h * 256;
        const bf16* ofb = PROJ + (size_t)M * 2048;
        const bf16* cfb = STATE + (size_t)(sc * 4 + h) * 32768;
        {
            const __amdgpu_buffer_rsrc_t vrs = __builtin_amdgcn_make_buffer_rsrc((void*)vb, 0, 256 * 1024 * 2, 0x00020000);
            const int voff = ((F.tid >> 5) * 1024 + (F.tid & 31) * 8) * 2;
            LAS unsigned char* vdst = Vl + ((F.tid & 31) >> 2) * 16384 + (F.tid >> 5) * 64 + (F.tid & 3) * 16;
#pragma unroll
            for (int half = 0; half < 2; ++half) { v4u vr[8];
#pragma unroll
                for (int i = 0; i < 8; ++i) vr[i] = __builtin_bit_cast(v4u, __builtin_amdgcn_raw_buffer_load_b128(vrs, voff, (half * 8 + i) * 16 * 2048, 0));
#pragma unroll
                for (int i = 0; i < 8; ++i) *(LAS v4u*)(vdst + (half * 8 + i) * 16 * 64) = vr[i]; }
        }
        asm volatile("" ::: "memory");
        if (F.tid < 64) { float btot, amax; sc_gates(GATES, sc, h, lane, bcum, aval, amc, btot, amax); }
        if (F.tid >= 64 && F.tid < 192) nst[F.tid - 64] = NST[(size_t)(sc * 4 + h) * 128 + F.tid - 64];
        asm volatile("" ::: "memory");
        __syncthreads();
        const int troff = (4 * hi + ((lane & 15) >> 2)) * 64 + ((lane >> 4) & 1) * 32 + (lane & 3) * 8;
        bf16* shw = SH + ((size_t)(unit * 2) * 8 + w) * 16 * 256 + lane * 4;
#pragma unroll 1
        for (int vh = 0; vh < 2; ++vh) {
            const int tb = vh ? 7 - w : w, t = tb * 32 + r32;
            const int fo = r32 * 8 + hi * 256;
            const bf16* qsrc = qfb + (size_t)(((sc * 8 + tb) * 4 + h) * 8) * 512 + fo;
            bf16x8 qf[8];
#pragma unroll
            for (int kk = 0; kk < 8; ++kk) qf[kk] = *(const bf16x8*)(qsrc + kk * 512);
            const bf16* csrc = cfb + (size_t)(vh * 4) * 4096 + fo;
            bf16x8 fr[8];
#pragma unroll
            for (int kk = 0; kk < 8; ++kk) fr[kk] = *(const bf16x8*)(csrc + kk * 512);
            const float b_t = bcum[t], m_t = b_t + fmaxf(mc, amc[t]), e_t = fexp(b_t + mc - m_t);
            float nq = 0.f;
#pragma unroll
            for (int kk = 0; kk < 8; ++kk) { const v4u qw = __builtin_bit_cast(v4u, qf[kk]); const f32x4 n0 = *(const LAS f32x4*)(nst + kk * 16 + hi * 8), n1 = *(const LAS f32x4*)(nst + kk * 16 + hi * 8 + 4);
                nq += (bflo(qw.x) * n0.x + bfhi(qw.x) * n0.y) + (bflo(qw.y) * n0.z + bfhi(qw.y) * n0.w) + (bflo(qw.z) * n1.x + bfhi(qw.z) * n1.y) + (bflo(qw.w) * n1.z + bfhi(qw.w) * n1.w); }
            nq = xor32_add(nq);
            const bf16* ksrc = kfb + (size_t)((sc * 8 * 4 + h) * 8) * 512 + fo;
            f32x16 acc[4];
#pragma unroll
            for (int i = 0; i < 4; ++i) { f32x16 xa;
#pragma unroll
                for (int r = 0; r < 16; ++r) xa[r] = 0.f;
#pragma unroll
                for (int kk = 0; kk < 8; ++kk) { xa = MFMA32(fr[kk], qf[kk], xa);
                    fr[kk] = (i < 3) ? *(const bf16x8*)(csrc + (size_t)(i + 1) * 4096 + kk * 512) : *(const bf16x8*)(ksrc + kk * 512); }
#pragma unroll
                for (int r = 0; r < 16; ++r) acc[i][r] = e_t * xa[r];
                asm volatile("" ::: "memory"); }
            float dsum = 0.f;
#pragma unroll 1
            for (int sb = 0; sb <= tb; ++sb) {
                f32x16 st;
#pragma unroll
                for (int r = 0; r < 16; ++r) st[r] = 0.f;
                const bf16* knext = ksrc + (size_t)(sb < tb ? sb + 1 : sb) * 16384;
#pragma unroll
                for (int kk = 0; kk < 8; ++kk) { st = MFMA32(fr[kk], qf[kk], st); fr[kk] = *(const bf16x8*)(knext + kk * 512); }
#pragma unroll
                for (int gq = 0; gq < 4; ++gq) { const f32x4 a4 = *(const LAS f32x4*)(aval + sb * 32 + 8 * gq + 4 * hi);
#pragma unroll
                    for (int i = 0; i < 4; ++i) { const int r = 4 * gq + i, cr = 8 * gq + 4 * hi + i; const bool valid = (sb < tb) || (cr <= r32);
                        const float wg = valid ? st[r] * fexp(b_t + a4[i] - m_t) : 0.f; st[r] = wg; dsum += wg; } }
                const bf16x8 pf0 = pack8(st, 0), pf1 = pack8(st, 1);
#pragma unroll
                for (int i = 0; i < 4; ++i) { const LAS unsigned char* vp = Vl + (vh * 4 + i) * 16384 + (sb * 32) * 64 + troff;
                    const bf16x8 vf0 = cat8(tr16(vp), tr16(vp + 8 * 64)), vf1 = cat8(tr16(vp + 16 * 64), tr16(vp + 24 * 64));
                    acc[i] = MFMA32(vf0, pf0, acc[i]); acc[i] = MFMA32(vf1, pf1, acc[i]); }
                asm volatile("" ::: "memory");
            }
            dsum = xor32_add(dsum);
            const float dinv = 1.f / fmaxf(fabsf(dsum + e_t * nq), fexp(-m_t));
            float ss = 0.f;
#pragma unroll
            for (int i = 0; i < 4; ++i)
#pragma unroll
                for (int gq = 0; gq < 4; ++gq) { const float h0 = acc[i][4 * gq] * dinv, h1 = acc[i][4 * gq + 1] * dinv, h2 = acc[i][4 * gq + 2] * dinv, h3 = acc[i][4 * gq + 3] * dinv;
                    u32x2 wv; wv.x = cvtpk(h0, h1); wv.y = cvtpk(h2, h3);
                    const float q0 = bflo(wv.x), q1 = bfhi(wv.x), q2 = bflo(wv.y), q3 = bfhi(wv.y); ss += (q0 * q0 + q1 * q1) + (q2 * q2 + q3 * q3);
                    *(u32x2*)(shw + (size_t)vh * 8 * 16 * 256 + (i * 4 + gq) * 256) = wv; }
            ss = xor32_add(ss);
            if (hi == 0) ssb[vh * 256 + t] = ss;
        }
        __syncthreads();
        LAS unsigned char* stg = Vl + w * 16384;
#pragma unroll 1
        for (int vh = 0; vh < 2; ++vh) {
            const int tb = vh ? 7 - w : w, t = tb * 32 + r32;
            const float rn = rsqrtf((ssb[t] + ssb[256 + t]) * (1.f / 256.f) + RMS_EPS);
            const bf16* osrc = ofb + (size_t)(((sc * 8 + tb) * 4 + h) * 8 + vh * 4) * 4 * 256 + r32 * 8 + hi * 4;
#pragma unroll
            for (int i = 0; i < 4; ++i)
#pragma unroll
                for (int gq = 0; gq < 4; ++gq) { const int v0 = h * 256 + (vh * 4 + i) * 32 + 8 * gq + 4 * hi;
                    const f32x4 gn = *(const f32x4*)(hnorm + v0); const u32x2 ow = *(const u32x2*)(osrc + (i * 4 + gq) * 256);
                    const u32x2 hp = *(const u32x2*)(shw + (size_t)vh * 8 * 16 * 256 + (i * 4 + gq) * 256); const unsigned p0 = hp.x, p1 = hp.y;
                    const float y0 = bflo(p0) * rn * gn.x * __builtin_amdgcn_rcpf(1.f + fexp(-bflo(ow.x))), y1 = bfhi(p0) * rn * gn.y * __builtin_amdgcn_rcpf(1.f + fexp(-bfhi(ow.x)));
                    const float y2 = bflo(p1) * rn * gn.z * __builtin_amdgcn_rcpf(1.f + fexp(-bflo(ow.y))), y3 = bfhi(p1) * rn * gn.w * __builtin_amdgcn_rcpf(1.f + fexp(-bfhi(ow.y)));
                    u32x2 wv; wv.x = cvtpk(y0, y1); wv.y = cvtpk(y2, y3);
                    *(LAS u32x2*)(stg + r32 * 272 + (i * 32 + 8 * gq + 4 * hi) * 2) = wv; }
            asm volatile("s_waitcnt lgkmcnt(0)" ::: "memory");
            bf16* orow = HG + (size_t)(sc * 256 + tb * 32) * D + h * 256 + vh * 128;
#pragma unroll
            for (int it = 0; it < 8; ++it) { const int rowl = it * 4 + (lane >> 4), ch = lane & 15; const v4u vv = *(const LAS v4u*)(stg + rowl * 272 + ch * 16); *(v4u*)(orow + (size_t)rowl * D + ch * 8) = vv; }
            asm volatile("s_waitcnt lgkmcnt(0)" ::: "memory");
        }
        __syncthreads();
    }
}

#ifndef ML256
#define ML256 1
#endif
#ifndef OVERLAP_CONV
#define OVERLAP_CONV 1
#endif
#ifndef XP_MLL
#define XP_MLL 0
#endif
#ifndef XP_MLO
#define XP_MLO 0
#endif
#ifndef XP_EPI
#define XP_EPI 0
#endif
#ifndef XP_PRO
#define XP_PRO 0
#endif
#ifndef XP_GEMM
#define XP_GEMM 0
#endif
#ifndef XP_ML
#define XP_ML 0
#endif
#ifndef XP_ATTN
#define XP_ATTN 0
#endif
#ifndef XP_GATES
#define XP_GATES 0
#endif
#ifndef XP_RES
#define XP_RES 0
#endif
#ifndef XP_SCAN
#define XP_SCAN 0
#endif
#ifndef XP_BAR
#define XP_BAR 0
#endif
#ifndef ATTN_MFMA
#define ATTN_MFMA 1
#endif
#ifndef MLL_MFMA
#define MLL_MFMA 1
#endif
#ifndef MLO_MFMA
#define MLO_MFMA 1
#endif
#ifndef PG8_SP2
#define PG8_SP2 true
#endif
#ifndef PG8_ALIGN
#define PG8_ALIGN true
#endif
__global__ void __launch_bounds__(NWAVES * 64, 2) yoco_fwd(Args args) {
    extern __shared__ __attribute__((aligned(16))) unsigned char lds[];
    Frame F;
    F.lds = (LAS unsigned char*)lds;
    F.MISC = (volatile LAS unsigned*)(F.lds + MISC_OFF);
    F.tid = threadIdx.x; F.lane = F.tid & 63; F.wave = __builtin_amdgcn_readfirstlane(F.tid >> 6);
    F.G = gridDim.x; { const int bx = blockIdx.x; F.vcu = (F.G % 8 == 0) ? (bx % 8) * (F.G / 8) + bx / 8 : bx; }
    F.ctl = (gu32*)(args.ws + WS_CTL);
    for (int u = F.tid; u < (LDS_BYTES - LDSCTL_OFF) / 4; u += NWAVES * 64) ((LAS unsigned*)(F.lds + LDSCTL_OFF))[u] = 0u;
    __syncthreads();
    unsigned bar_x; { XcdBarrier bar = xcd_barrier_post((unsigned*)(F.ctl + CW_BAR), F.MISC + 8); bar_x = __builtin_amdgcn_readfirstlane(bar.x); }
#define GRID_BAR() do { XcdBarrier b_; b_.bar = (unsigned*)(arg_ws() + WS_CTL) + CW_BAR; b_.x = bar_x; b_.st = (volatile LAS unsigned*)(F.lds + MISC_OFF) + 8; asm volatile("" : "+s"(b_.x)); xcd_barrier(b_); } while (0)

    for (int rep = 0; rep <= XP_PRO; ++rep) p0_prologue(F, args, OVERLAP_CONV ? 1 : 4);
    GRID_BAR();
    for (int rep = 0; rep < XP_BAR; ++rep) GRID_BAR();

#pragma unroll 1
    for (int l = 0; l < 4; ++l) {
        if (l < 2) {
            {
                pg8::Gemm g{WSP(const bf16, WS_XB), WSP(const bf16, WS_WIN) + (size_t)l * 3072 * D, M, 3072, D}; pg8::StaticOrder S; S.init(M, 3072, F.G, (int)blockIdx.x);
                EpiProjML E{WSP(bf16, WS_PROJ), WSP(const float, WS_SSP)};
                for (int rep = 0; rep <= XP_GEMM; ++rep) pg8::gemm_phase<EpiProjML, pg8::StaticOrder, PG8_ALIGN, PG8_SP2>(F.lds + RING_OFF, g, S, E);
                for (int rep = 0; rep <= XP_GATES; ++rep) gates_phase(F, WSP(const bf16, WS_XB), WSP(const float, WS_SSP), WSP(const float, WS_WGT) + l * 8 * 1024, arg_in(3) + l * 8, WSP(float, WS_GATES));
            }
            GRID_BAR();
            for (int rep = 0; rep <= XP_ML + XP_MLL; ++rep) ml_local256(F, WSP(const bf16, WS_PROJ), WSP(const float, WS_GATES), WSP(bf16, WS_STATE), WSP(float, WS_NST), WSP(float, WS_CH));
            GRID_BAR();
            for (int rep = 0; rep < XP_SCAN; ++rep) ml_scan256(F, WSP(bf16, WS_STATE), WSP(float, WS_NST), WSP(const float, WS_CH), WSP(float, WS_MS), WSP(bf16, WS_HG), (float*)(arg_ws() + WS_HG + 20 * MiB));
            ml_scan256(F, WSP(bf16, WS_STATE), WSP(float, WS_NST), WSP(const float, WS_CH), WSP(float, WS_MS), WSP(bf16, WS_STATE), WSP(float, WS_NST));
            GRID_BAR();
            for (int rep = 0; rep <= XP_ML + XP_MLO; ++rep) ml_out256(F, WSP(const bf16, WS_PROJ), WSP(const float, WS_GATES), WSP(const bf16, WS_STATE), WSP(const float, WS_NST), WSP(const float, WS_MS), arg_in(4) + l * D, WSP(bf16, WS_HG), (bf16*)(arg_ws() + WS_STATE + 32 * MiB));
            GRID_BAR();
            {
                pg8::Gemm g{WSP(const bf16, WS_HG), WSP(const bf16, WS_WOUT) + (size_t)l * D * D, M, D, D}; pg8::StaticOrder S; S.init(M, D, F.G, (int)blockIdx.x);
                for (int rep = 0; rep < XP_RES; ++rep) { EpiResid E0{(l == 0) ? arg_in(0) : nullptr, WSP(const bf16, WS_XB), WSP(bf16, WS_PROJ), nullptr, WSP(float, WS_GATES)}; pg8::gemm_phase<EpiResid, pg8::StaticOrder, false, PG8_SP2>(F.lds + RING_OFF, g, S, E0); }
                EpiResid E{(l == 0) ? arg_in(0) : nullptr, WSP(const bf16, WS_XB), WSP(bf16, WS_XB), nullptr, WSP(float, WS_SSP)};
                pg8::gemm_phase<EpiResid, pg8::StaticOrder, false, PG8_SP2>(F.lds + RING_OFF, g, S, E);
            }
            GRID_BAR();
        } else {
            const int j = l - 2;
            {
                const int N = (j == 0) ? 1280 : 1024;
                pg8::Gemm g{WSP(const bf16, WS_XB), (const bf16*)(arg_ws() + (j == 0 ? WS_WQ2 : WS_WQ3)), M, N, D}; pg8::StaticOrder S; S.init(M, N, F.G, (int)blockIdx.x);
                EpiProj E{WSP(bf16, WS_PROJ), D, WSP(bf16, WS_KV), 256, 1024, WSP(const float, WS_BQ) + j * 1280, WSP(const float, WS_SSP)};
                for (int rep = 0; rep <= XP_GEMM; ++rep) pg8::gemm_phase<EpiProj, pg8::StaticOrder, PG8_ALIGN, PG8_SP2>(F.lds + RING_OFF, g, S, E);
            }
            GRID_BAR();
            for (int rep = 0; rep <= XP_ATTN; ++rep) attn_phase_mfma(F, WSP(const bf16, WS_PROJ), WSP(const bf16, WS_KV), arg_in(12) + j * 16, WSP(bf16, WS_HG));
            GRID_BAR();
            {
                pg8::Gemm g{WSP(const bf16, WS_HG), WSP(const bf16, WS_WBO) + (size_t)j * D * D, M, D, D}; pg8::StaticOrder S; S.init(M, D, F.G, (int)blockIdx.x);
                for (int rep = 0; rep < XP_RES; ++rep) { EpiResid E0{nullptr, WSP(const bf16, WS_XB), WSP(bf16, WS_PROJ), arg_in(14) + j * D, WSP(float, WS_GATES)}; pg8::gemm_phase<EpiResid, pg8::StaticOrder, false, PG8_SP2>(F.lds + RING_OFF, g, S, E0); }
                EpiResid E{nullptr, WSP(const bf16, WS_XB), WSP(bf16, WS_XB), arg_in(14) + j * D, WSP(float, WS_SSP)};
                pg8::gemm_phase<EpiResid, pg8::StaticOrder, false, PG8_SP2>(F.lds + RING_OFF, g, S, E);
            }
            GRID_BAR();
        }
        {
            pg8::Gemm g{WSP(const bf16, WS_XB), WSP(const bf16, WS_WGU) + (size_t)l * 2 * DFF * D, M, 2 * DFF, D}; pg8::StaticOrder S; S.init(M, 2 * DFF, F.G, (int)blockIdx.x);
            EpiSwiglu E{WSP(bf16, WS_PROJ), WSP(const float, WS_SSP)};
            for (int rep = 0; rep <= XP_GEMM; ++rep) pg8::gemm_phase<EpiSwiglu, pg8::StaticOrder, PG8_ALIGN, PG8_SP2>(F.lds + RING_OFF, g, S, E);
        }
#if OVERLAP_CONV
        if (l < 3 && blockIdx.x >= 128) conv_layer(F, l + 1, ((int)blockIdx.x - 128) * NWAVES + F.wave, 128 * NWAVES);
#endif
        GRID_BAR();
        {
            pg8::Gemm g{WSP(const bf16, WS_PROJ), WSP(const bf16, WS_WD) + (size_t)l * D * DFF, M, D, DFF}; pg8::StaticOrder S; S.init(M, D, F.G, (int)blockIdx.x);
            for (int rep = 0; rep < XP_RES; ++rep) { EpiResid E0{nullptr, WSP(const bf16, WS_XB), WSP(bf16, WS_HG), nullptr, WSP(float, WS_GATES)}; pg8::gemm_phase<EpiResid, pg8::StaticOrder, false, PG8_SP2>(F.lds + RING_OFF, g, S, E0); }
            EpiResid E{nullptr, WSP(const bf16, WS_XB), WSP(bf16, WS_XB), nullptr, WSP(float, WS_SSP)};
            pg8::gemm_phase<EpiResid, pg8::StaticOrder, false, PG8_SP2>(F.lds + RING_OFF, g, S, E);
        }
        GRID_BAR();
    }
    final_norm_phase(F, arg_out(), WSP(const bf16, WS_XB), WSP(const float, WS_SSP), arg_in(18));
}

extern "C" void kernel_launch(void* const* d_in, const int* in_sizes, int n_in, void* d_out, int out_size, void* d_ws, size_t ws_size, hipStream_t stream) {
    static int grid = 0;
    if (grid == 0) {
        if (n_in != 19 || in_sizes[0] != M * D || out_size != M * D || ws_size < WS_END) { fprintf(stderr, "kernel_launch: unexpected shapes / workspace (n_in %d, ws %zu < %zu)\n", n_in, ws_size, (size_t)WS_END); grid = -1; return; }
        int dev = 0, cus = 0, per_cu = 0;
        if (hipGetDevice(&dev) != hipSuccess || hipDeviceGetAttribute(&cus, hipDeviceAttributeMultiprocessorCount, dev) != hipSuccess) { grid = -1; return; }
        if (hipFuncSetAttribute((const void*)yoco_fwd, hipFuncAttributeMaxDynamicSharedMemorySize, LDS_BYTES) != hipSuccess) { fprintf(stderr, "kernel_launch: hipFuncSetAttribute failed\n"); grid = -1; return; }
        if (hipOccupancyMaxActiveBlocksPerMultiprocessor(&per_cu, (const void*)yoco_fwd, NWAVES * 64, LDS_BYTES) != hipSuccess || per_cu < 1) { fprintf(stderr, "kernel_launch: occupancy query says %d blocks per CU\n", per_cu); (void)hipGetLastError(); grid = -1; return; }
        grid = cus;
        if (grid != 256) fprintf(stderr, "kernel_launch: %d CUs; this kernel is laid out for 256\n", grid);
    }
    if (grid < 0) return;
    if (hipMemsetAsync((char*)d_ws + WS_CTL, 0, CTL_ZERO_BYTES, stream) != hipSuccess) return;
    Args a{};
    for (int i = 0; i < 19; ++i) a.in[i] = (const float*)d_in[i];
    a.out = (float*)d_out; a.ws = (unsigned char*)d_ws;
    hipLaunchKernelGGL(yoco_fwd, dim3(grid), dim3(NWAVES * 64), LDS_BYTES, stream, a);
}
```
